# Optimizing an MI355X kernel written in HIP

```python
import math
import jax, jax.numpy as jnp
from jax import lax
import numpy as np

D_MODEL = 1024
BATCH = 8
SEQ = 4096
DEPTH = 2

CHUNK = 64
Q_BLOCK = 128
D_MIX = D_MODEL
N_GROUPS = 4
GROUP_WIDTH = D_MIX // N_GROUPS
HEAD_DIM = 64
GROUP_HEADS = GROUP_WIDTH // HEAD_DIM

MLA_Q_LORA = D_MODEL // 4
MLA_KV_LORA = D_MODEL // 8
MLA_NOPE = HEAD_DIM
MLA_ROPE = HEAD_DIM // 2
MLA_V = HEAD_DIM
ROPE_BASE = 10000.0

DIFF_QK = HEAD_DIM // 2

IDX_HEADS = 8
IDX_DIM = 32
TOPK_MAX = 256

CONV_WIDTH = 3

NUM_BUCKETS = 32
MAX_DISTANCE = 128
N_BIAS_HEADS = 2 * GROUP_HEADS + GROUP_HEADS

NORM_EPS = 1e-6
NEG = -1e30

IN_SPLITS = (
    ("a_cq", MLA_Q_LORA), ("a_ckv", MLA_KV_LORA), ("a_krope", MLA_ROPE), ("a_gate", GROUP_WIDTH),
    ("b_q", GROUP_HEADS * 2 * DIFF_QK), ("b_k", GROUP_HEADS * 2 * DIFF_QK), ("b_v", GROUP_WIDTH), ("b_gate", GROUP_WIDTH),
    ("c_q", GROUP_WIDTH), ("c_k", GROUP_WIDTH), ("c_v", GROUP_WIDTH),
    ("c_qidx", IDX_HEADS * IDX_DIM), ("c_kidx", IDX_DIM), ("c_widx", IDX_HEADS), ("c_gate", GROUP_WIDTH),
    ("d_b", GROUP_WIDTH), ("d_c", GROUP_WIDTH), ("d_h", GROUP_WIDTH), ("d_gate", GROUP_WIDTH),
)
IN_COLS = sum(w for _, w in IN_SPLITS)

kernel_name = "hybrid_parallel_mla_diff_dsa_conv"


def _rmsnorm(x, g):
    xf = x.astype(jnp.float32)
    y = xf * lax.rsqrt(jnp.mean(xf * xf, axis=-1, keepdims=True) + NORM_EPS)
    return (y * g.astype(jnp.float32)).astype(x.dtype)


def _split(p):
    out, off = {}, 0
    for name, width in IN_SPLITS:
        out[name] = p[..., off:off + width]
        off += width
    return out


def _rope(x, cos, sin):
    half = x.shape[-1] // 2
    x1, x2 = x[..., :half], x[..., half:]
    c, s = cos.astype(x.dtype), sin.astype(x.dtype)
    return jnp.concatenate([x1 * c - x2 * s, x2 * c + x1 * s], axis=-1)


def _rel_bucket(rel):
    nb = NUM_BUCKETS // 2
    max_exact = nb // 2
    ret = jnp.where(rel > 0, nb, 0)
    n = jnp.abs(rel)
    nf = jnp.maximum(n, max_exact).astype(jnp.float32)
    large = max_exact + (jnp.log(nf / max_exact) / math.log(MAX_DISTANCE / max_exact)
                         * (nb - max_exact)).astype(jnp.int32)
    large = jnp.minimum(large, nb - 1)
    return ret + jnp.where(n < max_exact, n, large)


def _masked_softmax(logits, mask):
    return jax.nn.softmax(jnp.where(mask, logits.astype(jnp.float32), NEG), axis=-1)


def _chunk_mask(qpos, kpos):
    return (kpos // CHUNK)[None, :] <= (qpos // CHUNK)[:, None]


def _sweep(fn, S):
    out = lax.map(fn, jnp.arange(S // Q_BLOCK, dtype=jnp.int32) * Q_BLOCK)
    out = jnp.moveaxis(out, 0, 1)
    return out.reshape((out.shape[0], S) + out.shape[3:])


def _mla(cq, ckv, krope, qa_g, w_uq, kva_g, w_ukv, cos, sin):
    B, S, _ = cq.shape
    H = GROUP_HEADS
    q = (_rmsnorm(cq, qa_g) @ w_uq).reshape(B, S, H, MLA_NOPE + MLA_ROPE)
    q_nope = q[..., :MLA_NOPE]
    q_rope = _rope(q[..., MLA_NOPE:], cos[:, None], sin[:, None])
    kv = (_rmsnorm(ckv, kva_g) @ w_ukv).reshape(B, S, H, MLA_NOPE + MLA_V)
    k_nope, v = kv[..., :MLA_NOPE], kv[..., MLA_NOPE:]
    k_rope = _rope(krope, cos, sin)
    scale = (MLA_NOPE + MLA_ROPE) ** -0.5
    kpos = jnp.arange(S, dtype=jnp.int32)

    def block(start):
        qpos = start + jnp.arange(Q_BLOCK, dtype=jnp.int32)
        qn = lax.dynamic_slice_in_dim(q_nope, start, Q_BLOCK, axis=1)
        qr = lax.dynamic_slice_in_dim(q_rope, start, Q_BLOCK, axis=1)
        logits = (jnp.einsum('bqhd,bkhd->bhqk', qn, k_nope)
                  + jnp.einsum('bqhr,bkr->bhqk', qr, k_rope)) * scale
        p = _masked_softmax(logits, _chunk_mask(qpos, kpos))
        return jnp.einsum('bhqk,bkhd->bqhd', p.astype(v.dtype), v)

    return _sweep(block, S).reshape(B, S, H * MLA_V)


def _diff_attn(q, k, v, lam_params, subln_g, rel_bias, lambda_init):
    B, S, _ = q.shape
    H = GROUP_HEADS
    q = q.reshape(B, S, H, 2, DIFF_QK)
    k = k.reshape(B, S, H, 2, DIFF_QK)
    v = v.reshape(B, S, H, HEAD_DIM)
    lp = lam_params.astype(jnp.float32)
    lam = jnp.exp(jnp.sum(lp[0] * lp[1])) - jnp.exp(jnp.sum(lp[2] * lp[3])) + lambda_init
    table = rel_bias[:, :2 * H].reshape(NUM_BUCKETS, H, 2)
    scale = DIFF_QK ** -0.5
    kpos = jnp.arange(S, dtype=jnp.int32)

    def block(start):
        qpos = start + jnp.arange(Q_BLOCK, dtype=jnp.int32)
        qb = lax.dynamic_slice_in_dim(q, start, Q_BLOCK, axis=1)
        bias = jnp.transpose(table[_rel_bucket(kpos[None, :] - qpos[:, None])], (2, 3, 0, 1))
        logits = jnp.einsum('bqhmd,bkhmd->bhmqk', qb, k) * scale + bias
        p = _masked_softmax(logits, _chunk_mask(qpos, kpos))
        a = p[:, :, 0] - lam * p[:, :, 1]
        return jnp.einsum('bhqk,bkhd->bqhd', a.astype(v.dtype), v)

    o = _sweep(block, S)
    o = _rmsnorm(o, subln_g) * (1.0 - lambda_init)
    return o.reshape(B, S, H * HEAD_DIM)


def _dsa(q, k, v, qidx, kidx, widx, rel_bias, topk):
    B, S, _ = q.shape
    H = GROUP_HEADS
    q = q.reshape(B, S, H, HEAD_DIM)
    k = k.reshape(B, S, H, HEAD_DIM)
    v = v.reshape(B, S, H, HEAD_DIM)
    qidx = qidx.reshape(B, S, IDX_HEADS, IDX_DIM)
    table = rel_bias[:, 2 * H:]
    scale = HEAD_DIM ** -0.5
    idx_scale = (IDX_HEADS ** -0.5) * (IDX_DIM ** -0.5)
    kpos = jnp.arange(S, dtype=jnp.int32)
    gather = jax.vmap(lambda xb, ib: xb[ib])

    def block(start):
        qpos = start + jnp.arange(Q_BLOCK, dtype=jnp.int32)
        qi = lax.dynamic_slice_in_dim(qidx, start, Q_BLOCK, axis=1)
        wi = lax.dynamic_slice_in_dim(widx, start, Q_BLOCK, axis=1).astype(jnp.float32)
        score = jax.nn.relu(jnp.einsum('bqhd,bkd->bqhk', qi, kidx).astype(jnp.float32))
        index = jnp.einsum('bqh,bqhk->bqk', wi, score) * idx_scale
        index = jnp.where(_chunk_mask(qpos, kpos)[None], index, NEG)
        _, sel = lax.top_k(index, topk)
        k_sel = gather(k, sel)
        v_sel = gather(v, sel)
        valid = (sel // CHUNK) <= (qpos // CHUNK)[None, :, None]
        bias = jnp.transpose(table[_rel_bucket(sel - qpos[None, :, None])], (0, 3, 1, 2))
        qb = lax.dynamic_slice_in_dim(q, start, Q_BLOCK, axis=1)
        logits = jnp.einsum('bqhd,bqjhd->bhqj', qb, k_sel) * scale + bias
        p = _masked_softmax(logits, valid[:, None])
        return jnp.einsum('bhqj,bqjhd->bqhd', p.astype(v.dtype), v_sel)

    return _sweep(block, S).reshape(B, S, H * HEAD_DIM)


def _short_conv(b, c, h, conv_w):
    u = c * h
    S = u.shape[1]
    up = jnp.pad(u, ((0, 0), (CONV_WIDTH - 1, 0), (0, 0)))
    y = conv_w[0] * up[:, 0:S]
    for j in range(1, CONV_WIDTH):
        y = y + conv_w[j] * up[:, j:j + S]
    return b * y


def setup_inputs(seed: int = 0) -> dict:
    key = jax.random.key(seed)
    ks = jax.random.split(key, 14)
    f32 = jnp.float32
    nrm = lambda k, shape: jax.random.normal(k, shape, f32)
    H = GROUP_HEADS
    return {
        "x": nrm(ks[0], (BATCH, SEQ, D_MODEL)),
        "norm_g": 1.0 + 0.05 * nrm(ks[1], (DEPTH, D_MODEL)),
        "w_in": nrm(ks[2], (DEPTH, D_MODEL, IN_COLS)) * D_MODEL ** -0.5,
        "mla_qa_g": 1.0 + 0.05 * nrm(ks[3], (DEPTH, MLA_Q_LORA)),
        "mla_w_uq": nrm(ks[4], (DEPTH, MLA_Q_LORA, H * (MLA_NOPE + MLA_ROPE))) * MLA_Q_LORA ** -0.5,
        "mla_kva_g": 1.0 + 0.05 * nrm(ks[5], (DEPTH, MLA_KV_LORA)),
        "mla_w_ukv": nrm(ks[6], (DEPTH, MLA_KV_LORA, H * (MLA_NOPE + MLA_V))) * MLA_KV_LORA ** -0.5,
        "diff_lambda": 0.1 * nrm(ks[7], (DEPTH, 4, DIFF_QK)),
        "diff_subln_g": 1.0 + 0.05 * nrm(ks[8], (DEPTH, HEAD_DIM)),
        "conv_w": nrm(ks[9], (DEPTH, CONV_WIDTH, GROUP_WIDTH)) * CONV_WIDTH ** -0.5,
        "w_out": nrm(ks[10], (DEPTH, D_MIX, D_MODEL)) * D_MIX ** -0.5,
        "rel_bias": 0.5 * nrm(ks[11], (NUM_BUCKETS, N_BIAS_HEADS)),
        "final_g": 1.0 + 0.05 * nrm(ks[12], (D_MODEL,)),
    }


def reference(x, norm_g, w_in, mla_qa_g, mla_w_uq, mla_kva_g, mla_w_ukv, diff_lambda,
              diff_subln_g, conv_w, w_out, rel_bias, final_g):
    S = x.shape[1]
    topk = min(TOPK_MAX, S // 4)
    half = MLA_ROPE // 2
    inv_freq = ROPE_BASE ** (-jnp.arange(half, dtype=jnp.float32) / half)
    ang = jnp.arange(S, dtype=jnp.float32)[:, None] * inv_freq[None, :]
    cos, sin = jnp.cos(ang), jnp.sin(ang)

    for l in range(DEPTH):
        lambda_init = 0.8 - 0.6 * math.exp(-0.3 * l)
        h = _rmsnorm(x, norm_g[l])
        p = _split(h @ w_in[l])
        o_a = _mla(p["a_cq"], p["a_ckv"], p["a_krope"], mla_qa_g[l], mla_w_uq[l],
                   mla_kva_g[l], mla_w_ukv[l], cos, sin)
        o_b = _diff_attn(p["b_q"], p["b_k"], p["b_v"], diff_lambda[l], diff_subln_g[l],
                         rel_bias, lambda_init)
        o_c = _dsa(p["c_q"], p["c_k"], p["c_v"], p["c_qidx"], p["c_kidx"], p["c_widx"],
                   rel_bias, topk)
        o_d = _short_conv(p["d_b"], p["d_c"], p["d_h"], conv_w[l])
        y = jnp.concatenate([
            o_a * jax.nn.silu(p["a_gate"]),
            o_b * jax.nn.silu(p["b_gate"]),
            o_c * jax.nn.silu(p["c_gate"]),
            o_d * jax.nn.silu(p["d_gate"]),
        ], axis=-1)
        x = x + y @ w_out[l]
    return _rmsnorm(x, final_g)
```

```cpp
#include <hip/hip_runtime.h>
#include <hip/hip_bf16.h>
#include <cstdint>
#include <cstdio>

#define LAS __attribute__((address_space(3)))
typedef unsigned short bf16_t;
typedef short bf16x8 __attribute__((ext_vector_type(8)));
typedef unsigned short u16x8 __attribute__((ext_vector_type(8)));
typedef float f32x4 __attribute__((ext_vector_type(4)));
typedef unsigned u32x4 __attribute__((ext_vector_type(4)));
typedef unsigned u32x2 __attribute__((ext_vector_type(2)));

constexpr int NB = 8, S = 4096, T = NB * S, D = 1024, NL = 2;
constexpr int PC = 4096;
constexpr int INC = 4040;
constexpr int CA_CQ = 0, CA_CKV = 256, CA_KR = 384, CA_G = 448;
constexpr int CB_Q = 704, CB_K = 960, CB_V = 1216, CB_G = 1472;
constexpr int CC_Q = 1728, CC_K = 1984, CC_V = 2240, CC_QI = 2496, CC_KI = 2752, CC_WI = 2784, CC_G = 2816;
constexpr int CD_B = 3072, CD_C = 3328, CD_H = 3584, CD_G = 3840;
constexpr float EPS = 1e-6f;
constexpr int NTHR = 512, NWAVE = 8;

constexpr size_t MiB = 1u << 20;
constexpr size_t WS_WTIN = 1 * MiB;
constexpr size_t WS_WTOUT = 17 * MiB;
constexpr size_t WS_WTUQ = 21 * MiB;
constexpr size_t WS_WTUKV = 22 * MiB;
constexpr size_t WS_ROPE = 23 * MiB;
constexpr size_t WS_HN = 24 * MiB;
constexpr size_t WS_Y = WS_HN;
constexpr size_t WS_Q384 = WS_HN;
constexpr size_t WS_KV512 = WS_HN + 24 * MiB;
constexpr size_t WS_P = 88 * MiB;
constexpr size_t WS_QA = 344 * MiB;
constexpr size_t WS_KA = 368 * MiB;
constexpr size_t WS_VA = 392 * MiB;
constexpr size_t WS_CQN = WS_VA;
constexpr size_t WS_MASK = 408 * MiB;
constexpr size_t WS_CKVN = WS_MASK;
constexpr size_t WS_OKL = 424 * MiB;
constexpr size_t WS_XR = 440 * MiB;
constexpr size_t WS_END = 504 * MiB;

constexpr int LDS_BYTES = 148480;

__device__ __forceinline__ bf16_t f2bf(float f) {
    unsigned u = __builtin_bit_cast(unsigned, f);
    return (bf16_t)((u + 0x7fffu + ((u >> 16) & 1u)) >> 16);
}
__device__ __forceinline__ float bf2f(bf16_t h) { return __builtin_bit_cast(float, (unsigned)h << 16); }
__device__ __forceinline__ float silu(float x) { return x / (1.f + __expf(-x)); }
__device__ __forceinline__ int orig_col(int pc) {
    if (pc < 416) return pc;
    if (pc < 448) return -1;
    if (pc < 2792) return pc - 32;
    if (pc < 2816) return -1;
    return pc - 56;
}
__device__ __forceinline__ int rel_bucket(int rel) {
    const int ret = rel > 0 ? 16 : 0;
    const int n = rel < 0 ? -rel : rel;
    if (n < 8) return ret + n;
    int large = 2 + (31 - __clz(n * n));
    if (large > 15) large = 15;
    return ret + large;
}

__device__ __forceinline__ int opaque_tid() { int t = threadIdx.x; asm volatile("" : "+v"(t)); return t; }
__device__ __forceinline__ int opaque_bid() { int b = blockIdx.x; asm volatile("" : "+s"(b)); return b; }
__device__ __forceinline__ int opaque_grid() { int g = gridDim.x; asm volatile("" : "+s"(g)); return g; }
namespace pg8 {
constexpr int BM = 256, BK = 64, HALF = 128, HTB = HALF * BK * 2, STAGE_BYTES = 8 * HTB, NXCD = 8, WGM = 8;
__host__ __device__ __forceinline__ int lds_byte(int r, int c) { const int st = (r >> 4) * 2 + (c >> 5), rr = r & 15, cc = c & 31, ob = rr * 64 + cc * 2; return st * 1024 + (ob ^ (((ob >> 9) & 1) << 5)); }
__host__ __device__ __forceinline__ void stage_rc(int b, int& R, int& C) { const int st = b / 1024, sb = b % 1024, swz = sb ^ (((sb >> 9) & 1) << 5); R = (st >> 1) * 16 + swz / 64; C = (st & 1) * 32 + (swz % 64) / 2; }
__host__ __device__ __forceinline__ int perm32(int rho) { const int n = rho >> 4, i = rho & 15; return 8 * (i >> 2) + 4 * n + (i & 3); }
struct Unit { int pm, pn; };
struct Gemm { const bf16_t* A; const bf16_t* Bt; int M, N, K; };
struct StaticOrder {
    int nM, nN, nwg, G, c;
    __host__ __device__ void init(int M, int N, int G_, int c_) { nM = M / BM; nN = N / BM; nwg = nM * nN; G = G_; c = c_; }
    __host__ __device__ bool next(int i, Unit& u) const {
        const long L = (long)i * G + c; if (L >= nwg) return false;
        int wgid = (int)L; { const int q = nwg / NXCD, r = nwg % NXCD, xcd = wgid % NXCD, off = wgid / NXCD; wgid = (xcd < r ? xcd * (q + 1) : r * (q + 1) + (xcd - r) * q) + off; }
        const int nig = WGM * nN, gid = wgid / nig, fm = gid * WGM, gsz = (nM - fm) < WGM ? (nM - fm) : WGM;
        u.pm = fm + ((wgid % nig) % gsz); u.pn = (wgid % nig) / gsz; return true;
    }
    __device__ __forceinline__ void a_ready(const Unit&) const {}
    __device__ __forceinline__ void done(const Unit&) const {}
};
__device__ __forceinline__ unsigned cvt_pk_bf16(float lo, float hi) { unsigned r; asm volatile("v_cvt_pk_bf16_f32 %0, %1, %2" : "=v"(r) : "v"(lo), "v"(hi)); return r; }
struct EpiBf16 {
    static constexpr bool PERM = true, AFTER_DRAIN = false;
    bf16_t* O; int ldc;
    __device__ __forceinline__ void operator()(const f32x4 (&acc)[2][2][4][2], const Unit& u, int wr, int wc, int fr, int fq) const {
        const int row0 = u.pm * BM + wr * 64 + fr; const int col0 = u.pn * BM + wc * 32 + 8 * fq;
#pragma unroll
        for (int ai = 0; ai < 2; ++ai)
#pragma unroll
            for (int m = 0; m < 4; ++m) { bf16_t* rowp = O + (size_t)(row0 + ai * HALF + m * 16) * ldc + col0;
#pragma unroll
                for (int bj = 0; bj < 2; ++bj) { const f32x4 v0 = acc[ai][bj][m][0], v1 = acc[ai][bj][m][1];
                    u32x4 w; w.x = cvt_pk_bf16(v0[0], v0[1]); w.y = cvt_pk_bf16(v0[2], v0[3]); w.z = cvt_pk_bf16(v1[0], v1[1]); w.w = cvt_pk_bf16(v1[2], v1[3]);
                    *(u32x4*)(rowp + bj * HALF) = w; } }
    }
};
struct EpiResF32 {
    static constexpr bool PERM = false, AFTER_DRAIN = false;
    const float* base; float* out; int ldc;
    __device__ __forceinline__ void operator()(const f32x4 (&acc)[2][2][4][2], const Unit& u, int wr, int wc, int fr, int fq) const {
        const int col0 = u.pn * BM + wc * 32 + 4 * fq;
#pragma unroll
        for (int ai = 0; ai < 2; ++ai)
#pragma unroll
            for (int m = 0; m < 4; ++m) { const size_t off = (size_t)(u.pm * BM + ai * HALF + wr * 64 + m * 16 + fr) * ldc + col0;
#pragma unroll
                for (int bj = 0; bj < 2; ++bj)
#pragma unroll
                    for (int n = 0; n < 2; ++n) { const f32x4 bs = *(const f32x4*)(base + off + bj * HALF + n * 16); *(f32x4*)(out + off + bj * HALF + n * 16) = bs + acc[ai][bj][m][n]; } }
    }
};
template <bool BASE_BF16>
struct EpiResBf16 {
    static constexpr bool PERM = true, AFTER_DRAIN = false;
    const void* base; bf16_t* out; int ldc;
    __device__ __forceinline__ void operator()(const f32x4 (&acc)[2][2][4][2], const Unit& u, int wr, int wc, int fr, int fq) const {
        const int row0 = u.pm * BM + wr * 64 + fr; const int col0 = u.pn * BM + wc * 32 + 8 * fq;
#pragma unroll
        for (int ai = 0; ai < 2; ++ai)
#pragma unroll
            for (int m = 0; m < 4; ++m) { const size_t ro = (size_t)(row0 + ai * HALF + m * 16) * ldc + col0;
#pragma unroll
                for (int bj = 0; bj < 2; ++bj) { const f32x4 v0 = acc[ai][bj][m][0], v1 = acc[ai][bj][m][1]; const size_t off = ro + bj * HALF;
                    f32x4 b0, b1;
                    if (BASE_BF16) { const u16x8 bb = *(const u16x8*)((const bf16_t*)base + off);
                        b0 = (f32x4){bf2f(bb[0]), bf2f(bb[1]), bf2f(bb[2]), bf2f(bb[3])}; b1 = (f32x4){bf2f(bb[4]), bf2f(bb[5]), bf2f(bb[6]), bf2f(bb[7])}; }
                    else { b0 = *(const f32x4*)((const float*)base + off); b1 = *(const f32x4*)((const float*)base + off + 4); }
                    const f32x4 s0 = b0 + v0, s1 = b1 + v1;
                    u32x4 w; w.x = cvt_pk_bf16(s0[0], s0[1]); w.y = cvt_pk_bf16(s0[2], s0[3]); w.z = cvt_pk_bf16(s1[0], s1[1]); w.w = cvt_pk_bf16(s1[2], s1[3]);
                    *(u32x4*)(out + off) = w; } }
    }
};
template <class Epi, class Sched, bool ALIGN_EPI = false, bool SP2 = false>
__device__ __forceinline__ void gemm_phase(LAS unsigned char* lds, const Gemm g, const Sched& S, const Epi& E) {
    const int tid = opaque_tid(), wid = __builtin_amdgcn_readfirstlane(tid >> 6), lane = tid & 63, wr = wid >> 2, wc = wid & 3, fr = lane & 15, fq = lane >> 4;
    const int K = g.K, nt = K / BK;
    unsigned voffA[2], voffB[2];
#pragma unroll
    for (int i = 0; i < 2; ++i) { int R, C; stage_rc(tid * 16 + i * 8192, R, C); const int Rb = Epi::PERM ? ((R & ~31) + perm32(R & 31)) : R;
        voffA[i] = (unsigned)(R * K + C) * 2u; voffB[i] = (unsigned)(Rb * K + C) * 2u; }
    const size_t kstep = (size_t)(BK * 2);
    const size_t hstep = (size_t)HALF * K * 2;
    const size_t tstep = 2 * hstep;
    const unsigned ldsw = (unsigned)wid * 1024u;
    const int aoff = lds_byte(wr * 64 + fr, fq * 8), boff = lds_byte(wc * 32 + fr, fq * 8);
#define PG8_SA(b, h) (((b) * 2 + (h)) * HTB)
#define PG8_SB(b, h) ((4 + (b) * 2 + (h)) * HTB)
#define PG8_STAGE(bufoff, gbase, voff) do { _Pragma("unroll") for (int _i = 0; _i < 2; ++_i) \
        __builtin_amdgcn_global_load_lds((const unsigned*)((const char*)(gbase) + (voff)[_i]), (LAS unsigned*)(lds + (bufoff) + ldsw + _i * 8192), 16, 0, 0); } while (0)
#define PG8_LDA(dst, b, h) do { _Pragma("unroll") for (int m = 0; m < 4; ++m) _Pragma("unroll") for (int k = 0; k < 2; ++k) dst[m][k] = *(const LAS bf16x8*)(lds + PG8_SA(b, h) + aoff + m * 2048 + k * 1024); } while (0)
#define PG8_LDB(dst, b, h) do { _Pragma("unroll") for (int n = 0; n < 2; ++n) _Pragma("unroll") for (int k = 0; k < 2; ++k) dst[n][k] = *(const LAS bf16x8*)(lds + PG8_SB(b, h) + boff + n * 2048 + k * 1024); } while (0)
#define PG8_MMA(ai, bj, At, Bt) do { __builtin_amdgcn_s_setprio(1); _Pragma("unroll") for (int m = 0; m < 4; ++m) _Pragma("unroll") for (int n = 0; n < 2; ++n) _Pragma("unroll") for (int k = 0; k < 2; ++k) \
        acc[ai][bj][m][n] = __builtin_amdgcn_mfma_f32_16x16x32_bf16(Bt[n][k], At[m][k], acc[ai][bj][m][n], 0, 0, 0); __builtin_amdgcn_s_setprio(0); } while (0)
#define PG8_WAIT_V(n) asm volatile("s_waitcnt vmcnt(" #n ")" ::: "memory")
#define PG8_WAIT_L(n) asm volatile("s_waitcnt lgkmcnt(" #n ")" ::: "memory")
#define PG8_BAR __builtin_amdgcn_s_barrier()
#define PG8_SCHED __builtin_amdgcn_sched_barrier(0)
    Unit cur, nxt; int ui = 0;
    if (!S.next(0, cur)) return;
    f32x4 acc[2][2][4][2];
#pragma unroll
    for (int a = 0; a < 2; ++a)
#pragma unroll
        for (int b = 0; b < 2; ++b)
#pragma unroll
            for (int m = 0; m < 4; ++m)
#pragma unroll
                for (int n = 0; n < 2; ++n) acc[a][b][m][n] = (f32x4){0.f, 0.f, 0.f, 0.f};
    bf16x8 At[4][2], B0[2][2], B1[2][2];
    const char* cA = (const char*)g.A + (size_t)cur.pm * tstep; const char* cB = (const char*)g.Bt + (size_t)cur.pn * tstep;
    S.a_ready(cur);
    if constexpr (SP2) {
        PG8_STAGE(PG8_SB(0, 0), cB, voffB); PG8_STAGE(PG8_SB(0, 1), cB + hstep, voffB); PG8_STAGE(PG8_SA(0, 0), cA, voffA); PG8_STAGE(PG8_SA(0, 1), cA + hstep, voffA);
        if (wr == 1) PG8_BAR;
        PG8_WAIT_V(2); PG8_BAR;
        PG8_STAGE(PG8_SB(1, 0), cB + kstep, voffB); PG8_STAGE(PG8_SA(1, 0), cA + kstep, voffA); PG8_STAGE(PG8_SB(1, 1), cB + hstep + kstep, voffB);
        PG8_WAIT_V(6); PG8_BAR;
    } else {
        PG8_STAGE(PG8_SB(0, 0), cB, voffB); PG8_STAGE(PG8_SA(0, 0), cA, voffA); PG8_STAGE(PG8_SB(0, 1), cB + hstep, voffB); PG8_STAGE(PG8_SA(0, 1), cA + hstep, voffA);
        if (wr == 1) PG8_BAR;
        PG8_WAIT_V(4); PG8_BAR;
        PG8_STAGE(PG8_SB(1, 0), cB + kstep, voffB); PG8_STAGE(PG8_SA(1, 0), cA + kstep, voffA); PG8_STAGE(PG8_SB(1, 1), cB + hstep + kstep, voffB);
        PG8_WAIT_V(6); PG8_BAR;
    }
    for (;;) {
        const bool has_next = S.next(ui + 1, nxt);
        const char* nA = has_next ? (const char*)g.A + (size_t)nxt.pm * tstep : cA; const char* nB = has_next ? (const char*)g.Bt + (size_t)nxt.pn * tstep : cB;
        for (int t = 0; t < nt; t += 2) {
            const bool last = (t == nt - 2);
            const char* a1 = cA + (size_t)(t + 1) * kstep;
            const char* a2 = last ? nA : cA + (size_t)(t + 2) * kstep; const char* b2 = last ? nB : cB + (size_t)(t + 2) * kstep;
            const char* a3 = a2 + kstep; const char* b3 = b2 + kstep;
            if (last && has_next) S.a_ready(nxt);
            if constexpr (SP2) {
            PG8_LDB(B0, 0, 0); PG8_LDB(B1, 0, 1); PG8_SCHED; PG8_LDA(At, 0, 0); PG8_STAGE(PG8_SA(1, 1), a1 + hstep, voffA);
            PG8_WAIT_V(8); PG8_WAIT_L(0); PG8_BAR; PG8_MMA(0, 0, At, B0); PG8_MMA(0, 1, At, B1); PG8_BAR; PG8_SCHED;
            PG8_LDA(At, 0, 1); PG8_STAGE(PG8_SB(0, 0), b2, voffB); PG8_STAGE(PG8_SB(0, 1), b2 + hstep, voffB); PG8_STAGE(PG8_SA(0, 0), a2, voffA);
            PG8_WAIT_V(8); PG8_WAIT_L(0); PG8_BAR; PG8_MMA(1, 0, At, B0); PG8_MMA(1, 1, At, B1); PG8_BAR; PG8_SCHED;
            PG8_LDB(B0, 1, 0); PG8_LDB(B1, 1, 1); PG8_SCHED; PG8_LDA(At, 1, 0); PG8_STAGE(PG8_SA(0, 1), a2 + hstep, voffA);
            PG8_WAIT_V(8); PG8_WAIT_L(0); PG8_BAR; PG8_MMA(0, 0, At, B0); PG8_MMA(0, 1, At, B1); PG8_BAR; PG8_SCHED;
            PG8_LDA(At, 1, 1); PG8_STAGE(PG8_SB(1, 0), b3, voffB); PG8_STAGE(PG8_SB(1, 1), b3 + hstep, voffB); PG8_STAGE(PG8_SA(1, 0), a3, voffA);
            PG8_WAIT_V(8); PG8_WAIT_L(0); PG8_BAR; PG8_MMA(1, 0, At, B0); PG8_MMA(1, 1, At, B1); PG8_BAR; PG8_SCHED;
            } else {
            PG8_LDB(B0, 0, 0); PG8_SCHED; PG8_LDA(At, 0, 0); PG8_STAGE(PG8_SA(1, 1), a1 + hstep, voffA);
            PG8_WAIT_L(8); PG8_BAR; PG8_WAIT_L(0); PG8_MMA(0, 0, At, B0); PG8_BAR; PG8_SCHED;
            PG8_LDB(B1, 0, 1); PG8_STAGE(PG8_SB(0, 0), b2, voffB);
            PG8_BAR; PG8_WAIT_L(0); PG8_MMA(0, 1, At, B1); PG8_BAR;
            PG8_LDA(At, 0, 1); PG8_STAGE(PG8_SA(0, 0), a2, voffA);
            PG8_BAR; PG8_WAIT_L(0); PG8_MMA(1, 0, At, B0); PG8_BAR; PG8_SCHED;
            PG8_STAGE(PG8_SB(0, 1), b2 + hstep, voffB);
            PG8_WAIT_V(6); PG8_BAR; PG8_MMA(1, 1, At, B1); PG8_BAR;
            PG8_LDB(B0, 1, 0); PG8_SCHED; PG8_LDA(At, 1, 0); PG8_STAGE(PG8_SA(0, 1), a2 + hstep, voffA);
            PG8_WAIT_L(8); PG8_BAR; PG8_WAIT_L(0); PG8_MMA(0, 0, At, B0); PG8_BAR; PG8_SCHED;
            PG8_LDB(B1, 1, 1); PG8_STAGE(PG8_SB(1, 0), b3, voffB);
            PG8_BAR; PG8_WAIT_L(0); PG8_MMA(0, 1, At, B1); PG8_BAR;
            PG8_LDA(At, 1, 1); PG8_STAGE(PG8_SA(1, 0), a3, voffA);
            PG8_BAR; PG8_WAIT_L(0); PG8_MMA(1, 0, At, B0); PG8_BAR; PG8_SCHED;
            PG8_STAGE(PG8_SB(1, 1), b3 + hstep, voffB);
            PG8_WAIT_V(6); PG8_BAR; PG8_MMA(1, 1, At, B1); PG8_BAR;
            }
        }
        if constexpr (ALIGN_EPI) { if (wr == 0) PG8_BAR; }
        if constexpr (!Epi::AFTER_DRAIN) { E(acc, cur, wr, wc, fr, fq); S.done(cur); }
        if (!has_next) break;
#pragma unroll
        for (int a = 0; a < 2; ++a)
#pragma unroll
            for (int b = 0; b < 2; ++b)
#pragma unroll
                for (int m = 0; m < 4; ++m)
#pragma unroll
                    for (int n = 0; n < 2; ++n) acc[a][b][m][n] = (f32x4){0.f, 0.f, 0.f, 0.f};
        cur = nxt; cA = nA; cB = nB; ++ui;
        if constexpr (ALIGN_EPI) { if (wr == 1) PG8_BAR; }
    }
    PG8_WAIT_V(0);
    if constexpr (!ALIGN_EPI) { if (wr == 0) PG8_BAR; }
    PG8_BAR;
#undef PG8_SA
#undef PG8_SB
#undef PG8_STAGE
#undef PG8_LDA
#undef PG8_LDB
#undef PG8_MMA
#undef PG8_WAIT_V
#undef PG8_WAIT_L
#undef PG8_BAR
#undef PG8_SCHED
}
}

struct Args {
    const float* x; const float* norm_g; const float* w_in; const float* qa_g; const float* w_uq; const float* kva_g; const float* w_ukv;
    const float* dlam; const float* subg; const float* conv_w; const float* w_out; const float* rel_bias; const float* final_g;
    float* out; unsigned char* ws;
    float lambda_init[2]; int pad[2];
};

typedef const __attribute__((address_space(4))) Args* ArgsP;
__device__ __forceinline__ ArgsP get_args() { ArgsP p = (ArgsP)__builtin_amdgcn_kernarg_segment_ptr(); asm volatile("" : "+s"(p)); return p; }

#define XB_TMO      128
#define XB_XCNT(j)  (256  + 64 * (j))
#define XB_XSUB(j)  (1280 + 64 * (j))
#define XB_XGEN(j)  (2304 + 64 * (j))
#define XB_TOP      3328
#define XB_TOPGEN   3392
#define XCD_BAR_WORDS 3456
#define XB_SPIN_CAP (1u << 18)
constexpr int LDS_XB = 148464;
__device__ __forceinline__ unsigned xb_ld(unsigned* p)              { return __hip_atomic_load(p, __ATOMIC_RELAXED, __HIP_MEMORY_SCOPE_AGENT); }
__device__ __forceinline__ unsigned xb_add(unsigned* p, unsigned v) { return __hip_atomic_fetch_add(p, v, __ATOMIC_RELAXED, __HIP_MEMORY_SCOPE_AGENT); }
__device__ __forceinline__ unsigned xb_xcc_id() { return (unsigned)__builtin_amdgcn_s_getreg((3 << 11) | 20) & 0xFu; }
#define XB_SPIN(cond, bar) do { unsigned _sp = 0; while (cond) { __builtin_amdgcn_s_sleep(1); \
    if ((++_sp & 255u) == 0u) { if (xb_ld(&(bar)[XB_TMO])) break; if (_sp > XB_SPIN_CAP) { atomicAdd(&(bar)[XB_TMO], 1u); break; } } } } while (0)
__device__ __forceinline__ void xcd_barrier_complete(unsigned* bar, unsigned x, unsigned& nloc, unsigned& nx) {
    const unsigned G = gridDim.x * gridDim.y * gridDim.z;
    unsigned sum, cnt, mine, sp = 0u;
    for (;;) {
        sum = 0u; cnt = 0u; mine = 0u;
#pragma unroll
        for (unsigned j = 0; j < 16; ++j) { const unsigned c = xb_ld(&bar[XB_XCNT(j)]); sum += c; cnt += (c > 0u) ? 1u : 0u; mine = (j == x) ? c : mine; }
        if (sum == G) break;
        __builtin_amdgcn_s_sleep(1);
        if ((++sp & 255u) == 0u) { if (xb_ld(&bar[XB_TMO])) break; if (sp > XB_SPIN_CAP) { atomicAdd(&bar[XB_TMO], 1u); break; } }
    }
    nloc = mine > 0u ? mine : 1u; nx = cnt > 0u ? cnt : 1u;
}
__device__ __forceinline__ void xcd_barrier_post(LAS unsigned char* lds) {
    ArgsP A = get_args(); unsigned* bar = (unsigned*)A->ws;
    if (threadIdx.x == 0) { ((volatile LAS unsigned*)(lds + LDS_XB))[0] = 0u; ((volatile LAS unsigned*)(lds + LDS_XB))[1] = 0u;
        (void)xb_add(&bar[XB_XCNT(xb_xcc_id())], 1u); }
    __syncthreads();
}
__device__ __forceinline__ void xcd_barrier(LAS unsigned char* lds) {
    ArgsP A = get_args(); unsigned* bar = (unsigned*)A->ws;
    asm volatile("s_waitcnt vmcnt(0)" ::: "memory");
    __syncthreads();
    if (threadIdx.x == 0) {
        const unsigned x = xb_xcc_id();
        volatile LAS unsigned* st = (volatile LAS unsigned*)(lds + LDS_XB);
        __builtin_amdgcn_s_waitcnt(0);
        unsigned nloc = st[0], nx = st[1];
        if (nloc == 0u) { xcd_barrier_complete(bar, x, nloc, nx); st[0] = nloc; st[1] = nx; }
        const unsigned old = xb_add(&bar[XB_XSUB(x)], 1u);
        const unsigned gen = old / nloc;
        if (old + 1u == (gen + 1u) * nloc) {
            __builtin_amdgcn_fence(__ATOMIC_RELEASE, "agent");
            asm volatile("s_waitcnt vmcnt(0)" ::: "memory");
            const unsigned og = xb_add(&bar[XB_TOP], 1u);
            const unsigned tg = og / nx;
            if (og + 1u == (tg + 1u) * nx) xb_add(&bar[XB_TOPGEN], 1u);
            else XB_SPIN(xb_ld(&bar[XB_TOPGEN]) == tg, bar);
            __builtin_amdgcn_fence(__ATOMIC_ACQUIRE, "agent");
            xb_add(&bar[XB_XGEN(x)], 1u);
            asm volatile("s_waitcnt vmcnt(0)" ::: "memory");
        } else {
            XB_SPIN(xb_ld(&bar[XB_XGEN(x)]) == gen, bar);
            __builtin_amdgcn_fence(__ATOMIC_ACQUIRE, "agent");
            asm volatile("s_waitcnt vmcnt(0)" ::: "memory");
        }
    }
    __syncthreads();
}

constexpr float QS_MLA = 0.10206207261596575f * 1.4426950408889634f;
constexpr float QS_DIFF = 0.17677669529663687f * 1.4426950408889634f;
constexpr float QS_DSA = 0.125f * 1.4426950408889634f;
template <bool OUT_BF16>
__device__ __forceinline__ void rms_rows4(const float* xbase, size_t rstride, const float* g, bf16_t* obase, float* fbase, int lane) {
    f32x4 v[4][4]; float ss[4];
#pragma unroll
    for (int k = 0; k < 4; ++k) { const f32x4* xr = (const f32x4*)(xbase + k * rstride) + lane;
#pragma unroll
        for (int j = 0; j < 4; ++j) v[k][j] = xr[64 * j]; }
#pragma unroll
    for (int k = 0; k < 4; ++k) { float s = 0.f;
#pragma unroll
        for (int j = 0; j < 4; ++j) s += v[k][j].x * v[k][j].x + v[k][j].y * v[k][j].y + v[k][j].z * v[k][j].z + v[k][j].w * v[k][j].w;
        ss[k] = s; }
#pragma unroll
    for (int o = 1; o < 64; o <<= 1) {
#pragma unroll
        for (int k = 0; k < 4; ++k) ss[k] += __shfl_xor(ss[k], o); }
    f32x4 gv[4];
#pragma unroll
    for (int j = 0; j < 4; ++j) gv[j] = ((const f32x4*)g)[lane + 64 * j];
#pragma unroll
    for (int k = 0; k < 4; ++k) { const float r = rsqrtf(ss[k] * (1.f / D) + EPS);
#pragma unroll
        for (int j = 0; j < 4; ++j) {
            const f32x4 o = (f32x4){v[k][j].x * r * gv[j].x, v[k][j].y * r * gv[j].y, v[k][j].z * r * gv[j].z, v[k][j].w * r * gv[j].w};
            if (OUT_BF16) { u32x2 w; w.x = pg8::cvt_pk_bf16(o.x, o.y); w.y = pg8::cvt_pk_bf16(o.z, o.w); ((u32x2*)(obase + k * rstride))[lane + 64 * j] = w; }
            else ((f32x4*)(fbase + k * rstride))[lane + 64 * j] = o;
        } }
}
template <bool OUT_BF16>
__device__ __forceinline__ void rms_rows4b(const bf16_t* xbase, size_t rstride, const float* g, bf16_t* obase, float* fbase, int lane) {
    u16x8 v[4][2]; float ss[4];
#pragma unroll
    for (int k = 0; k < 4; ++k) { const u16x8* xr = (const u16x8*)(xbase + k * rstride) + lane;
#pragma unroll
        for (int j = 0; j < 2; ++j) v[k][j] = xr[64 * j]; }
#pragma unroll
    for (int k = 0; k < 4; ++k) { float s = 0.f;
#pragma unroll
        for (int j = 0; j < 2; ++j)
#pragma unroll
            for (int e = 0; e < 8; ++e) { const float f = bf2f(v[k][j][e]); s += f * f; }
        ss[k] = s; }
#pragma unroll
    for (int o = 1; o < 64; o <<= 1) {
#pragma unroll
        for (int k = 0; k < 4; ++k) ss[k] += __shfl_xor(ss[k], o); }
    f32x4 gv[2][2];
#pragma unroll
    for (int j = 0; j < 2; ++j) { gv[j][0] = ((const f32x4*)g)[2 * lane + 128 * j]; gv[j][1] = ((const f32x4*)g)[2 * lane + 1 + 128 * j]; }
#pragma unroll
    for (int k = 0; k < 4; ++k) { const float r = rsqrtf(ss[k] * (1.f / D) + EPS);
#pragma unroll
        for (int j = 0; j < 2; ++j) {
            f32x4 o0, o1;
#pragma unroll
            for (int e = 0; e < 4; ++e) { o0[e] = bf2f(v[k][j][e]) * r * gv[j][0][e]; o1[e] = bf2f(v[k][j][4 + e]) * r * gv[j][1][e]; }
            if (OUT_BF16) { u32x4 w; w.x = pg8::cvt_pk_bf16(o0[0], o0[1]); w.y = pg8::cvt_pk_bf16(o0[2], o0[3]); w.z = pg8::cvt_pk_bf16(o1[0], o1[1]); w.w = pg8::cvt_pk_bf16(o1[2], o1[3]);
                ((u32x4*)(obase + k * rstride))[lane + 64 * j] = w; }
            else { ((f32x4*)(fbase + k * rstride))[2 * lane + 128 * j] = o0; ((f32x4*)(fbase + k * rstride))[2 * lane + 1 + 128 * j] = o1; }
        } }
}
__device__ __forceinline__ void convert_tile(LAS float* scr, const float* W, bf16_t* Wt, int K, int Nsrc, int remap, float uscale, int k0, int n0, int tid) {
    __syncthreads();
#pragma unroll
    for (int i = 0; i < 8; ++i) { const int e = tid + 512 * i, kk = e >> 6, nn = e & 63, n = n0 + nn;
        const int sc = remap ? orig_col(n) : n;
        float s = uscale;
        if (remap) { if (n >= CB_Q && n < CB_Q + 256) s = QS_DIFF; if (n >= CC_Q && n < CC_Q + 256) s = QS_DSA; }
        scr[kk * 65 + nn] = (sc >= 0) ? W[(size_t)(k0 + kk) * Nsrc + sc] * s : 0.f; }
    __syncthreads();
    { const int nn = tid >> 3, kc = (tid & 7) * 8;
        u32x4 w; w.x = pg8::cvt_pk_bf16(scr[(kc + 0) * 65 + nn], scr[(kc + 1) * 65 + nn]); w.y = pg8::cvt_pk_bf16(scr[(kc + 2) * 65 + nn], scr[(kc + 3) * 65 + nn]);
        w.z = pg8::cvt_pk_bf16(scr[(kc + 4) * 65 + nn], scr[(kc + 5) * 65 + nn]); w.w = pg8::cvt_pk_bf16(scr[(kc + 6) * 65 + nn], scr[(kc + 7) * 65 + nn]);
        *(u32x4*)(Wt + (size_t)(n0 + nn) * K + k0 + kc) = w; }
}
namespace fa {
typedef short ps16x2 __attribute__((ext_vector_type(2)));
typedef unsigned short pu16x2 __attribute__((ext_vector_type(2)));
__device__ __forceinline__ unsigned ppk_lt(unsigned v, unsigned c) { const ps16x2 d = __builtin_elementwise_sub_sat(__builtin_bit_cast(ps16x2, v), __builtin_bit_cast(ps16x2, c)); return __builtin_bit_cast(unsigned, __builtin_bit_cast(pu16x2, d) >> 15); }
__device__ __forceinline__ unsigned ppk_add(unsigned a, unsigned b) { return __builtin_bit_cast(unsigned, __builtin_bit_cast(pu16x2, a) + __builtin_bit_cast(pu16x2, b)); }
typedef float f32x16 __attribute__((ext_vector_type(16)));
typedef short s16x4 __attribute__((ext_vector_type(4)));
typedef short v4i16_t __attribute__((ext_vector_type(4)));
constexpr int KCS = 1040;
constexpr int KBUF = 12 * KCS + 64;
constexpr int L_K0 = 0, L_V0 = 4 * KBUF, L_WSF = L_V0 + 4 * 8192, L_BIAS = L_WSF + 8 * 256, L_END = L_BIAS + 12 * 320 * 4, L_FLAG = L_END;
constexpr float THR = 6.0f;
constexpr float LOG2E = 1.4426950408889634f;
__device__ __forceinline__ int crow(int r, int hi) { return (r & 3) + 8 * (r >> 2) + 4 * hi; }
__device__ __forceinline__ unsigned cvtpk(float lo, float hi) { typedef float f2 __attribute__((ext_vector_type(2))); typedef __bf16 b2 __attribute__((ext_vector_type(2)));
    f2 v = {lo, hi}; b2 r = __builtin_convertvector(v, b2); return __builtin_bit_cast(unsigned, r); }
__device__ __forceinline__ s16x4 vtr(const LAS unsigned char* p) { return __builtin_bit_cast(s16x4, __builtin_amdgcn_ds_read_tr16_b64_v4i16((LAS v4i16_t*)p)); }
__device__ __forceinline__ float max3f(float a, float b, float c) { float r; asm("v_max3_f32 %0, %1, %2, %3" : "=v"(r) : "v"(a), "v"(b), "v"(c)); return r; }
__device__ __forceinline__ float max2f(float a, float b) { float r; asm("v_max_f32_e32 %0, %1, %2" : "=v"(r) : "v"(a), "v"(b)); return r; }
#define FA_ROWMAX(rm, S0, S1) do { asm volatile("s_nop 15\n\ts_nop 7" : "+v"(S0), "+v"(S1)); \
        float a_ = max3f(S0[0], S0[1], S1[0]), b_ = max3f(S0[2], S0[3], S1[1]); a_ = max3f(a_, S1[2], S1[3]); \
        _Pragma("unroll") for (int r = 4; r < 16; r += 4) { a_ = max3f(a_, S0[r], S0[r + 1]); b_ = max3f(b_, S0[r + 2], S0[r + 3]); a_ = max3f(a_, S1[r], S1[r + 1]); b_ = max3f(b_, S1[r + 2], S1[r + 3]); } \
        rm = max2f(a_, b_); } while (0)
__device__ __forceinline__ float xhalf_max(float v) { auto rr = __builtin_amdgcn_permlane32_swap(__float_as_uint(v), __float_as_uint(v), false, false); return fmaxf(__uint_as_float(rr[0]), __uint_as_float(rr[1])); }
__device__ __forceinline__ float xhalf_sum(float v) { auto rr = __builtin_amdgcn_permlane32_swap(__float_as_uint(v), __float_as_uint(v), false, false); return __uint_as_float(rr[0]) + __uint_as_float(rr[1]); }

__device__ __forceinline__ void build_bias(LAS unsigned char* lds, const float* rel_bias) {
    LAS float* bt = (LAS float*)(lds + L_BIAS);
    for (int e = opaque_tid(); e < 12 * 320; e += NTHR) { const int col = e / 320, i = e % 320;
        bt[e] = (rel_bias[rel_bucket(i - 256) * 12 + col] - rel_bias[15 * 12 + col]) * LOG2E; }
}

template <int TYPE>
__device__ __forceinline__ void attn_unit(LAS unsigned char* lds, int b, int h, int qb, int layer) {
    ArgsP A = get_args();
    unsigned char* ws = A->ws;
    const bf16_t* P = (const bf16_t*)(ws + WS_P);
    const int tid = opaque_tid(), lane = tid & 63, r32 = lane & 31, hi = lane >> 5, wid = __builtin_amdgcn_readfirstlane(tid >> 6);
    constexpr int DK = (TYPE == 0) ? 96 : 64, NCH = DK / 8, NPASS = (TYPE == 1) ? 2 : 1, DQ = (TYPE == 0) ? 96 : (TYPE == 1) ? 32 : 64, NQF = DQ / 16;
    const size_t row0 = (size_t)b * S;
    const bf16_t* Kg; const bf16_t* Vg; int kpitch, vpitch;
    if (TYPE == 0) { Kg = (const bf16_t*)(ws + WS_KA) + row0 * 384 + h * 96; kpitch = 384; Vg = (const bf16_t*)(ws + WS_VA) + row0 * 256 + h * 64; vpitch = 256; }
    else { Kg = P + row0 * PC + ((TYPE == 1) ? CB_K : CC_K) + h * 64; kpitch = PC; Vg = P + row0 * PC + ((TYPE == 1) ? CB_V : CC_V) + h * 64; vpitch = PC; }
    const int k0key = tid / NCH, k0ch = tid % NCH;
    const int k1key = (tid + 512) / NCH, k1ch = (tid + 512) % NCH;
    const bool has_k1 = (NCH == 12) && (tid < 256);
    const int vkey = tid >> 3, vc8 = tid & 7;
    const bf16_t* kg0 = Kg + (size_t)k0key * kpitch + k0ch * 8;
    const bf16_t* kg1 = Kg + (size_t)k1key * kpitch + k1ch * 8;
    const bf16_t* vg0 = Vg + (size_t)vkey * vpitch + vc8 * 8;
    const int kl0 = k0ch * KCS + k0key * 16, kl1 = k1ch * KCS + k1key * 16;
    const int vl0 = ((vc8 >> 2) * 4 + (vkey >> 4)) * 1024 + (vkey & 15) * 64 + (vc8 & 3) * 16;
    const int qw = qb * 256 + wid * 32;
    const size_t tq = row0 + qw + r32;
    const int NT = 4 * qb + 4, NTw = 4 * qb + (wid >> 1) + 1, TM = 4 * qb;
    LAS float* wsf = (LAS float*)(lds + L_WSF) + wid * 64;
    const LAS unsigned char* vfb = lds + L_V0 + ((lane >> 4) & 1) * 32 + (lane & 3) * 8 + (4 * hi + ((lane & 15) >> 2)) * 64;
    const unsigned* mrow = (const unsigned*)(ws + WS_MASK) + tq * 128;
    float* okl = (float*)(ws + WS_OKL) + ((size_t)opaque_bid() * 8 + wid) * 2048 + lane;
    f32x16 o0 = f32x16{}, o1 = f32x16{};
    float mhat = 0.f, lsum = 0.f;
    int fast = 1; asm volatile("" : "+s"(fast));
#pragma unroll 1
    for (;;) {
#pragma unroll 1
    for (int mp = 0; mp < NPASS; ++mp) {
    bf16x8 qf[NQF];
#pragma unroll
    for (int d0 = 0; d0 < NQF; ++d0) {
        const bf16_t* qp = (TYPE == 0) ? (const bf16_t*)(ws + WS_QA) + tq * 384 + h * 96 + 16 * d0 + 8 * hi
                                       : P + tq * PC + ((TYPE == 1) ? CB_Q + mp * 32 : CC_Q) + h * 64 + 16 * d0 + 8 * hi;
        qf[d0] = *(const bf16x8*)qp;
    }
    mhat = 0.f; lsum = 0.f; o0 = f32x16{}; o1 = f32x16{};
    const LAS unsigned char* kfb = lds + L_K0 + hi * KCS + r32 * 16 + ((TYPE == 1) ? mp * 4 * KCS : 0);
    const LAS unsigned char* btb = lds + L_BIAS + (256 + 4 * hi - r32 - qw) * 4 + ((TYPE == 1) ? 2 * h + mp : 8 + h) * 1280;
    u32x4 kr0, kr1, vr;
    const bf16_t* kp0 = kg0; const bf16_t* kp1 = kg1; const bf16_t* vp0 = vg0;
    const size_t kstep = (size_t)64 * kpitch, vstep = (size_t)64 * vpitch;
#define FA_BIAS(S0, S1, t) do { if (TYPE != 0) { if (64 * (t) > qw - 154) { const LAS float* bt = (const LAS float*)(btb + (t) * 256); \
            _Pragma("unroll") for (int r = 0; r < 16; ++r) { S0[r] += bt[(r & 3) + 8 * (r >> 2)]; S1[r] += bt[32 + (r & 3) + 8 * (r >> 2)]; } } } } while (0)
#define FA_RESCALE(S0, S1, t) do { if (fast) break; \
        float rm; FA_ROWMAX(rm, S0, S1); \
        rm = xhalf_max(rm); \
        const bool first = ((t) == 0); \
        if (__any(first || rm > THR)) { \
            const float dl = first ? fmaxf(rm, -64.f) : fmaxf(rm, 0.f);     \
            mhat += dl; \
            _Pragma("unroll") for (int r = 0; r < 16; ++r) { S0[r] -= dl; S1[r] -= dl; } \
            if (!first) { const float f = __builtin_amdgcn_exp2f(-dl); lsum *= f; \
                if (hi == 0) wsf[r32] = f; \
                _Pragma("unroll") for (int r = 0; r < 16; ++r) { const float fr_ = wsf[crow(r, hi)]; o0[r] *= fr_; o1[r] *= fr_; } \
                asm volatile("" ::: "memory"); } \
        } } while (0)
#define FA_EXP(S0, S1) do { float sacc = 0.f; \
        _Pragma("unroll") for (int r = 0; r < 16; ++r) { \
            S0[r] = __builtin_amdgcn_exp2f(S0[r]); S1[r] = __builtin_amdgcn_exp2f(S1[r]); \
            sacc += S0[r] + S1[r]; } \
        lsum += sacc; \
        _Pragma("unroll") for (int i = 0; i < 4; ++i) { pw[0][i] = cvtpk(S0[2 * i], S0[2 * i + 1]); pw[1][i] = cvtpk(S0[8 + 2 * i], S0[8 + 2 * i + 1]); \
                                                       pw[2][i] = cvtpk(S1[2 * i], S1[2 * i + 1]); pw[3][i] = cvtpk(S1[8 + 2 * i], S1[8 + 2 * i + 1]); } } while (0)
#define FA_PV() do { \
        _Pragma("unroll") for (int ks = 0; ks < 4; ++ks) { const bf16x8 vfrag = (bf16x8){vlo_[ks][0], vlo_[ks][1], vlo_[ks][2], vlo_[ks][3], vhi_[ks][0], vhi_[ks][1], vhi_[ks][2], vhi_[ks][3]}; \
            o0 = __builtin_amdgcn_mfma_f32_32x32x16_bf16(__builtin_bit_cast(bf16x8, pw[ks]), vfrag, o0, 0, 0, 0); } \
        _Pragma("unroll") for (int i = 0; i < 4; ++i) { vlo_[i] = vtr(vb_ + (4 + i) * 1024); vhi_[i] = vtr(vb_ + (4 + i) * 1024 + 512); } \
        _Pragma("unroll") for (int ks = 0; ks < 4; ++ks) { const bf16x8 vfrag = (bf16x8){vlo_[ks][0], vlo_[ks][1], vlo_[ks][2], vlo_[ks][3], vhi_[ks][0], vhi_[ks][1], vhi_[ks][2], vhi_[ks][3]}; \
            o1 = __builtin_amdgcn_mfma_f32_32x32x16_bf16(__builtin_bit_cast(bf16x8, pw[ks]), vfrag, o1, 0, 0, 0); } } while (0)
#define FA_KLOAD(ks_off) do { const LAS unsigned char* kb_ = kfb + (ks_off); \
        _Pragma("unroll") for (int d0 = 0; d0 < NQF; ++d0) { ka_[d0][0] = *(const LAS bf16x8*)(kb_ + d0 * 2 * KCS); ka_[d0][1] = *(const LAS bf16x8*)(kb_ + d0 * 2 * KCS + 512); } } while (0)
#define FA_QKMFMA(N0, N1, tt, MW0, MW1) do { \
        if (TYPE == 2) { const unsigned w0_ = MW0 >> (4 * hi), w1_ = MW1 >> (4 * hi); const unsigned nm_ = __float_as_uint(-mhat); unsigned neg_ = 0xF149F2CAu; asm volatile("" : "+v"(neg_)); \
            _Pragma("unroll") for (int r = 0; r < 16; ++r) { const int pos_ = (r & 3) + 8 * (r >> 2); \
                const unsigned k0m = (unsigned)((int)(w0_ << (31 - pos_)) >> 31), k1m = (unsigned)((int)(w1_ << (31 - pos_)) >> 31); \
                N0[r] = __uint_as_float(__builtin_amdgcn_bitop3_b32(k0m, nm_, neg_, 0xCA)); N1[r] = __uint_as_float(__builtin_amdgcn_bitop3_b32(k1m, nm_, neg_, 0xCA)); } }     \
        else if (fast) { N0 = __builtin_amdgcn_mfma_f32_32x32x16_bf16(ka_[0][0], qf[0], f32x16{}, 0, 0, 0); N1 = __builtin_amdgcn_mfma_f32_32x32x16_bf16(ka_[0][1], qf[0], f32x16{}, 0, 0, 0); } \
        else { const float nm_ = -mhat; N0 = (f32x16){nm_, nm_, nm_, nm_, nm_, nm_, nm_, nm_, nm_, nm_, nm_, nm_, nm_, nm_, nm_, nm_}; N1 = N0; \
            N0 = __builtin_amdgcn_mfma_f32_32x32x16_bf16(ka_[0][0], qf[0], N0, 0, 0, 0); N1 = __builtin_amdgcn_mfma_f32_32x32x16_bf16(ka_[0][1], qf[0], N1, 0, 0, 0); } \
        _Pragma("unroll") for (int d0 = (TYPE == 2) ? 0 : 1; d0 < NQF; ++d0) { \
            N0 = __builtin_amdgcn_mfma_f32_32x32x16_bf16(ka_[d0][0], qf[d0], N0, 0, 0, 0); \
            N1 = __builtin_amdgcn_mfma_f32_32x32x16_bf16(ka_[d0][1], qf[d0], N1, 0, 0, 0); } } while (0)
#define FA_VLOAD(vs_off) const LAS unsigned char* vb_ = vfb + (vs_off); \
        _Pragma("unroll") for (int i = 0; i < 4; ++i) { vlo_[i] = vtr(vb_ + i * 1024); vhi_[i] = vtr(vb_ + i * 1024 + 512); }
#define FA_MASKW(t)
#define FA_STEP_U(C0, C1, N0, N1, t, vs_off, nks_off, MW0, MW1) do { \
        bf16x8 ka_[NQF][2]; s16x4 vlo_[4], vhi_[4]; u32x4 pw[4]; \
        FA_KLOAD(nks_off); FA_VLOAD(vs_off); FA_MASKW(t); \
        FA_BIAS(C0, C1, t); FA_RESCALE(C0, C1, t); \
        FA_QKMFMA(N0, N1, (t) + 1, MW0, MW1); FA_EXP(C0, C1); FA_PV(); } while (0)
#define FA_STEP_C(C0, C1, N0, N1, t, vs_off, nks_off, MW0, MW1) do { \
        if ((t) + 1 < NTw) { bf16x8 ka_[NQF][2]; FA_KLOAD(nks_off); FA_QKMFMA(N0, N1, (t) + 1, MW0, MW1); } \
        if ((t) < NTw) { s16x4 vlo_[4], vhi_[4]; u32x4 pw[4]; FA_VLOAD(vs_off); FA_MASKW(t); \
            FA_BIAS(C0, C1, t); \
            if (!fast) { float rm; FA_ROWMAX(rm, C0, C1); \
              rm = xhalf_max(rm); \
              const bool first = ((t) == 0); \
              if (__any(first || rm > THR)) { \
                const float dl = first ? fmaxf(rm, -64.f) : fmaxf(rm, 0.f);     \
                mhat += dl; \
                _Pragma("unroll") for (int r = 0; r < 16; ++r) { C0[r] -= dl; C1[r] -= dl; N0[r] -= dl; N1[r] -= dl; } \
                if (!first) { const float f = __builtin_amdgcn_exp2f(-dl); lsum *= f; \
                    if (hi == 0) wsf[r32] = f; \
                    _Pragma("unroll") for (int r = 0; r < 16; ++r) { const float fr_ = wsf[crow(r, hi)]; o0[r] *= fr_; o1[r] *= fr_; } \
                    asm volatile("" ::: "memory"); } } } \
            FA_EXP(C0, C1); FA_PV(); } } while (0)
#define FA_LOADKV(tk, tv) do { if (FA_UNC || (tk) < NT) { kr0 = *(const u32x4*)kp0; if (has_k1) kr1 = *(const u32x4*)kp1; kp0 += kstep; kp1 += kstep; } \
        if (FA_UNC || (tv) < NT) { vr = *(const u32x4*)vp0; vp0 += vstep; } } while (0)
#define FA_COMMIT(tk, kslot, tv, vslot) do { if (FA_UNC || (tk) < NT) { *(LAS u32x4*)(lds + L_K0 + (kslot) + kl0) = kr0; if (has_k1) *(LAS u32x4*)(lds + L_K0 + (kslot) + kl1) = kr1; } \
        if (FA_UNC || (tv) < NT) *(LAS u32x4*)(lds + L_V0 + (vslot) + vl0) = vr; } while (0)
#define FA_UNC 0
    {
        FA_LOADKV(0, 0);
        const u32x4 ka0 = kr0, ka1 = kr1, va = vr;
        FA_LOADKV(1, 1);
        const u32x4 kb0 = kr0, kb1 = kr1, vb = vr;
        FA_LOADKV(2, NT);
        __syncthreads();
        *(LAS u32x4*)(lds + L_K0 + kl0) = ka0; if (has_k1) *(LAS u32x4*)(lds + L_K0 + kl1) = ka1; *(LAS u32x4*)(lds + L_V0 + vl0) = va;
        *(LAS u32x4*)(lds + L_K0 + KBUF + kl0) = kb0; if (has_k1) *(LAS u32x4*)(lds + L_K0 + KBUF + kl1) = kb1; *(LAS u32x4*)(lds + L_V0 + 8192 + vl0) = vb;
        FA_COMMIT(2, 2 * KBUF, NT, 0);
        if (fast && mp == 0 && tid == 0) *(volatile LAS unsigned*)(lds + L_FLAG) = 0u;
    }
    __syncthreads();
    f32x16 sA0, sA1, sB0, sB1;
    unsigned mwA0 = 0u, mwA1 = 0u, mwB0 = 0u, mwB1 = 0u;
#define FA_MLOAD(W0, W1, tt) do { if (TYPE == 2 && (FA_UNC || (tt) < NT)) { W0 = mrow[2 * (tt)]; W1 = mrow[2 * (tt) + 1]; } } while (0)
    FA_MLOAD(mwA0, mwA1, 0); FA_MLOAD(mwB0, mwB1, 1);
    { bf16x8 ka_[NQF][2]; FA_KLOAD(0); FA_QKMFMA(sA0, sA1, 0, mwA0, mwA1); }
    __syncthreads();
#pragma unroll
    for (int r = 0; r < 16; ++r) { sB0[r] = 0.f; sB1[r] = 0.f; }
#define FA_KS(tt) ((((tt)) & 3) * KBUF)
#define FA_VS(tt) ((((tt)) & 3) * 8192)
    int t = 0;
#undef FA_UNC
#define FA_UNC 1
    for (; t < TM; t += 2) {
        FA_LOADKV(t + 3, t + 2); FA_MLOAD(mwA0, mwA1, t + 2);
        FA_STEP_U(sA0, sA1, sB0, sB1, t, FA_VS(t), FA_KS(t + 1), mwB0, mwB1);
        FA_COMMIT(t + 3, FA_KS(t + 3), t + 2, FA_VS(t + 2));
        FA_LOADKV(t + 4, t + 3); FA_MLOAD(mwB0, mwB1, t + 3);
        FA_STEP_U(sB0, sB1, sA0, sA1, t + 1, FA_VS(t + 1), FA_KS(t + 2), mwA0, mwA1);
        FA_COMMIT(t + 4, FA_KS(t + 4), t + 3, FA_VS(t + 3));
        __syncthreads();
    }
#undef FA_UNC
#define FA_UNC 0
    for (; t < NT; t += 2) {
        FA_LOADKV(t + 3, t + 2); FA_MLOAD(mwA0, mwA1, t + 2);
        FA_STEP_C(sA0, sA1, sB0, sB1, t, FA_VS(t), FA_KS(t + 1), mwB0, mwB1);
        FA_COMMIT(t + 3, FA_KS(t + 3), t + 2, FA_VS(t + 2));
        FA_LOADKV(t + 4, t + 3); FA_MLOAD(mwB0, mwB1, t + 3);
        FA_STEP_C(sB0, sB1, sA0, sA1, t + 1, FA_VS(t + 1), FA_KS(t + 2), mwA0, mwA1);
        FA_COMMIT(t + 4, FA_KS(t + 4), t + 3, FA_VS(t + 3));
        __syncthreads();
    }
#undef FA_KS
#undef FA_UNC
#undef FA_MLOAD
#undef FA_VS
#undef FA_BIAS
#undef FA_RESCALE
#undef FA_EXP
#undef FA_PV
#undef FA_KLOAD
#undef FA_QKMFMA
#undef FA_VLOAD
#undef FA_MASKW
#undef FA_STEP_U
#undef FA_STEP_C
#undef FA_LOADKV
#undef FA_COMMIT
    {
        const float lt = xhalf_sum(lsum);
        if (fast) { if (!(lt >= 0x1p-90f && lt <= 0x1p90f)) *(volatile LAS unsigned*)(lds + L_FLAG) = 1u; }
        if (hi == 0) wsf[32 + r32] = __builtin_amdgcn_rcpf(lt);
#pragma unroll
        for (int r = 0; r < 16; ++r) { const float iv = wsf[32 + crow(r, hi)]; o0[r] *= iv; o1[r] *= iv; }
        asm volatile("" ::: "memory");
    }
    if (TYPE == 1 && mp == 0) {
#pragma unroll
        for (int r = 0; r < 16; ++r) { okl[r * 64] = o0[r]; okl[(16 + r) * 64] = o1[r]; }
    }
    }
    if (!fast) break;
    __syncthreads();
    if (__builtin_amdgcn_readfirstlane(*(volatile LAS unsigned*)(lds + L_FLAG)) == 0u) break;
    fast = 0;
    }
    const int gcol = (TYPE == 0) ? CA_G : (TYPE == 1) ? CB_G : CC_G;
    bf16_t* Y = (bf16_t*)(ws + WS_Y);
    float gs0[16], gs1[16];
    {
        bf16_t gr0[16], gr1[16];
#pragma unroll
        for (int r = 0; r < 16; ++r) { const bf16_t* gp = P + (row0 + qw + crow(r, hi)) * PC + gcol + h * 64; gr0[r] = gp[r32]; gr1[r] = gp[32 + r32]; }
#pragma unroll
        for (int r = 0; r < 16; ++r) { const float a0 = bf2f(gr0[r]), a1 = bf2f(gr1[r]);
            gs0[r] = a0 * __builtin_amdgcn_rcpf(1.f + __expf(-a0)); gs1[r] = a1 * __builtin_amdgcn_rcpf(1.f + __expf(-a1)); }
    }
    if (TYPE == 1) {
        const float* lamp = A->dlam + layer * 128;
        float s1 = 0.f, s2 = 0.f;
        for (int i = 0; i < 32; ++i) { s1 += lamp[i] * lamp[32 + i]; s2 += lamp[64 + i] * lamp[96 + i]; }
        const float lambda_init = A->lambda_init[layer];
        const float lam = __expf(s1) - __expf(s2) + lambda_init;
        const float g0 = A->subg[layer * 64 + r32], g1 = A->subg[layer * 64 + 32 + r32];
#pragma unroll
        for (int r = 0; r < 16; ++r) {
            const float v0 = okl[r * 64] - lam * o0[r];
            const float v1 = okl[(16 + r) * 64] - lam * o1[r];
            float ss = v0 * v0 + v1 * v1;
#pragma unroll
            for (int off = 1; off < 32; off <<= 1) ss += __shfl_xor(ss, off);
            const float rr = rsqrtf(ss * (1.f / 64.f) + EPS) * (1.f - lambda_init);
            bf16_t* yp = Y + (row0 + qw + crow(r, hi)) * D + 256 + h * 64;
            yp[r32] = f2bf(v0 * rr * g0 * gs0[r]);
            yp[32 + r32] = f2bf(v1 * rr * g1 * gs1[r]);
        }
    } else {
#pragma unroll
        for (int r = 0; r < 16; ++r) {
            bf16_t* yp = Y + (row0 + qw + crow(r, hi)) * D + TYPE * 256 + h * 64;
            yp[r32] = f2bf(o0[r] * gs0[r]);
            yp[32 + r32] = f2bf(o1[r] * gs1[r]);
        }
    }
}
__device__ __forceinline__ void attn_unit_diff(LAS unsigned char* lds, int b, int h, int qb, int layer) {
    ArgsP A = get_args();
    unsigned char* ws = A->ws;
    const bf16_t* P = (const bf16_t*)(ws + WS_P);
    const int tid = opaque_tid(), lane = tid & 63, r32 = lane & 31, hi = lane >> 5, wid = __builtin_amdgcn_readfirstlane(tid >> 6);
    const size_t row0 = (size_t)b * S;
    const int skey = tid >> 3, sch = tid & 7;
    const bf16_t* kg0 = P + (row0 + skey) * PC + CB_K + h * 64 + sch * 8;
    const bf16_t* vg0 = P + (row0 + skey) * PC + CB_V + h * 64 + sch * 8;
    const int kl0 = sch * KCS + skey * 16;
    const int vl0 = ((sch >> 2) * 4 + (skey >> 4)) * 1024 + (skey & 15) * 64 + (sch & 3) * 16;
    const int qw = qb * 256 + wid * 32;
    const size_t tq = row0 + qw + r32;
    const int NT = 4 * qb + 4, NTw = 4 * qb + (wid >> 1) + 1, TM = 4 * qb;
    LAS float* wsf = (LAS float*)(lds + L_WSF) + wid * 64;
    const LAS unsigned char* vfb = lds + L_V0 + ((lane >> 4) & 1) * 32 + (lane & 3) * 8 + (4 * hi + ((lane & 15) >> 2)) * 64;
    const LAS unsigned char* kfA = lds + L_K0 + hi * KCS + r32 * 16;
    const LAS unsigned char* kfB = kfA + 4 * KCS;
    const LAS unsigned char* btA = lds + L_BIAS + (256 + 4 * hi - r32 - qw) * 4 + (2 * h) * 1280;
    const LAS unsigned char* btB = btA + 1280;
    bf16x8 qA[2], qB[2];
#pragma unroll
    for (int d0 = 0; d0 < 2; ++d0) { qA[d0] = *(const bf16x8*)(P + tq * PC + CB_Q + h * 64 + 16 * d0 + 8 * hi); qB[d0] = *(const bf16x8*)(P + tq * PC + CB_Q + 32 + h * 64 + 16 * d0 + 8 * hi); }
    f32x16 oA0, oA1, oB0, oB1;
    float mA, mB, lA, lB;
    const size_t tstep = (size_t)64 * PC;
    int fast = 1; asm volatile("" : "+s"(fast));
#define DF_KS(tt) ((((tt)) & 3) * KBUF)
#define DF_VS(tt) ((((tt)) & 3) * 8192)
#define DF_QK(N0, N1, KF, ks_off, QF, MH) do { const LAS unsigned char* kb_ = (KF) + (ks_off); \
        const bf16x8 k00 = *(const LAS bf16x8*)kb_, k01 = *(const LAS bf16x8*)(kb_ + 512), k10 = *(const LAS bf16x8*)(kb_ + 2 * KCS), k11 = *(const LAS bf16x8*)(kb_ + 2 * KCS + 512); \
        if (fast) { N0 = __builtin_amdgcn_mfma_f32_32x32x16_bf16(k00, QF[0], f32x16{}, 0, 0, 0); N1 = __builtin_amdgcn_mfma_f32_32x32x16_bf16(k01, QF[0], f32x16{}, 0, 0, 0); } \
        else { const float nm_ = -(MH); N0 = (f32x16){nm_, nm_, nm_, nm_, nm_, nm_, nm_, nm_, nm_, nm_, nm_, nm_, nm_, nm_, nm_, nm_}; N1 = N0; \
            N0 = __builtin_amdgcn_mfma_f32_32x32x16_bf16(k00, QF[0], N0, 0, 0, 0); N1 = __builtin_amdgcn_mfma_f32_32x32x16_bf16(k01, QF[0], N1, 0, 0, 0); } \
        N0 = __builtin_amdgcn_mfma_f32_32x32x16_bf16(k10, QF[1], N0, 0, 0, 0); N1 = __builtin_amdgcn_mfma_f32_32x32x16_bf16(k11, QF[1], N1, 0, 0, 0); } while (0)
#define DF_SOFTMAX(S0, S1, O0, O1, MH, LS, BT, WOFF, t, PW) do { \
        if (64 * (t) > qw - 154) { const LAS float* bt = (const LAS float*)((BT) + (t) * 256); \
            _Pragma("unroll") for (int r = 0; r < 16; ++r) { S0[r] += bt[(r & 3) + 8 * (r >> 2)]; S1[r] += bt[32 + (r & 3) + 8 * (r >> 2)]; } } \
        if (!fast) { float rm; FA_ROWMAX(rm, S0, S1); rm = xhalf_max(rm); const bool first = ((t) == 0); \
            if (__any(first || rm > THR)) { const float dl = first ? fmaxf(rm, -64.f) : fmaxf(rm, 0.f); MH += dl; \
                _Pragma("unroll") for (int r = 0; r < 16; ++r) { S0[r] -= dl; S1[r] -= dl; } \
                if (!first) { const float f = __builtin_amdgcn_exp2f(-dl); LS *= f; if (hi == 0) wsf[(WOFF) + r32] = f; \
                    _Pragma("unroll") for (int r = 0; r < 16; ++r) { const float fr_ = wsf[(WOFF) + crow(r, hi)]; O0[r] *= fr_; O1[r] *= fr_; } \
                    asm volatile("" ::: "memory"); } } } \
        { float sacc = 0.f; \
          _Pragma("unroll") for (int r = 0; r < 16; ++r) { S0[r] = __builtin_amdgcn_exp2f(S0[r]); S1[r] = __builtin_amdgcn_exp2f(S1[r]); sacc += S0[r] + S1[r]; } \
          LS += sacc; } \
        _Pragma("unroll") for (int i = 0; i < 4; ++i) { PW[0][i] = cvtpk(S0[2 * i], S0[2 * i + 1]); PW[1][i] = cvtpk(S0[8 + 2 * i], S0[8 + 2 * i + 1]); \
                                                       PW[2][i] = cvtpk(S1[2 * i], S1[2 * i + 1]); PW[3][i] = cvtpk(S1[8 + 2 * i], S1[8 + 2 * i + 1]); } } while (0)
#define DF_VLOAD(vs_off, G0) do { const LAS unsigned char* vb_ = vfb + (vs_off); \
        _Pragma("unroll") for (int i = 0; i < 4; ++i) { vlo_[i] = vtr(vb_ + ((G0) + i) * 1024); vhi_[i] = vtr(vb_ + ((G0) + i) * 1024 + 512); } } while (0)
#define DF_PV(O0, O1, PW, vs_off) do { \
        DF_VLOAD(vs_off, 0); \
        _Pragma("unroll") for (int ks = 0; ks < 4; ++ks) { const bf16x8 vf = (bf16x8){vlo_[ks][0], vlo_[ks][1], vlo_[ks][2], vlo_[ks][3], vhi_[ks][0], vhi_[ks][1], vhi_[ks][2], vhi_[ks][3]}; \
            O0 = __builtin_amdgcn_mfma_f32_32x32x16_bf16(__builtin_bit_cast(bf16x8, PW[ks]), vf, O0, 0, 0, 0); } \
        DF_VLOAD(vs_off, 4); \
        _Pragma("unroll") for (int ks = 0; ks < 4; ++ks) { const bf16x8 vf = (bf16x8){vlo_[ks][0], vlo_[ks][1], vlo_[ks][2], vlo_[ks][3], vhi_[ks][0], vhi_[ks][1], vhi_[ks][2], vhi_[ks][3]}; \
            O1 = __builtin_amdgcn_mfma_f32_32x32x16_bf16(__builtin_bit_cast(bf16x8, PW[ks]), vf, O1, 0, 0, 0); } } while (0)
#define DF_STEP(COND, t) do { \
        if (!(COND) || (t) + 2 < NT) { kr = *(const u32x4*)kp; kp += tstep; } \
        if (!(COND) || (t) + 1 < NT) { vr = *(const u32x4*)vp; vp += tstep; } \
        if (!(COND) || (t) < NTw) { s16x4 vlo_[4], vhi_[4]; u32x4 pw[4]; \
            DF_QK(sB0, sB1, kfB, DF_KS(t), qB, mB); \
            DF_SOFTMAX(sA0, sA1, oA0, oA1, mA, lA, btA, 0, t, pw); \
            DF_PV(oA0, oA1, pw, DF_VS(t)); \
            DF_SOFTMAX(sB0, sB1, oB0, oB1, mB, lB, btB, 32, t, pw); \
            if (!(COND) || (t) + 1 < NTw) DF_QK(sA0, sA1, kfA, DF_KS((t) + 1), qA, mA); \
            DF_PV(oB0, oB1, pw, DF_VS(t)); } \
        if (!(COND) || (t) + 2 < NT) *(LAS u32x4*)(lds + L_K0 + DF_KS((t) + 2) + kl0) = kr; \
        if (!(COND) || (t) + 1 < NT) *(LAS u32x4*)(lds + L_V0 + DF_VS((t) + 1) + vl0) = vr; \
        __syncthreads(); } while (0)
#pragma unroll 1
    for (;;) {
        mA = 0.f; mB = 0.f; lA = 0.f; lB = 0.f; oA0 = f32x16{}; oA1 = f32x16{}; oB0 = f32x16{}; oB1 = f32x16{};
        const bf16_t* kp = kg0; const bf16_t* vp = vg0;
        u32x4 kr, vr;
        {
            const u32x4 ka = *(const u32x4*)kp; kp += tstep; const u32x4 va = *(const u32x4*)vp; vp += tstep; const u32x4 kb = *(const u32x4*)kp; kp += tstep;
            __syncthreads();
            *(LAS u32x4*)(lds + L_K0 + kl0) = ka; *(LAS u32x4*)(lds + L_V0 + vl0) = va; *(LAS u32x4*)(lds + L_K0 + KBUF + kl0) = kb;
            if (fast && tid == 0) *(volatile LAS unsigned*)(lds + L_FLAG) = 0u;
        }
        __syncthreads();
        f32x16 sA0, sA1, sB0, sB1;
        DF_QK(sA0, sA1, kfA, 0, qA, mA);
#pragma unroll
        for (int r = 0; r < 16; ++r) { sB0[r] = 0.f; sB1[r] = 0.f; }
        int t = 0;
        _Pragma("unroll 1") for (; t < TM; ++t) { DF_STEP(false, t); }
        _Pragma("unroll 1") for (; t < NT; ++t) { DF_STEP(true, t); }
        {
            const float ltA = xhalf_sum(lA), ltB = xhalf_sum(lB);
            if (fast) { if (!(ltA >= 0x1p-90f && ltA <= 0x1p90f && ltB >= 0x1p-90f && ltB <= 0x1p90f)) *(volatile LAS unsigned*)(lds + L_FLAG) = 1u; }
            if (hi == 0) { wsf[r32] = __builtin_amdgcn_rcpf(ltA); wsf[32 + r32] = __builtin_amdgcn_rcpf(ltB); }
#pragma unroll
            for (int r = 0; r < 16; ++r) { const float ia = wsf[crow(r, hi)], ib = wsf[32 + crow(r, hi)]; oA0[r] *= ia; oA1[r] *= ia; oB0[r] *= ib; oB1[r] *= ib; }
            asm volatile("" ::: "memory");
        }
        if (!fast) break;
        __syncthreads();
        if (__builtin_amdgcn_readfirstlane(*(volatile LAS unsigned*)(lds + L_FLAG)) == 0u) break;
        fast = 0;
    }
#undef DF_STEP
#undef DF_PV
#undef DF_VLOAD
#undef DF_SOFTMAX
#undef DF_QK
#undef DF_KS
#undef DF_VS
    bf16_t* Y = (bf16_t*)(ws + WS_Y);
    float gs0[16], gs1[16];
    {
        bf16_t gr0[16], gr1[16];
#pragma unroll
        for (int r = 0; r < 16; ++r) { const bf16_t* gp = P + (row0 + qw + crow(r, hi)) * PC + CB_G + h * 64; gr0[r] = gp[r32]; gr1[r] = gp[32 + r32]; }
#pragma unroll
        for (int r = 0; r < 16; ++r) { const float a0 = bf2f(gr0[r]), a1 = bf2f(gr1[r]);
            gs0[r] = a0 * __builtin_amdgcn_rcpf(1.f + __expf(-a0)); gs1[r] = a1 * __builtin_amdgcn_rcpf(1.f + __expf(-a1)); }
    }
    {
        const float* lamp = A->dlam + layer * 128;
        float s1 = 0.f, s2 = 0.f;
        for (int i = 0; i < 32; ++i) { s1 += lamp[i] * lamp[32 + i]; s2 += lamp[64 + i] * lamp[96 + i]; }
        const float lambda_init = A->lambda_init[layer];
        const float lam = __expf(s1) - __expf(s2) + lambda_init;
        const float g0 = A->subg[layer * 64 + r32], g1 = A->subg[layer * 64 + 32 + r32];
#pragma unroll
        for (int r = 0; r < 16; ++r) {
            const float v0 = oA0[r] - lam * oB0[r];
            const float v1 = oA1[r] - lam * oB1[r];
            float ss = v0 * v0 + v1 * v1;
#pragma unroll
            for (int off = 1; off < 32; off <<= 1) ss += __shfl_xor(ss, off);
            const float rr = rsqrtf(ss * (1.f / 64.f) + EPS) * (1.f - lambda_init);
            bf16_t* yp = Y + (row0 + qw + crow(r, hi)) * D + 256 + h * 64;
            yp[r32] = f2bf(v0 * rr * g0 * gs0[r]);
            yp[32 + r32] = f2bf(v1 * rr * g1 * gs1[r]);
        }
    }
}
}

namespace sel {
__device__ __forceinline__ float relu_s(float x) { const int i = __builtin_bit_cast(int, x); return __builtin_bit_cast(float, i > 0 ? i : 0); }
}

namespace sel2 {
typedef float f32x16 __attribute__((ext_vector_type(16)));
typedef short s16x2 __attribute__((ext_vector_type(2)));
typedef unsigned short u16x2 __attribute__((ext_vector_type(2)));
__device__ __forceinline__ unsigned pk_lt(unsigned v, unsigned c) {
    const s16x2 d = __builtin_elementwise_sub_sat(__builtin_bit_cast(s16x2, v), __builtin_bit_cast(s16x2, c));
    return __builtin_bit_cast(unsigned, __builtin_bit_cast(u16x2, d) >> 15);
}
__device__ __forceinline__ unsigned pk_add(unsigned a, unsigned b) { return __builtin_bit_cast(unsigned, __builtin_bit_cast(u16x2, a) + __builtin_bit_cast(u16x2, b)); }
__device__ __forceinline__ unsigned half_sum(unsigned x) {
    x = pk_add(x, (unsigned)__builtin_amdgcn_update_dpp(0, (int)x, 0xB1, 0xf, 0xf, false));
    x = pk_add(x, (unsigned)__builtin_amdgcn_update_dpp(0, (int)x, 0x4E, 0xf, 0xf, false));
    x = pk_add(x, (unsigned)__builtin_amdgcn_update_dpp(0, (int)x, 0x141, 0xf, 0xf, false));
    x = pk_add(x, (unsigned)__builtin_amdgcn_update_dpp(0, (int)x, 0x140, 0xf, 0xf, false));
    x = pk_add(x, (unsigned)__builtin_amdgcn_ds_swizzle((int)x, 0x401F));
    return x;
}
__device__ __forceinline__ void select_unit(LAS unsigned char* lds, int b, int c, int half) {
    ArgsP A = get_args();
    unsigned char* ws = A->ws;
    const bf16_t* P = (const bf16_t*)(ws + WS_P);
    unsigned* MASK = (unsigned*)(ws + WS_MASK);
    const int tid = opaque_tid(), lane = tid & 63, r32 = lane & 31, hi = lane >> 5; const int wid = __builtin_amdgcn_readfirstlane(tid >> 6);
    const int ni = c + 1, nb = 2 * ni;
    const size_t tq0 = (size_t)b * S + 64 * c + 32 * half + 4 * wid;
    if (c <= 3) {
        for (int e = lane; e < 4 * nb; e += 64) MASK[(tq0 + e / nb) * 128 + e % nb] = 0xffffffffu;
        return;
    }
    int nkeys_v = 64 * ni; asm volatile("" : "+v"(nkeys_v));
    unsigned vals[64];
    LAS unsigned* ldsv = (LAS unsigned*)lds + wid * 4096 + lane;
#define SVAL(blk) (((blk) < 64) ? vals[(blk) & 63] : ldsv[(((blk) - 64) & 63) * 64])
    {
        const int ql = 2 * ((r32 >> 2) & 1) + (r32 >> 4), hh = ((r32 >> 3) & 1) * 4 + (r32 & 3);
        const bf16x8 af0 = *(const bf16x8*)(P + (tq0 + ql) * PC + CC_QI + hh * 32 + 8 * hi), af1 = *(const bf16x8*)(P + (tq0 + ql) * PC + CC_QI + hh * 32 + 16 + 8 * hi);
        const float idx_scale = 0.35355339059327373f * 0.17677669529663687f * 0.125f;
        float wv[16];
#pragma unroll
        for (int qh = 0; qh < 2; ++qh) { const u16x8 w8 = *(const u16x8*)(P + (tq0 + 2 * hi + qh) * PC + CC_WI);
#pragma unroll
            for (int e = 0; e < 8; ++e) wv[8 * qh + e] = bf2f(w8[e]) * idx_scale; }
        const bf16_t* kbase = P + ((size_t)b * S + r32) * PC + CC_KI + 8 * hi;
        bf16x8 afc[2][2] = {{af0, af1}, {af0, af1}};
        bf16x8 pb0[3], pb1[3];
        pb0[0] = *(const bf16x8*)kbase; pb1[0] = *(const bf16x8*)(kbase + 16);
        pb0[1] = *(const bf16x8*)(kbase + (size_t)32 * PC); pb1[1] = *(const bf16x8*)(kbase + (size_t)32 * PC + 16);
        const int ng16i = (nb + 15) >> 4;
#pragma unroll
        for (int g = 0; g < 8; ++g) if (g < ng16i) {
#pragma unroll
            for (int jb = 0; jb < 16; ++jb) { const int blk = 16 * g + jb;
                pb0[(blk + 2) % 3] = *(const bf16x8*)(kbase + (size_t)(32 * (blk + 2)) * PC); pb1[(blk + 2) % 3] = *(const bf16x8*)(kbase + (size_t)(32 * (blk + 2)) * PC + 16);
                f32x16 acc = f32x16{};
                acc = __builtin_amdgcn_mfma_f32_32x32x16_bf16(afc[blk & 1][0], pb0[blk % 3], acc, 0, 0, 0);
                acc = __builtin_amdgcn_mfma_f32_32x32x16_bf16(afc[blk & 1][1], pb1[blk % 3], acc, 0, 0, 0);
                float pr_[16];
#pragma unroll
                for (int r = 0; r < 16; ++r) pr_[r] = sel::relu_s(acc[r]);
                const float v0 = ((wv[0] * pr_[0] + wv[1] * pr_[1]) + (wv[2] * pr_[2] + wv[3] * pr_[3])) + ((wv[4] * pr_[4] + wv[5] * pr_[5]) + (wv[6] * pr_[6] + wv[7] * pr_[7]));
                const float v1 = ((wv[8] * pr_[8] + wv[9] * pr_[9]) + (wv[10] * pr_[10] + wv[11] * pr_[11])) + ((wv[12] * pr_[12] + wv[13] * pr_[13]) + (wv[14] * pr_[14] + wv[15] * pr_[15]));
                unsigned sv_ = __builtin_bit_cast(unsigned, __builtin_amdgcn_cvt_pknorm_i16(v0, v1));
                sv_ = (32 * blk + r32 < nkeys_v) ? sv_ : 0x80008000u;
                asm volatile("" : "+v"(afc[blk & 1][0]) : "v"(sv_));
                if (blk < 64) vals[blk & 63] = sv_; else ldsv[((blk - 64) & 63) * 64] = sv_;
            }
        }
    }
    const int ng16 = (nb + 15) >> 4;
    const unsigned total = (unsigned)ng16 * 512u;
#define SEL2_COUNT_LT(res, c2) do { unsigned a0_ = 0u, a1_ = 0u, a2_ = 0u, a3_ = 0u; \
        _Pragma("unroll") for (int g = 0; g < 8; ++g) if (g < ng16) { \
            unsigned sv_[16]; _Pragma("unroll") for (int j = 0; j < 16; ++j) sv_[j] = SVAL(16 * g + j); \
            __builtin_amdgcn_sched_barrier(0); \
            s16x2 dd_[16]; _Pragma("unroll") for (int j = 0; j < 16; ++j) dd_[j] = __builtin_elementwise_sub_sat(__builtin_bit_cast(s16x2, sv_[j]), __builtin_bit_cast(s16x2, (unsigned)(c2))); \
            __builtin_amdgcn_sched_barrier(0); \
            u16x2 ss_[16]; _Pragma("unroll") for (int j = 0; j < 16; ++j) ss_[j] = __builtin_bit_cast(u16x2, dd_[j]) >> 15; \
            __builtin_amdgcn_sched_barrier(0); \
            _Pragma("unroll") for (int j = 0; j < 8; ++j) ss_[j] += ss_[j + 8]; \
            __builtin_amdgcn_sched_barrier(0); \
            _Pragma("unroll") for (int j = 0; j < 4; ++j) ss_[j] += ss_[j + 4]; \
            __builtin_amdgcn_sched_barrier(0); \
            a0_ = pk_add(a0_, __builtin_bit_cast(unsigned, ss_[0])); a1_ = pk_add(a1_, __builtin_bit_cast(unsigned, ss_[1])); a2_ = pk_add(a2_, __builtin_bit_cast(unsigned, ss_[2])); a3_ = pk_add(a3_, __builtin_bit_cast(unsigned, ss_[3])); \
            __builtin_amdgcn_sched_barrier(0); } \
        res = half_sum(pk_add(pk_add(a0_, a1_), pk_add(a2_, a3_))); } while (0)
    unsigned Tu2 = 0u;
    unsigned cge_lo = total, cge_hi = total;
#pragma unroll 1
    for (int bit = 15; bit >= 0; --bit) {
        const unsigned cand2 = Tu2 | ((1u << bit) * 0x10001u);
        unsigned clt; SEL2_COUNT_LT(clt, cand2 ^ 0x80008000u);
        const unsigned g_lo = total - (clt & 0xffffu), g_hi = total - (clt >> 16);
        if (g_lo >= 256u) { Tu2 = (Tu2 & 0xffff0000u) | (cand2 & 0x0000ffffu); cge_lo = g_lo; }
        if (g_hi >= 256u) { Tu2 = (Tu2 & 0x0000ffffu) | (cand2 & 0xffff0000u); cge_hi = g_hi; }
        if (__all((cge_lo == 256u) && (cge_hi == 256u))) break;
    }
    const unsigned Ts2 = Tu2 ^ 0x80008000u;
    const bool anytie = __any((cge_lo != 256u) || (cge_hi != 256u));
    LAS unsigned* m0 = (LAS unsigned*)(lds + 131072) + wid * 512; LAS unsigned* m1 = m0 + 128; LAS unsigned* m2 = m0 + 256; LAS unsigned* m3 = m0 + 384;
    if (!anytie) {
#pragma unroll
        for (int g = 0; g < 8; ++g) if (g < ng16)
#pragma unroll
        for (int jb = 0; jb < 16; ++jb) { const int blk = 16 * g + jb;
            const unsigned d = __builtin_bit_cast(unsigned, __builtin_elementwise_sub_sat(__builtin_bit_cast(s16x2, SVAL(blk)), __builtin_bit_cast(s16x2, Ts2)));
            const unsigned long long bl = __ballot((d & 0x8000u) == 0u), bh = __ballot((int)d >= 0);
            if (lane == 0) { m0[blk] = (unsigned)bl; m2[blk] = (unsigned)(bl >> 32); m1[blk] = (unsigned)bh; m3[blk] = (unsigned)(bh >> 32); }
        }
    } else {
        const s16x2 tp1 = __builtin_elementwise_add_sat(__builtin_bit_cast(s16x2, Ts2), (s16x2){1, 1});
        unsigned clt_u; SEL2_COUNT_LT(clt_u, __builtin_bit_cast(unsigned, tp1));
        const int cgt_lo = ((Ts2 & 0xffffu) == 0x7fffu) ? 0 : (int)(total - (clt_u & 0xffffu)), cgt_hi = ((Ts2 >> 16) == 0x7fffu) ? 0 : (int)(total - (clt_u >> 16));
        const int need_lo = 256 - cgt_lo, need_hi = 256 - cgt_hi;
        int taken_lo = 0, taken_hi = 0;
#pragma unroll
        for (int g = 0; g < 8; ++g) if (g < ng16)
#pragma unroll
        for (int jb = 0; jb < 16; ++jb) { const int blk = 16 * g + jb;
            const unsigned d = __builtin_bit_cast(unsigned, __builtin_elementwise_sub_sat(__builtin_bit_cast(s16x2, SVAL(blk)), __builtin_bit_cast(s16x2, Ts2)));
            const bool eq_lo = ((d & 0xffffu) == 0u), eq_hi = ((d >> 16) == 0u);
            const bool gt_lo = !eq_lo && ((d & 0x8000u) == 0u), gt_hi = !eq_hi && ((int)d >= 0);
            const unsigned long long el = __ballot(eq_lo), eh = __ballot(eq_hi);
            const int cl0 = __popc((unsigned)el), cl1 = __popc((unsigned)(el >> 32)), ch0 = __popc((unsigned)eh), ch1 = __popc((unsigned)(eh >> 32));
            const int pre_lo = (int)__builtin_amdgcn_mbcnt_hi((unsigned)(el >> 32), __builtin_amdgcn_mbcnt_lo((unsigned)el, 0u)) - (hi ? cl0 : 0);
            const int pre_hi = (int)__builtin_amdgcn_mbcnt_hi((unsigned)(eh >> 32), __builtin_amdgcn_mbcnt_lo((unsigned)eh, 0u)) - (hi ? ch0 : 0);
            const bool s_lo = gt_lo || (eq_lo && (taken_lo + pre_lo) < need_lo), s_hi = gt_hi || (eq_hi && (taken_hi + pre_hi) < need_hi);
            taken_lo += hi ? cl1 : cl0; taken_hi += hi ? ch1 : ch0;
            const unsigned long long bl = __ballot(s_lo), bh = __ballot(s_hi);
            if (lane == 0) { m0[blk] = (unsigned)bl; m2[blk] = (unsigned)(bl >> 32); m1[blk] = (unsigned)bh; m3[blk] = (unsigned)(bh >> 32); }
        }
    }
    asm volatile("s_waitcnt lgkmcnt(0)" ::: "memory");
#pragma unroll
    for (int q = 0; q < 4; ++q)
#pragma unroll
        for (int hf = 0; hf < 2; ++hf) { const int bw = lane + 64 * hf; if (bw < nb) MASK[(tq0 + q) * 128 + bw] = m0[q * 128 + bw]; }
#undef SEL2_COUNT_LT
#undef SVAL
}
}

namespace mp {
constexpr int AQ_STRIDE = 528, AKV_STRIDE = 272, L_AQ = 0, L_AKV = 128 * AQ_STRIDE;
__device__ __forceinline__ void store4(bf16_t* p, const f32x4 v) { uint2 w; w.x = pg8::cvt_pk_bf16(v[0], v[1]); w.y = pg8::cvt_pk_bf16(v[2], v[3]); *(uint2*)p = w; }
__device__ __forceinline__ void mla_prep_unit(LAS unsigned char* lds, int tile, int l) {
    ArgsP A = get_args();
    unsigned char* ws = A->ws;
    const bf16_t* P = (const bf16_t*)(ws + WS_P);
    const float* ROPE = (const float*)(ws + WS_ROPE);
    bf16_t* QA = (bf16_t*)(ws + WS_QA); bf16_t* KA = (bf16_t*)(ws + WS_KA); bf16_t* VA = (bf16_t*)(ws + WS_VA);
    const int tid = opaque_tid(), lane = tid & 63, fr = lane & 15, fq = lane >> 4, wid = __builtin_amdgcn_readfirstlane(tid >> 6);
    const size_t t0 = (size_t)tile * 128;
    __syncthreads();
    {
        const float* qg = A->qa_g + l * 256; const float* kg = A->kva_g + l * 128;
        float gq[4], gk[4];
#pragma unroll
        for (int j = 0; j < 4; ++j) { gq[j] = qg[4 * lane + j]; gk[j] = kg[(4 * lane + j) & 127]; }
#pragma unroll 4
        for (int i = 0; i < 16; ++i) {
            const int row = 16 * wid + i; const size_t t = t0 + row;
            const bf16_t* p = P + t * PC;
            const uint2 cq = *(const uint2*)(p + CA_CQ + 4 * lane);
            const uint2 ck = *(const uint2*)(p + CA_CKV + 4 * (lane & 31));
            float a[4] = {bf2f((bf16_t)(cq.x & 0xffff)), bf2f((bf16_t)(cq.x >> 16)), bf2f((bf16_t)(cq.y & 0xffff)), bf2f((bf16_t)(cq.y >> 16))};
            float c[4] = {bf2f((bf16_t)(ck.x & 0xffff)), bf2f((bf16_t)(ck.x >> 16)), bf2f((bf16_t)(ck.y & 0xffff)), bf2f((bf16_t)(ck.y >> 16))};
            float sa = a[0] * a[0] + a[1] * a[1] + a[2] * a[2] + a[3] * a[3];
            float sb = (lane < 32) ? (c[0] * c[0] + c[1] * c[1] + c[2] * c[2] + c[3] * c[3]) : 0.f;
#pragma unroll
            for (int o = 1; o < 64; o <<= 1) { sa += __shfl_xor(sa, o); sb += __shfl_xor(sb, o); }
            const float ra = rsqrtf(sa * (1.f / 256.f) + EPS), rb = rsqrtf(sb * (1.f / 128.f) + EPS);
            u32x2 w; w.x = pg8::cvt_pk_bf16(a[0] * ra * gq[0], a[1] * ra * gq[1]); w.y = pg8::cvt_pk_bf16(a[2] * ra * gq[2], a[3] * ra * gq[3]);
            *(LAS u32x2*)(lds + L_AQ + row * AQ_STRIDE + 8 * lane) = w;
            if (lane < 32) { u32x2 v; v.x = pg8::cvt_pk_bf16(c[0] * rb * gk[0], c[1] * rb * gk[1]); v.y = pg8::cvt_pk_bf16(c[2] * rb * gk[2], c[3] * rb * gk[3]);
                *(LAS u32x2*)(lds + L_AKV + row * AKV_STRIDE + 8 * lane) = v; }
            if (lane < 16) {
                const int pos = (int)(t % S);
                const float k1 = bf2f(p[CA_KR + lane]), k2 = bf2f(p[CA_KR + 16 + lane]);
                const float cs = ROPE[pos * 16 + lane], sn = ROPE[S * 16 + pos * 16 + lane];
                const bf16_t o1 = f2bf(k1 * cs - k2 * sn), o2 = f2bf(k2 * cs + k1 * sn);
#pragma unroll
                for (int h = 0; h < 4; ++h) { KA[t * 384 + h * 96 + 64 + lane] = o1; KA[t * 384 + h * 96 + 80 + lane] = o2; }
            }
        }
    }
    __syncthreads();
    const int h = wid >> 1, half = wid & 1;
    {
        const bf16_t* W = (const bf16_t*)(ws + WS_WTUQ) + (size_t)l * 384 * 256 + (size_t)(48 * wid + fr) * 256 + 8 * fq;
        f32x4 acc[8][3];
#pragma unroll
        for (int mi = 0; mi < 8; ++mi)
#pragma unroll
            for (int nf = 0; nf < 3; ++nf) acc[mi][nf] = (f32x4){0.f, 0.f, 0.f, 0.f};
#pragma unroll 2
        for (int ks = 0; ks < 8; ++ks) {
            bf16x8 wf[3];
#pragma unroll
            for (int nf = 0; nf < 3; ++nf) wf[nf] = *(const bf16x8*)(W + (size_t)(16 * nf) * 256 + 32 * ks);
#pragma unroll
            for (int mi = 0; mi < 8; ++mi) {
                const bf16x8 xf = *(const LAS bf16x8*)(lds + L_AQ + (16 * mi + fr) * AQ_STRIDE + 64 * ks + 16 * fq);
#pragma unroll
                for (int nf = 0; nf < 3; ++nf) acc[mi][nf] = __builtin_amdgcn_mfma_f32_16x16x32_bf16(wf[nf], xf, acc[mi][nf], 0, 0, 0);
            }
        }
#pragma unroll
        for (int mi = 0; mi < 8; ++mi) {
            const size_t t = t0 + 16 * mi + fr;
            bf16_t* qo = QA + t * 384 + h * 96 + 48 * half + 4 * fq;
            if (half == 0) {
#pragma unroll
                for (int nf = 0; nf < 3; ++nf) store4(qo + 16 * nf, acc[mi][nf]);
            } else {
                store4(qo, acc[mi][0]);
                const int pos = (int)(t % S);
                const f32x4 cs = *(const f32x4*)(ROPE + pos * 16 + 4 * fq), sn = *(const f32x4*)(ROPE + S * 16 + pos * 16 + 4 * fq);
                const f32x4 x1 = acc[mi][1], x2 = acc[mi][2];
                store4(qo + 16, x1 * cs - x2 * sn); store4(qo + 32, x2 * cs + x1 * sn);
            }
        }
    }
    {
        const bf16_t* W = (const bf16_t*)(ws + WS_WTUKV) + (size_t)l * 512 * 128 + (size_t)(64 * wid + fr) * 128 + 8 * fq;
        f32x4 acc[8][4];
#pragma unroll
        for (int mi = 0; mi < 8; ++mi)
#pragma unroll
            for (int nf = 0; nf < 4; ++nf) acc[mi][nf] = (f32x4){0.f, 0.f, 0.f, 0.f};
#pragma unroll 2
        for (int ks = 0; ks < 4; ++ks) {
            bf16x8 wf[4];
#pragma unroll
            for (int nf = 0; nf < 4; ++nf) wf[nf] = *(const bf16x8*)(W + (size_t)(16 * nf) * 128 + 32 * ks);
#pragma unroll
            for (int mi = 0; mi < 8; ++mi) {
                const bf16x8 xf = *(const LAS bf16x8*)(lds + L_AKV + (16 * mi + fr) * AKV_STRIDE + 64 * ks + 16 * fq);
#pragma unroll
                for (int nf = 0; nf < 4; ++nf) acc[mi][nf] = __builtin_amdgcn_mfma_f32_16x16x32_bf16(wf[nf], xf, acc[mi][nf], 0, 0, 0);
            }
        }
#pragma unroll
        for (int mi = 0; mi < 8; ++mi) {
            const size_t t = t0 + 16 * mi + fr;
            bf16_t* o = (half == 0) ? KA + t * 384 + h * 96 + 4 * fq : VA + t * 256 + h * 64 + 4 * fq;
#pragma unroll
            for (int nf = 0; nf < 4; ++nf) store4(o + 16 * nf, acc[mi][nf]);
        }
    }
}
}

__device__ __forceinline__ void conv_tokens(int t, int cg, const bf16_t* P, const float* cw, bf16_t* Y) {
    const int pos = t % S, ch = cg * 8;
    const bf16_t* p = P + (size_t)t * PC;
    const u16x8 zero = (u16x8){0, 0, 0, 0, 0, 0, 0, 0};
    const u16x8 c2 = *(const u16x8*)(p + CD_C + ch), h2 = *(const u16x8*)(p + CD_H + ch);
    const u16x8 c1 = (pos >= 1) ? *(const u16x8*)(p - PC + CD_C + ch) : zero, h1 = (pos >= 1) ? *(const u16x8*)(p - PC + CD_H + ch) : zero;
    const u16x8 c0 = (pos >= 2) ? *(const u16x8*)(p - 2 * PC + CD_C + ch) : zero, h0 = (pos >= 2) ? *(const u16x8*)(p - 2 * PC + CD_H + ch) : zero;
    const u16x8 bb = *(const u16x8*)(p + CD_B + ch), gg = *(const u16x8*)(p + CD_G + ch);
    u16x8 out;
#pragma unroll
    for (int e = 0; e < 8; ++e) {
        const float y = cw[ch + e] * (bf2f(c0[e]) * bf2f(h0[e])) + cw[256 + ch + e] * (bf2f(c1[e]) * bf2f(h1[e])) + cw[512 + ch + e] * (bf2f(c2[e]) * bf2f(h2[e]));
        const float g = bf2f(gg[e]);
        out[e] = f2bf(bf2f(bb[e]) * y * (g * __builtin_amdgcn_rcpf(1.f + __expf(-g))));
    }
    *(u16x8*)(Y + (size_t)t * D + 768 + ch) = out;
}

#define PH_PRE const int tid = opaque_tid(), lane = tid & 63, wave = __builtin_amdgcn_readfirstlane(tid >> 6); const int G = opaque_grid(), bid = opaque_bid(); \
    ArgsP A = get_args(); unsigned char* ws = A->ws; (void)lane; (void)wave; (void)G; (void)bid; (void)ws;
__device__ __forceinline__ void ph_prologue(LAS unsigned char* lds) {
    PH_PRE
    const long gtid = (long)bid * NTHR + tid, gthreads = (long)G * NTHR;
    {
        LAS float* scr = (LAS float*)lds;
        constexpr int T_IN = 16 * 64, T_OUT = 16 * 16, T_UQ = 4 * 6, T_UKV = 2 * 8, T_L = T_IN + T_OUT + T_UQ + T_UKV;
        for (int it = bid; it < NL * T_L; it += G) {
            const int l = it / T_L; int r = it % T_L;
            if (r < T_IN) { convert_tile(scr, A->w_in + (size_t)l * 1024 * INC, (bf16_t*)(ws + WS_WTIN) + (size_t)l * PC * 1024, 1024, INC, 1, 1.f, (r >> 6) * 64, (r & 63) * 64, tid); continue; } r -= T_IN;
            if (r < T_OUT) { convert_tile(scr, A->w_out + (size_t)l * 1024 * 1024, (bf16_t*)(ws + WS_WTOUT) + (size_t)l * 1024 * 1024, 1024, 1024, 0, 1.f, (r >> 4) * 64, (r & 15) * 64, tid); continue; } r -= T_OUT;
            if (r < T_UQ) { convert_tile(scr, A->w_uq + (size_t)l * 256 * 384, (bf16_t*)(ws + WS_WTUQ) + (size_t)l * 384 * 256, 256, 384, 0, QS_MLA, (r / 6) * 64, (r % 6) * 64, tid); continue; } r -= T_UQ;
            convert_tile(scr, A->w_ukv + (size_t)l * 128 * 512, (bf16_t*)(ws + WS_WTUKV) + (size_t)l * 512 * 128, 128, 512, 0, 1.f, (r >> 3) * 64, (r & 7) * 64, tid);
        }
        __syncthreads();
    }
    float* ROPE = (float*)(ws + WS_ROPE);
    for (long i = gtid; i < S * 16; i += gthreads) {
        const int s = (int)(i >> 4), f = (int)(i & 15);
        const float inv = powf(10000.0f, -(float)f / 16.0f);
        const float ang = (float)s * inv;
        float sn, c; sincosf(ang, &sn, &c);
        ROPE[i] = c; ROPE[S * 16 + i] = sn;
    }
}
__device__ __forceinline__ void ph_rms(int l) {
    PH_PRE
    bf16_t* HN = (bf16_t*)(ws + WS_HN);
    const int NGW = G * NWAVE;
    if (l == 0) { for (int r = bid * NWAVE + wave; r < T; r += 4 * NGW) rms_rows4<true>(A->x + (size_t)r * D, (size_t)NGW * D, A->norm_g + l * D, HN + (size_t)r * D, nullptr, lane); }
    else { const bf16_t* XR = (const bf16_t*)(ws + WS_XR);
        for (int r = bid * NWAVE + wave; r < T; r += 4 * NGW) rms_rows4b<true>(XR + (size_t)r * D, (size_t)NGW * D, A->norm_g + l * D, HN + (size_t)r * D, nullptr, lane); }
}
__device__ __forceinline__ void ph_gemm_in(LAS unsigned char* lds, int l) {
    PH_PRE
    pg8::Gemm g{(const bf16_t*)(ws + WS_HN), (const bf16_t*)(ws + WS_WTIN) + (size_t)l * PC * 1024, T, PC, 1024}; pg8::StaticOrder So; So.init(T, PC, G, bid);
    pg8::EpiBf16 E{(bf16_t*)(ws + WS_P), PC};
    pg8::gemm_phase<pg8::EpiBf16, pg8::StaticOrder, true, true>(lds, g, So, E);
}
__device__ __forceinline__ void ph_mid(LAS unsigned char* lds, int l) {
    const int G = opaque_grid(), bid = opaque_bid();
    for (int u = bid; u < T / 128; u += G) mp::mla_prep_unit(lds, u, l);
    __syncthreads();
    {
        const int vcu = (bid & 7) * (G >> 3) + (bid >> 3);
        const int b = vcu >> 5, j = vcu & 31;
        for (int m = 0; m < 4; ++m) { const int c = ((m & 1) ? (15 - (j >> 1)) : (j >> 1)) + 16 * m; sel2::select_unit(lds, b, c, j & 1); }
    }
}
__device__ __forceinline__ void ph_attn(LAS unsigned char* lds, int l) {
    const int G = opaque_grid(), bid = opaque_bid();
    {
        const int vcu = (bid & 7) * (G >> 3) + (bid >> 3);
        const int b = vcu >> 5, h = (vcu >> 3) & 3, s = vcu & 7;
        { ArgsP A = get_args(); fa::build_bias(lds, A->rel_bias); }
#define ATTN_UNIT(TY) do { _Pragma("unroll 1") for (int u_ = 0; u_ < 2; ++u_) { int b_ = b, h_ = h, q_ = u_ ? s : 15 - s, l_ = l; asm volatile("" : "+s"(b_), "+s"(h_), "+s"(q_), "+s"(l_)); \
            fa::attn_unit<TY>(lds, b_, h_, q_, l_); } } while (0)
        ATTN_UNIT(0);
        { _Pragma("unroll 1") for (int u_ = 0; u_ < 2; ++u_) { int b_ = b, h_ = h, q_ = u_ ? s : 15 - s, l_ = l; asm volatile("" : "+s"(b_), "+s"(h_), "+s"(q_), "+s"(l_)); fa::attn_unit_diff(lds, b_, h_, q_, l_); } }
        ATTN_UNIT(2);
#undef ATTN_UNIT
        __syncthreads();
    }
    {
        PH_PRE
        for (int t = bid * 16 + (tid >> 5); t < T; t += 16 * G) conv_tokens(t, tid & 31, (const bf16_t*)(ws + WS_P), A->conv_w + l * 768, (bf16_t*)(ws + WS_Y));
    }
}
__device__ __forceinline__ void ph_gemm_out(LAS unsigned char* lds, int l) {
    PH_PRE
    pg8::Gemm g{(const bf16_t*)(ws + WS_Y), (const bf16_t*)(ws + WS_WTOUT) + (size_t)l * 1024 * 1024, T, 1024, 1024}; pg8::StaticOrder So; So.init(T, 1024, G, bid);
    bf16_t* XR = (bf16_t*)(ws + WS_XR);
    if (l == 0) { pg8::EpiResBf16<false> E{A->x, XR, 1024}; pg8::gemm_phase<pg8::EpiResBf16<false>, pg8::StaticOrder, true, true>(lds, g, So, E); }
    else { pg8::EpiResBf16<true> E{XR, XR, 1024}; pg8::gemm_phase<pg8::EpiResBf16<true>, pg8::StaticOrder, true, true>(lds, g, So, E); }
}
__device__ __forceinline__ void ph_final() {
    PH_PRE
    const int NGW = G * NWAVE;
    const bf16_t* XR = (const bf16_t*)(ws + WS_XR);
    for (int r = bid * NWAVE + wave; r < T; r += 4 * NGW) rms_rows4b<false>(XR + (size_t)r * D, (size_t)NGW * D, A->final_g, nullptr, A->out + (size_t)r * D, lane);
}

#define GRID_SYNC() xcd_barrier(lds)
__global__ void __launch_bounds__(NTHR, 2) mk_fwd(Args Akernarg) {
    extern __shared__ __attribute__((aligned(16))) unsigned char lds_raw[];
    LAS unsigned char* lds = (LAS unsigned char*)lds_raw;
    xcd_barrier_post(lds);
    ph_prologue(lds);
    for (int l = 0; l < NL; ++l) {
        ph_rms(l);
        GRID_SYNC();
        ph_gemm_in(lds, l);
        GRID_SYNC();
        ph_mid(lds, l);
        GRID_SYNC();
        ph_attn(lds, l);
        GRID_SYNC();
        ph_gemm_out(lds, l);
        GRID_SYNC();
    }
    ph_final();
}

extern "C" void kernel_launch(void* const* d_in, const int* in_sizes, int n_in, void* d_out, int out_size, void* d_ws, size_t ws_size, hipStream_t stream) {
    static int grid = 0;
    if (grid == 0) {
        if (ws_size < WS_END) { fprintf(stderr, "kernel_launch: workspace too small (%zu < %zu)\n", ws_size, (size_t)WS_END); grid = -1; return; }
        int dev = 0, cus = 0, per_cu = 0;
        hipGetDevice(&dev);
        hipDeviceGetAttribute(&cus, hipDeviceAttributeMultiprocessorCount, dev);
        hipFuncSetAttribute((const void*)mk_fwd, hipFuncAttributeMaxDynamicSharedMemorySize, LDS_BYTES);
        hipOccupancyMaxActiveBlocksPerMultiprocessor(&per_cu, (const void*)mk_fwd, NTHR, LDS_BYTES);
        if (per_cu < 1) fprintf(stderr, "kernel_launch: note: the occupancy query reports %d workgroups per CU; 145 KiB of LDS per workgroup admits exactly one\n", per_cu);
        (void)hipGetLastError();
        if (cus != 256) { fprintf(stderr, "kernel_launch: built for a 256-CU device (one workgroup per CU, 32 per batch); found %d CUs; nothing launched\n", cus); grid = -1; return; }
        grid = cus;
    }
    if (grid < 0) return;
    Args a{};
    a.x = (const float*)d_in[0]; a.norm_g = (const float*)d_in[1]; a.w_in = (const float*)d_in[2]; a.qa_g = (const float*)d_in[3];
    a.w_uq = (const float*)d_in[4]; a.kva_g = (const float*)d_in[5]; a.w_ukv = (const float*)d_in[6]; a.dlam = (const float*)d_in[7];
    a.subg = (const float*)d_in[8]; a.conv_w = (const float*)d_in[9]; a.w_out = (const float*)d_in[10]; a.rel_bias = (const float*)d_in[11];
    a.final_g = (const float*)d_in[12];
    a.out = (float*)d_out; a.ws = (unsigned char*)d_ws;
    a.lambda_init[0] = 0.8f - 0.6f * expf(-0.3f * 0.f); a.lambda_init[1] = 0.8f - 0.6f * expf(-0.3f * 1.f);
    if (hipMemsetAsync(d_ws, 0, 65536, stream) != hipSuccess) { fprintf(stderr, "kernel_launch: memset of the barrier words failed\n"); return; }
    hipLaunchKernelGGL(mk_fwd, dim3(grid), dim3(NTHR), LDS_BYTES, stream, a);
    const hipError_t e = hipPeekAtLastError();
    if (e != hipSuccess) fprintf(stderr, "launch failed: %s (grid %d)\n", hipGetErrorString(e), grid);
}
```

```cpp
#include <hip/hip_runtime.h>
#include <hip/hip_bf16.h>
#include <cstdint>
#include <cstdio>

#define LAS __attribute__((address_space(3)))
typedef unsigned short bf16_t;
typedef short bf16x8 __attribute__((ext_vector_type(8)));
typedef unsigned short u16x8 __attribute__((ext_vector_type(8)));
typedef float f32x4 __attribute__((ext_vector_type(4)));
typedef unsigned u32x4 __attribute__((ext_vector_type(4)));
typedef unsigned u32x2 __attribute__((ext_vector_type(2)));

constexpr int NB = 8, S = 4096, T = NB * S, D = 1024, NL = 2;
constexpr int PC = 4096;
constexpr int INC = 4040;
constexpr int CA_CQ = 0, CA_CKV = 256, CA_KR = 384, CA_G = 448;
constexpr int CB_Q = 704, CB_K = 960, CB_V = 1216, CB_G = 1472;
constexpr int CC_Q = 1728, CC_K = 1984, CC_V = 2240, CC_QI = 2496, CC_KI = 2752, CC_WI = 2784, CC_G = 2816;
constexpr int CD_B = 3072, CD_C = 3328, CD_H = 3584, CD_G = 3840;
constexpr float EPS = 1e-6f;
constexpr int NTHR = 512, NWAVE = 8;

constexpr size_t MiB = 1u << 20;
constexpr size_t WS_WTIN = 1 * MiB;
constexpr size_t WS_WTOUT = 17 * MiB;
constexpr size_t WS_WTUQ = 21 * MiB;
constexpr size_t WS_WTUKV = 22 * MiB;
constexpr size_t WS_ROPE = 23 * MiB;
constexpr size_t WS_HN = 24 * MiB;
constexpr size_t WS_Y = WS_HN;
constexpr size_t WS_Q384 = WS_HN;
constexpr size_t WS_KV512 = WS_HN + 24 * MiB;
constexpr size_t WS_P = 88 * MiB;
constexpr size_t WS_QA = 344 * MiB;
constexpr size_t WS_KA = 368 * MiB;
constexpr size_t WS_VA = 392 * MiB;
constexpr size_t WS_CQN = WS_VA;
constexpr size_t WS_MASK = 408 * MiB;
constexpr size_t WS_CKVN = WS_MASK;
constexpr size_t WS_OKL = 424 * MiB;
constexpr size_t WS_XR = 440 * MiB;
constexpr size_t WS_END = 504 * MiB;

constexpr int LDS_BYTES = 148480;

__device__ __forceinline__ bf16_t f2bf(float f) {
    unsigned u = __builtin_bit_cast(unsigned, f);
    return (bf16_t)((u + 0x7fffu + ((u >> 16) & 1u)) >> 16);
}
__device__ __forceinline__ float bf2f(bf16_t h) { return __builtin_bit_cast(float, (unsigned)h << 16); }
__device__ __forceinline__ float silu(float x) { return x / (1.f + __expf(-x)); }
__device__ __forceinline__ int orig_col(int pc) {
    if (pc < 416) return pc;
    if (pc < 448) return -1;
    if (pc < 2792) return pc - 32;
    if (pc < 2816) return -1;
    return pc - 56;
}
__device__ __forceinline__ int rel_bucket(int rel) {
    const int ret = rel > 0 ? 16 : 0;
    const int n = rel < 0 ? -rel : rel;
    if (n < 8) return ret + n;
    int large = 2 + (31 - __clz(n * n));
    if (large > 15) large = 15;
    return ret + large;
}

__device__ __forceinline__ int opaque_tid() { int t = threadIdx.x; asm volatile("" : "+v"(t)); return t; }
__device__ __forceinline__ int opaque_bid() { int b = blockIdx.x; asm volatile("" : "+s"(b)); return b; }
__device__ __forceinline__ int opaque_grid() { int g = gridDim.x; asm volatile("" : "+s"(g)); return g; }
namespace pg8 {
constexpr int BM = 256, BK = 64, HALF = 128, HTB = HALF * BK * 2, STAGE_BYTES = 8 * HTB, NXCD = 8, WGM = 8;
__host__ __device__ __forceinline__ int lds_byte(int r, int c) { const int st = (r >> 4) * 2 + (c >> 5), rr = r & 15, cc = c & 31, ob = rr * 64 + cc * 2; return st * 1024 + (ob ^ (((ob >> 9) & 1) << 5)); }
__host__ __device__ __forceinline__ void stage_rc(int b, int& R, int& C) { const int st = b / 1024, sb = b % 1024, swz = sb ^ (((sb >> 9) & 1) << 5); R = (st >> 1) * 16 + swz / 64; C = (st & 1) * 32 + (swz % 64) / 2; }
__host__ __device__ __forceinline__ int perm32(int rho) { const int n = rho >> 4, i = rho & 15; return 8 * (i >> 2) + 4 * n + (i & 3); }
struct Unit { int pm, pn; };
struct Gemm { const bf16_t* A; const bf16_t* Bt; int M, N, K; };
struct StaticOrder {
    int nM, nN, nwg, G, c;
    __host__ __device__ void init(int M, int N, int G_, int c_) { nM = M / BM; nN = N / BM; nwg = nM * nN; G = G_; c = c_; }
    __host__ __device__ bool next(int i, Unit& u) const {
        const long L = (long)i * G + c; if (L >= nwg) return false;
        int wgid = (int)L; { const int q = nwg / NXCD, r = nwg % NXCD, xcd = wgid % NXCD, off = wgid / NXCD; wgid = (xcd < r ? xcd * (q + 1) : r * (q + 1) + (xcd - r) * q) + off; }
        const int nig = WGM * nN, gid = wgid / nig, fm = gid * WGM, gsz = (nM - fm) < WGM ? (nM - fm) : WGM;
        u.pm = fm + ((wgid % nig) % gsz); u.pn = (wgid % nig) / gsz; return true;
    }
    __device__ __forceinline__ void a_ready(const Unit&) const {}
    __device__ __forceinline__ void done(const Unit&) const {}
};
__device__ __forceinline__ unsigned cvt_pk_bf16(float lo, float hi) { unsigned r; asm volatile("v_cvt_pk_bf16_f32 %0, %1, %2" : "=v"(r) : "v"(lo), "v"(hi)); return r; }
struct EpiBf16 {
    static constexpr bool PERM = true, AFTER_DRAIN = false;
    bf16_t* O; int ldc;
    __device__ __forceinline__ void operator()(const f32x4 (&acc)[2][2][4][2], const Unit& u, int wr, int wc, int fr, int fq) const {
        const int row0 = u.pm * BM + wr * 64 + fr; const int col0 = u.pn * BM + wc * 32 + 8 * fq;
#pragma unroll
        for (int ai = 0; ai < 2; ++ai)
#pragma unroll
            for (int m = 0; m < 4; ++m) { bf16_t* rowp = O + (size_t)(row0 + ai * HALF + m * 16) * ldc + col0;
#pragma unroll
                for (int bj = 0; bj < 2; ++bj) { const f32x4 v0 = acc[ai][bj][m][0], v1 = acc[ai][bj][m][1];
                    u32x4 w; w.x = cvt_pk_bf16(v0[0], v0[1]); w.y = cvt_pk_bf16(v0[2], v0[3]); w.z = cvt_pk_bf16(v1[0], v1[1]); w.w = cvt_pk_bf16(v1[2], v1[3]);
                    *(u32x4*)(rowp + bj * HALF) = w; } }
    }
};
struct EpiResF32 {
    static constexpr bool PERM = false, AFTER_DRAIN = false;
    const float* base; float* out; int ldc;
    __device__ __forceinline__ void operator()(const f32x4 (&acc)[2][2][4][2], const Unit& u, int wr, int wc, int fr, int fq) const {
        const int col0 = u.pn * BM + wc * 32 + 4 * fq;
#pragma unroll
        for (int ai = 0; ai < 2; ++ai)
#pragma unroll
            for (int m = 0; m < 4; ++m) { const size_t off = (size_t)(u.pm * BM + ai * HALF + wr * 64 + m * 16 + fr) * ldc + col0;
#pragma unroll
                for (int bj = 0; bj < 2; ++bj)
#pragma unroll
                    for (int n = 0; n < 2; ++n) { const f32x4 bs = *(const f32x4*)(base + off + bj * HALF + n * 16); *(f32x4*)(out + off + bj * HALF + n * 16) = bs + acc[ai][bj][m][n]; } }
    }
};
template <bool BASE_BF16>
struct EpiResBf16 {
    static constexpr bool PERM = true, AFTER_DRAIN = false;
    const void* base; bf16_t* out; int ldc;
    __device__ __forceinline__ void operator()(const f32x4 (&acc)[2][2][4][2], const Unit& u, int wr, int wc, int fr, int fq) const {
        const int row0 = u.pm * BM + wr * 64 + fr; const int col0 = u.pn * BM + wc * 32 + 8 * fq;
#pragma unroll
        for (int ai = 0; ai < 2; ++ai)
#pragma unroll
            for (int m = 0; m < 4; ++m) { const size_t ro = (size_t)(row0 + ai * HALF + m * 16) * ldc + col0;
#pragma unroll
                for (int bj = 0; bj < 2; ++bj) { const f32x4 v0 = acc[ai][bj][m][0], v1 = acc[ai][bj][m][1]; const size_t off = ro + bj * HALF;
                    f32x4 b0, b1;
                    if (BASE_BF16) { const u16x8 bb = *(const u16x8*)((const bf16_t*)base + off);
                        b0 = (f32x4){bf2f(bb[0]), bf2f(bb[1]), bf2f(bb[2]), bf2f(bb[3])}; b1 = (f32x4){bf2f(bb[4]), bf2f(bb[5]), bf2f(bb[6]), bf2f(bb[7])}; }
                    else { b0 = *(const f32x4*)((const float*)base + off); b1 = *(const f32x4*)((const float*)base + off + 4); }
                    const f32x4 s0 = b0 + v0, s1 = b1 + v1;
                    u32x4 w; w.x = cvt_pk_bf16(s0[0], s0[1]); w.y = cvt_pk_bf16(s0[2], s0[3]); w.z = cvt_pk_bf16(s1[0], s1[1]); w.w = cvt_pk_bf16(s1[2], s1[3]);
                    *(u32x4*)(out + off) = w; } }
    }
};
template <class Epi, class Sched, bool ALIGN_EPI = false, bool SP2 = false>
__device__ __forceinline__ void gemm_phase(LAS unsigned char* lds, const Gemm g, const Sched& S, const Epi& E) {
    const int tid = opaque_tid(), wid = __builtin_amdgcn_readfirstlane(tid >> 6), lane = tid & 63, wr = wid >> 2, wc = wid & 3, fr = lane & 15, fq = lane >> 4;
    const int K = g.K, nt = K / BK;
    unsigned voffA[2], voffB[2];
#pragma unroll
    for (int i = 0; i < 2; ++i) { int R, C; stage_rc(tid * 16 + i * 8192, R, C); const int Rb = Epi::PERM ? ((R & ~31) + perm32(R & 31)) : R;
        voffA[i] = (unsigned)(R * K + C) * 2u; voffB[i] = (unsigned)(Rb * K + C) * 2u; }
    const size_t kstep = (size_t)(BK * 2);
    const size_t hstep = (size_t)HALF * K * 2;
    const size_t tstep = 2 * hstep;
    const unsigned ldsw = (unsigned)wid * 1024u;
    const int aoff = lds_byte(wr * 64 + fr, fq * 8), boff = lds_byte(wc * 32 + fr, fq * 8);
#define PG8_SA(b, h) (((b) * 2 + (h)) * HTB)
#define PG8_SB(b, h) ((4 + (b) * 2 + (h)) * HTB)
#define PG8_STAGE(bufoff, gbase, voff) do { _Pragma("unroll") for (int _i = 0; _i < 2; ++_i) \
        __builtin_amdgcn_global_load_lds((const unsigned*)((const char*)(gbase) + (voff)[_i]), (LAS unsigned*)(lds + (bufoff) + ldsw + _i * 8192), 16, 0, 0); } while (0)
#define PG8_LDA(dst, b, h) do { _Pragma("unroll") for (int m = 0; m < 4; ++m) _Pragma("unroll") for (int k = 0; k < 2; ++k) dst[m][k] = *(const LAS bf16x8*)(lds + PG8_SA(b, h) + aoff + m * 2048 + k * 1024); } while (0)
#define PG8_LDB(dst, b, h) do { _Pragma("unroll") for (int n = 0; n < 2; ++n) _Pragma("unroll") for (int k = 0; k < 2; ++k) dst[n][k] = *(const LAS bf16x8*)(lds + PG8_SB(b, h) + boff + n * 2048 + k * 1024); } while (0)
#define PG8_MMA(ai, bj, At, Bt) do { __builtin_amdgcn_s_setprio(1); _Pragma("unroll") for (int m = 0; m < 4; ++m) _Pragma("unroll") for (int n = 0; n < 2; ++n) _Pragma("unroll") for (int k = 0; k < 2; ++k) \
        acc[ai][bj][m][n] = __builtin_amdgcn_mfma_f32_16x16x32_bf16(Bt[n][k], At[m][k], acc[ai][bj][m][n], 0, 0, 0); __builtin_amdgcn_s_setprio(0); } while (0)
#define PG8_WAIT_V(n) asm volatile("s_waitcnt vmcnt(" #n ")" ::: "memory")
#define PG8_WAIT_L(n) asm volatile("s_waitcnt lgkmcnt(" #n ")" ::: "memory")
#define PG8_BAR __builtin_amdgcn_s_barrier()
#define PG8_SCHED __builtin_amdgcn_sched_barrier(0)
    Unit cur, nxt; int ui = 0;
    if (!S.next(0, cur)) return;
    f32x4 acc[2][2][4][2];
#pragma unroll
    for (int a = 0; a < 2; ++a)
#pragma unroll
        for (int b = 0; b < 2; ++b)
#pragma unroll
            for (int m = 0; m < 4; ++m)
#pragma unroll
                for (int n = 0; n < 2; ++n) acc[a][b][m][n] = (f32x4){0.f, 0.f, 0.f, 0.f};
    bf16x8 At[4][2], B0[2][2], B1[2][2];
    const char* cA = (const char*)g.A + (size_t)cur.pm * tstep; const char* cB = (const char*)g.Bt + (size_t)cur.pn * tstep;
    S.a_ready(cur);
    if constexpr (SP2) {
        PG8_STAGE(PG8_SB(0, 0), cB, voffB); PG8_STAGE(PG8_SB(0, 1), cB + hstep, voffB); PG8_STAGE(PG8_SA(0, 0), cA, voffA); PG8_STAGE(PG8_SA(0, 1), cA + hstep, voffA);
        if (wr == 1) PG8_BAR;
        PG8_WAIT_V(2); PG8_BAR;
        PG8_STAGE(PG8_SB(1, 0), cB + kstep, voffB); PG8_STAGE(PG8_SA(1, 0), cA + kstep, voffA); PG8_STAGE(PG8_SB(1, 1), cB + hstep + kstep, voffB);
        PG8_WAIT_V(6); PG8_BAR;
    } else {
        PG8_STAGE(PG8_SB(0, 0), cB, voffB); PG8_STAGE(PG8_SA(0, 0), cA, voffA); PG8_STAGE(PG8_SB(0, 1), cB + hstep, voffB); PG8_STAGE(PG8_SA(0, 1), cA + hstep, voffA);
        if (wr == 1) PG8_BAR;
        PG8_WAIT_V(4); PG8_BAR;
        PG8_STAGE(PG8_SB(1, 0), cB + kstep, voffB); PG8_STAGE(PG8_SA(1, 0), cA + kstep, voffA); PG8_STAGE(PG8_SB(1, 1), cB + hstep + kstep, voffB);
        PG8_WAIT_V(6); PG8_BAR;
    }
    for (;;) {
        const bool has_next = S.next(ui + 1, nxt);
        const char* nA = has_next ? (const char*)g.A + (size_t)nxt.pm * tstep : cA; const char* nB = has_next ? (const char*)g.Bt + (size_t)nxt.pn * tstep : cB;
        for (int t = 0; t < nt; t += 2) {
            const bool last = (t == nt - 2);
            const char* a1 = cA + (size_t)(t + 1) * kstep;
            const char* a2 = last ? nA : cA + (size_t)(t + 2) * kstep; const char* b2 = last ? nB : cB + (size_t)(t + 2) * kstep;
            const char* a3 = a2 + kstep; const char* b3 = b2 + kstep;
            if (last && has_next) S.a_ready(nxt);
            if constexpr (SP2) {
            PG8_LDB(B0, 0, 0); PG8_LDB(B1, 0, 1); PG8_SCHED; PG8_LDA(At, 0, 0); PG8_STAGE(PG8_SA(1, 1), a1 + hstep, voffA);
            PG8_WAIT_V(8); PG8_WAIT_L(0); PG8_BAR; PG8_MMA(0, 0, At, B0); PG8_MMA(0, 1, At, B1); PG8_BAR; PG8_SCHED;
            PG8_LDA(At, 0, 1); PG8_STAGE(PG8_SB(0, 0), b2, voffB); PG8_STAGE(PG8_SB(0, 1), b2 + hstep, voffB); PG8_STAGE(PG8_SA(0, 0), a2, voffA);
            PG8_WAIT_V(8); PG8_WAIT_L(0); PG8_BAR; PG8_MMA(1, 0, At, B0); PG8_MMA(1, 1, At, B1); PG8_BAR; PG8_SCHED;
            PG8_LDB(B0, 1, 0); PG8_LDB(B1, 1, 1); PG8_SCHED; PG8_LDA(At, 1, 0); PG8_STAGE(PG8_SA(0, 1), a2 + hstep, voffA);
            PG8_WAIT_V(8); PG8_WAIT_L(0); PG8_BAR; PG8_MMA(0, 0, At, B0); PG8_MMA(0, 1, At, B1); PG8_BAR; PG8_SCHED;
            PG8_LDA(At, 1, 1); PG8_STAGE(PG8_SB(1, 0), b3, voffB); PG8_STAGE(PG8_SB(1, 1), b3 + hstep, voffB); PG8_STAGE(PG8_SA(1, 0), a3, voffA);
            PG8_WAIT_V(8); PG8_WAIT_L(0); PG8_BAR; PG8_MMA(1, 0, At, B0); PG8_MMA(1, 1, At, B1); PG8_BAR; PG8_SCHED;
            } else {
            PG8_LDB(B0, 0, 0); PG8_SCHED; PG8_LDA(At, 0, 0); PG8_STAGE(PG8_SA(1, 1), a1 + hstep, voffA);
            PG8_WAIT_L(8); PG8_BAR; PG8_WAIT_L(0); PG8_MMA(0, 0, At, B0); PG8_BAR; PG8_SCHED;
            PG8_LDB(B1, 0, 1); PG8_STAGE(PG8_SB(0, 0), b2, voffB);
            PG8_BAR; PG8_WAIT_L(0); PG8_MMA(0, 1, At, B1); PG8_BAR;
            PG8_LDA(At, 0, 1); PG8_STAGE(PG8_SA(0, 0), a2, voffA);
            PG8_BAR; PG8_WAIT_L(0); PG8_MMA(1, 0, At, B0); PG8_BAR; PG8_SCHED;
            PG8_STAGE(PG8_SB(0, 1), b2 + hstep, voffB);
            PG8_WAIT_V(6); PG8_BAR; PG8_MMA(1, 1, At, B1); PG8_BAR;
            PG8_LDB(B0, 1, 0); PG8_SCHED; PG8_LDA(At, 1, 0); PG8_STAGE(PG8_SA(0, 1), a2 + hstep, voffA);
            PG8_WAIT_L(8); PG8_BAR; PG8_WAIT_L(0); PG8_MMA(0, 0, At, B0); PG8_BAR; PG8_SCHED;
            PG8_LDB(B1, 1, 1); PG8_STAGE(PG8_SB(1, 0), b3, voffB);
            PG8_BAR; PG8_WAIT_L(0); PG8_MMA(0, 1, At, B1); PG8_BAR;
            PG8_LDA(At, 1, 1); PG8_STAGE(PG8_SA(1, 0), a3, voffA);
            PG8_BAR; PG8_WAIT_L(0); PG8_MMA(1, 0, At, B0); PG8_BAR; PG8_SCHED;
            PG8_STAGE(PG8_SB(1, 1), b3 + hstep, voffB);
            PG8_WAIT_V(6); PG8_BAR; PG8_MMA(1, 1, At, B1); PG8_BAR;
            }
        }
        if constexpr (ALIGN_EPI) { if (wr == 0) PG8_BAR; }
        if constexpr (!Epi::AFTER_DRAIN) { E(acc, cur, wr, wc, fr, fq); S.done(cur); }
        if (!has_next) break;
#pragma unroll
        for (int a = 0; a < 2; ++a)
#pragma unroll
            for (int b = 0; b < 2; ++b)
#pragma unroll
                for (int m = 0; m < 4; ++m)
#pragma unroll
                    for (int n = 0; n < 2; ++n) acc[a][b][m][n] = (f32x4){0.f, 0.f, 0.f, 0.f};
        cur = nxt; cA = nA; cB = nB; ++ui;
        if constexpr (ALIGN_EPI) { if (wr == 1) PG8_BAR; }
    }
    PG8_WAIT_V(0);
    if constexpr (!ALIGN_EPI) { if (wr == 0) PG8_BAR; }
    PG8_BAR;
#undef PG8_SA
#undef PG8_SB
#undef PG8_STAGE
#undef PG8_LDA
#undef PG8_LDB
#undef PG8_MMA
#undef PG8_WAIT_V
#undef PG8_WAIT_L
#undef PG8_BAR
#undef PG8_SCHED
}
}

struct Args {
    const float* x; const float* norm_g; const float* w_in; const float* qa_g; const float* w_uq; const float* kva_g; const float* w_ukv;
    const float* dlam; const float* subg; const float* conv_w; const float* w_out; const float* rel_bias; const float* final_g;
    float* out; unsigned char* ws;
    float lambda_init[2]; int pad[2];
};

typedef const __attribute__((address_space(4))) Args* ArgsP;
__device__ __forceinline__ ArgsP get_args() { ArgsP p = (ArgsP)__builtin_amdgcn_kernarg_segment_ptr(); asm volatile("" : "+s"(p)); return p; }

#define XB_TMO      128
#define XB_XCNT(j)  (256  + 64 * (j))
#define XB_XSUB(j)  (1280 + 64 * (j))
#define XB_XGEN(j)  (2304 + 64 * (j))
#define XB_TOP      3328
#define XB_TOPGEN   3392
#define XCD_BAR_WORDS 3456
#define XB_SPIN_CAP (1u << 18)
constexpr int LDS_XB = 148464;
__device__ __forceinline__ unsigned xb_ld(unsigned* p)              { return __hip_atomic_load(p, __ATOMIC_RELAXED, __HIP_MEMORY_SCOPE_AGENT); }
__device__ __forceinline__ unsigned xb_add(unsigned* p, unsigned v) { return __hip_atomic_fetch_add(p, v, __ATOMIC_RELAXED, __HIP_MEMORY_SCOPE_AGENT); }
__device__ __forceinline__ unsigned xb_xcc_id() { return (unsigned)__builtin_amdgcn_s_getreg((3 << 11) | 20) & 0xFu; }
#define XB_SPIN(cond, bar) do { unsigned _sp = 0; while (cond) { __builtin_amdgcn_s_sleep(1); \
    if ((++_sp & 255u) == 0u) { if (xb_ld(&(bar)[XB_TMO])) break; if (_sp > XB_SPIN_CAP) { atomicAdd(&(bar)[XB_TMO], 1u); break; } } } } while (0)
__device__ __forceinline__ void xcd_barrier_complete(unsigned* bar, unsigned x, unsigned& nloc, unsigned& nx) {
    const unsigned G = gridDim.x * gridDim.y * gridDim.z;
    unsigned sum, cnt, mine, sp = 0u;
    for (;;) {
        sum = 0u; cnt = 0u; mine = 0u;
#pragma unroll
        for (unsigned j = 0; j < 16; ++j) { const unsigned c = xb_ld(&bar[XB_XCNT(j)]); sum += c; cnt += (c > 0u) ? 1u : 0u; mine = (j == x) ? c : mine; }
        if (sum == G) break;
        __builtin_amdgcn_s_sleep(1);
        if ((++sp & 255u) == 0u) { if (xb_ld(&bar[XB_TMO])) break; if (sp > XB_SPIN_CAP) { atomicAdd(&bar[XB_TMO], 1u); break; } }
    }
    nloc = mine > 0u ? mine : 1u; nx = cnt > 0u ? cnt : 1u;
}
__device__ __forceinline__ void xcd_barrier_post(LAS unsigned char* lds) {
    ArgsP A = get_args(); unsigned* bar = (unsigned*)A->ws;
    if (threadIdx.x == 0) { ((volatile LAS unsigned*)(lds + LDS_XB))[0] = 0u; ((volatile LAS unsigned*)(lds + LDS_XB))[1] = 0u;
        (void)xb_add(&bar[XB_XCNT(xb_xcc_id())], 1u); }
    __syncthreads();
}
__device__ __forceinline__ void xcd_barrier(LAS unsigned char* lds) {
    ArgsP A = get_args(); unsigned* bar = (unsigned*)A->ws;
    asm volatile("s_waitcnt vmcnt(0)" ::: "memory");
    __syncthreads();
    if (threadIdx.x == 0) {
        const unsigned x = xb_xcc_id();
        volatile LAS unsigned* st = (volatile LAS unsigned*)(lds + LDS_XB);
        __builtin_amdgcn_s_waitcnt(0);
        unsigned nloc = st[0], nx = st[1];
        if (nloc == 0u) { xcd_barrier_complete(bar, x, nloc, nx); st[0] = nloc; st[1] = nx; }
        const unsigned old = xb_add(&bar[XB_XSUB(x)], 1u);
        const unsigned gen = old / nloc;
        if (old + 1u == (gen + 1u) * nloc) {
            __builtin_amdgcn_fence(__ATOMIC_RELEASE, "agent");
            asm volatile("s_waitcnt vmcnt(0)" ::: "memory");
            const unsigned og = xb_add(&bar[XB_TOP], 1u);
            const unsigned tg = og / nx;
            if (og + 1u == (tg + 1u) * nx) xb_add(&bar[XB_TOPGEN], 1u);
            else XB_SPIN(xb_ld(&bar[XB_TOPGEN]) == tg, bar);
            __builtin_amdgcn_fence(__ATOMIC_ACQUIRE, "agent");
            xb_add(&bar[XB_XGEN(x)], 1u);
            asm volatile("s_waitcnt vmcnt(0)" ::: "memory");
        } else {
            XB_SPIN(xb_ld(&bar[XB_XGEN(x)]) == gen, bar);
            __builtin_amdgcn_fence(__ATOMIC_ACQUIRE, "agent");
            asm volatile("s_waitcnt vmcnt(0)" ::: "memory");
        }
    }
    __syncthreads();
}

constexpr float QS_MLA = 0.10206207261596575f * 1.4426950408889634f;
constexpr float QS_DIFF = 0.17677669529663687f * 1.4426950408889634f;
constexpr float QS_DSA = 0.125f * 1.4426950408889634f;
template <bool OUT_BF16>
__device__ __forceinline__ void rms_rows4(const float* xbase, size_t rstride, const float* g, bf16_t* obase, float* fbase, int lane) {
    f32x4 v[4][4]; float ss[4];
#pragma unroll
    for (int k = 0; k < 4; ++k) { const f32x4* xr = (const f32x4*)(xbase + k * rstride) + lane;
#pragma unroll
        for (int j = 0; j < 4; ++j) v[k][j] = xr[64 * j]; }
#pragma unroll
    for (int k = 0; k < 4; ++k) { float s = 0.f;
#pragma unroll
        for (int j = 0; j < 4; ++j) s += v[k][j].x * v[k][j].x + v[k][j].y * v[k][j].y + v[k][j].z * v[k][j].z + v[k][j].w * v[k][j].w;
        ss[k] = s; }
#pragma unroll
    for (int o = 1; o < 64; o <<= 1) {
#pragma unroll
        for (int k = 0; k < 4; ++k) ss[k] += __shfl_xor(ss[k], o); }
    f32x4 gv[4];
#pragma unroll
    for (int j = 0; j < 4; ++j) gv[j] = ((const f32x4*)g)[lane + 64 * j];
#pragma unroll
    for (int k = 0; k < 4; ++k) { const float r = rsqrtf(ss[k] * (1.f / D) + EPS);
#pragma unroll
        for (int j = 0; j < 4; ++j) {
            const f32x4 o = (f32x4){v[k][j].x * r * gv[j].x, v[k][j].y * r * gv[j].y, v[k][j].z * r * gv[j].z, v[k][j].w * r * gv[j].w};
            if (OUT_BF16) { u32x2 w; w.x = pg8::cvt_pk_bf16(o.x, o.y); w.y = pg8::cvt_pk_bf16(o.z, o.w); ((u32x2*)(obase + k * rstride))[lane + 64 * j] = w; }
            else ((f32x4*)(fbase + k * rstride))[lane + 64 * j] = o;
        } }
}
template <bool OUT_BF16>
__device__ __forceinline__ void rms_rows4b(const bf16_t* xbase, size_t rstride, const float* g, bf16_t* obase, float* fbase, int lane) {
    u16x8 v[4][2]; float ss[4];
#pragma unroll
    for (int k = 0; k < 4; ++k) { const u16x8* xr = (const u16x8*)(xbase + k * rstride) + lane;
#pragma unroll
        for (int j = 0; j < 2; ++j) v[k][j] = xr[64 * j]; }
#pragma unroll
    for (int k = 0; k < 4; ++k) { float s = 0.f;
#pragma unroll
        for (int j = 0; j < 2; ++j)
#pragma unroll
            for (int e = 0; e < 8; ++e) { const float f = bf2f(v[k][j][e]); s += f * f; }
        ss[k] = s; }
#pragma unroll
    for (int o = 1; o < 64; o <<= 1) {
#pragma unroll
        for (int k = 0; k < 4; ++k) ss[k] += __shfl_xor(ss[k], o); }
    f32x4 gv[2][2];
#pragma unroll
    for (int j = 0; j < 2; ++j) { gv[j][0] = ((const f32x4*)g)[2 * lane + 128 * j]; gv[j][1] = ((const f32x4*)g)[2 * lane + 1 + 128 * j]; }
#pragma unroll
    for (int k = 0; k < 4; ++k) { const float r = rsqrtf(ss[k] * (1.f / D) + EPS);
#pragma unroll
        for (int j = 0; j < 2; ++j) {
            f32x4 o0, o1;
#pragma unroll
            for (int e = 0; e < 4; ++e) { o0[e] = bf2f(v[k][j][e]) * r * gv[j][0][e]; o1[e] = bf2f(v[k][j][4 + e]) * r * gv[j][1][e]; }
            if (OUT_BF16) { u32x4 w; w.x = pg8::cvt_pk_bf16(o0[0], o0[1]); w.y = pg8::cvt_pk_bf16(o0[2], o0[3]); w.z = pg8::cvt_pk_bf16(o1[0], o1[1]); w.w = pg8::cvt_pk_bf16(o1[2], o1[3]);
                ((u32x4*)(obase + k * rstride))[lane + 64 * j] = w; }
            else { ((f32x4*)(fbase + k * rstride))[2 * lane + 128 * j] = o0; ((f32x4*)(fbase + k * rstride))[2 * lane + 1 + 128 * j] = o1; }
        } }
}
__device__ __forceinline__ void convert_tile(LAS float* scr, const float* W, bf16_t* Wt, int K, int Nsrc, int remap, float uscale, int k0, int n0, int tid) {
    __syncthreads();
#pragma unroll
    for (int i = 0; i < 8; ++i) { const int e = tid + 512 * i, kk = e >> 6, nn = e & 63, n = n0 + nn;
        const int sc = remap ? orig_col(n) : n;
        float s = uscale;
        if (remap) { if (n >= CB_Q && n < CB_Q + 256) s = QS_DIFF; if (n >= CC_Q && n < CC_Q + 256) s = QS_DSA; }
        scr[kk * 65 + nn] = (sc >= 0) ? W[(size_t)(k0 + kk) * Nsrc + sc] * s : 0.f; }
    __syncthreads();
    { const int nn = tid >> 3, kc = (tid & 7) * 8;
        u32x4 w; w.x = pg8::cvt_pk_bf16(scr[(kc + 0) * 65 + nn], scr[(kc + 1) * 65 + nn]); w.y = pg8::cvt_pk_bf16(scr[(kc + 2) * 65 + nn], scr[(kc + 3) * 65 + nn]);
        w.z = pg8::cvt_pk_bf16(scr[(kc + 4) * 65 + nn], scr[(kc + 5) * 65 + nn]); w.w = pg8::cvt_pk_bf16(scr[(kc + 6) * 65 + nn], scr[(kc + 7) * 65 + nn]);
        *(u32x4*)(Wt + (size_t)(n0 + nn) * K + k0 + kc) = w; }
}
namespace fa {
typedef short ps16x2 __attribute__((ext_vector_type(2)));
typedef unsigned short pu16x2 __attribute__((ext_vector_type(2)));
__device__ __forceinline__ unsigned ppk_lt(unsigned v, unsigned c) { const ps16x2 d = __builtin_elementwise_sub_sat(__builtin_bit_cast(ps16x2, v), __builtin_bit_cast(ps16x2, c)); return __builtin_bit_cast(unsigned, __builtin_bit_cast(pu16x2, d) >> 15); }
__device__ __forceinline__ unsigned ppk_add(unsigned a, unsigned b) { return __builtin_bit_cast(unsigned, __builtin_bit_cast(pu16x2, a) + __builtin_bit_cast(pu16x2, b)); }
typedef float f32x16 __attribute__((ext_vector_type(16)));
typedef short s16x4 __attribute__((ext_vector_type(4)));
typedef short v4i16_t __attribute__((ext_vector_type(4)));
constexpr int KCS = 1040;
constexpr int KBUF = 12 * KCS + 64;
constexpr int L_K0 = 0, L_V0 = 4 * KBUF, L_WSF = L_V0 + 4 * 8192, L_BIAS = L_WSF + 8 * 256, L_END = L_BIAS + 12 * 320 * 4, L_FLAG = L_END;
constexpr float THR = 6.0f;
constexpr float LOG2E = 1.4426950408889634f;
__device__ __forceinline__ int crow(int r, int hi) { return (r & 3) + 8 * (r >> 2) + 4 * hi; }
__device__ __forceinline__ unsigned cvtpk(float lo, float hi) { typedef float f2 __attribute__((ext_vector_type(2))); typedef __bf16 b2 __attribute__((ext_vector_type(2)));
    f2 v = {lo, hi}; b2 r = __builtin_convertvector(v, b2); return __builtin_bit_cast(unsigned, r); }
__device__ __forceinline__ s16x4 vtr(const LAS unsigned char* p) { return __builtin_bit_cast(s16x4, __builtin_amdgcn_ds_read_tr16_b64_v4i16((LAS v4i16_t*)p)); }
__device__ __forceinline__ float max3f(float a, float b, float c) { float r; asm("v_max3_f32 %0, %1, %2, %3" : "=v"(r) : "v"(a), "v"(b), "v"(c)); return r; }
__device__ __forceinline__ float max2f(float a, float b) { float r; asm("v_max_f32_e32 %0, %1, %2" : "=v"(r) : "v"(a), "v"(b)); return r; }
#define FA_ROWMAX(rm, S0, S1) do { asm volatile("s_nop 15\n\ts_nop 7" : "+v"(S0), "+v"(S1)); \
        float a_ = max3f(S0[0], S0[1], S1[0]), b_ = max3f(S0[2], S0[3], S1[1]); a_ = max3f(a_, S1[2], S1[3]); \
        _Pragma("unroll") for (int r = 4; r < 16; r += 4) { a_ = max3f(a_, S0[r], S0[r + 1]); b_ = max3f(b_, S0[r + 2], S0[r + 3]); a_ = max3f(a_, S1[r], S1[r + 1]); b_ = max3f(b_, S1[r + 2], S1[r + 3]); } \
        rm = max2f(a_, b_); } while (0)
__device__ __forceinline__ float xhalf_max(float v) { auto rr = __builtin_amdgcn_permlane32_swap(__float_as_uint(v), __float_as_uint(v), false, false); return fmaxf(__uint_as_float(rr[0]), __uint_as_float(rr[1])); }
__device__ __forceinline__ float xhalf_sum(float v) { auto rr = __builtin_amdgcn_permlane32_swap(__float_as_uint(v), __float_as_uint(v), false, false); return __uint_as_float(rr[0]) + __uint_as_float(rr[1]); }

__device__ __forceinline__ void build_bias(LAS unsigned char* lds, const float* rel_bias) {
    LAS float* bt = (LAS float*)(lds + L_BIAS);
    for (int e = opaque_tid(); e < 12 * 320; e += NTHR) { const int col = e / 320, i = e % 320;
        bt[e] = (rel_bias[rel_bucket(i - 256) * 12 + col] - rel_bias[15 * 12 + col]) * LOG2E; }
}

template <int TYPE>
__device__ __forceinline__ void attn_unit(LAS unsigned char* lds, int b, int h, int qb, int layer) {
    ArgsP A = get_args();
    unsigned char* ws = A->ws;
    const bf16_t* P = (const bf16_t*)(ws + WS_P);
    const int tid = opaque_tid(), lane = tid & 63, r32 = lane & 31, hi = lane >> 5, wid = __builtin_amdgcn_readfirstlane(tid >> 6);
    constexpr int DK = (TYPE == 0) ? 96 : 64, NCH = DK / 8, NPASS = (TYPE == 1) ? 2 : 1, DQ = (TYPE == 0) ? 96 : (TYPE == 1) ? 32 : 64, NQF = DQ / 16;
    const size_t row0 = (size_t)b * S;
    const bf16_t* Kg; const bf16_t* Vg; int kpitch, vpitch;
    if (TYPE == 0) { Kg = (const bf16_t*)(ws + WS_KA) + row0 * 384 + h * 96; kpitch = 384; Vg = (const bf16_t*)(ws + WS_VA) + row0 * 256 + h * 64; vpitch = 256; }
    else { Kg = P + row0 * PC + ((TYPE == 1) ? CB_K : CC_K) + h * 64; kpitch = PC; Vg = P + row0 * PC + ((TYPE == 1) ? CB_V : CC_V) + h * 64; vpitch = PC; }
    const int k0key = tid / NCH, k0ch = tid % NCH;
    const int k1key = (tid + 512) / NCH, k1ch = (tid + 512) % NCH;
    const bool has_k1 = (NCH == 12) && (tid < 256);
    const int vkey = tid >> 3, vc8 = tid & 7;
    const bf16_t* kg0 = Kg + (size_t)k0key * kpitch + k0ch * 8;
    const bf16_t* kg1 = Kg + (size_t)k1key * kpitch + k1ch * 8;
    const bf16_t* vg0 = Vg + (size_t)vkey * vpitch + vc8 * 8;
    const int kl0 = k0ch * KCS + k0key * 16, kl1 = k1ch * KCS + k1key * 16;
    const int vl0 = ((vc8 >> 2) * 4 + (vkey >> 4)) * 1024 + (vkey & 15) * 64 + (vc8 & 3) * 16;
    const int qw = qb * 256 + wid * 32;
    const size_t tq = row0 + qw + r32;
    const int NT = 4 * qb + 4, NTw = 4 * qb + (wid >> 1) + 1, TM = 4 * qb;
    LAS float* wsf = (LAS float*)(lds + L_WSF) + wid * 64;
    const LAS unsigned char* vfb = lds + L_V0 + ((lane >> 4) & 1) * 32 + (lane & 3) * 8 + (4 * hi + ((lane & 15) >> 2)) * 64;
    const unsigned* mrow = (const unsigned*)(ws + WS_MASK) + tq * 128;
    float* okl = (float*)(ws + WS_OKL) + ((size_t)opaque_bid() * 8 + wid) * 2048 + lane;
    f32x16 o0 = f32x16{}, o1 = f32x16{};
    float mhat = 0.f, lsum = 0.f;
    int fast = 1; asm volatile("" : "+s"(fast));
#pragma unroll 1
    for (;;) {
#pragma unroll 1
    for (int mp = 0; mp < NPASS; ++mp) {
    bf16x8 qf[NQF];
#pragma unroll
    for (int d0 = 0; d0 < NQF; ++d0) {
        const bf16_t* qp = (TYPE == 0) ? (const bf16_t*)(ws + WS_QA) + tq * 384 + h * 96 + 16 * d0 + 8 * hi
                                       : P + tq * PC + ((TYPE == 1) ? CB_Q + mp * 32 : CC_Q) + h * 64 + 16 * d0 + 8 * hi;
        qf[d0] = *(const bf16x8*)qp;
    }
    mhat = 0.f; lsum = 0.f; o0 = f32x16{}; o1 = f32x16{};
    const LAS unsigned char* kfb = lds + L_K0 + hi * KCS + r32 * 16 + ((TYPE == 1) ? mp * 4 * KCS : 0);
    const LAS unsigned char* btb = lds + L_BIAS + (256 + 4 * hi - r32 - qw) * 4 + ((TYPE == 1) ? 2 * h + mp : 8 + h) * 1280;
    u32x4 kr0, kr1, vr;
    const bf16_t* kp0 = kg0; const bf16_t* kp1 = kg1; const bf16_t* vp0 = vg0;
    const size_t kstep = (size_t)64 * kpitch, vstep = (size_t)64 * vpitch;
#define FA_BIAS(S0, S1, t) do { if (TYPE != 0) { if (64 * (t) > qw - 154) { const LAS float* bt = (const LAS float*)(btb + (t) * 256); \
            _Pragma("unroll") for (int r = 0; r < 16; ++r) { S0[r] += bt[(r & 3) + 8 * (r >> 2)]; S1[r] += bt[32 + (r & 3) + 8 * (r >> 2)]; } } } } while (0)
#define FA_RESCALE(S0, S1, t) do { if (fast) break; \
        float rm; FA_ROWMAX(rm, S0, S1); \
        rm = xhalf_max(rm); \
        const bool first = ((t) == 0); \
        if (__any(first || rm > THR)) { \
            const float dl = first ? fmaxf(rm, -64.f) : fmaxf(rm, 0.f);     \
            mhat += dl; \
            _Pragma("unroll") for (int r = 0; r < 16; ++r) { S0[r] -= dl; S1[r] -= dl; } \
            if (!first) { const float f = __builtin_amdgcn_exp2f(-dl); lsum *= f; \
                if (hi == 0) wsf[r32] = f; \
                _Pragma("unroll") for (int r = 0; r < 16; ++r) { const float fr_ = wsf[crow(r, hi)]; o0[r] *= fr_; o1[r] *= fr_; } \
                asm volatile("" ::: "memory"); } \
        } } while (0)
#define FA_EXP(S0, S1) do { float sacc = 0.f; \
        _Pragma("unroll") for (int r = 0; r < 16; ++r) { \
            S0[r] = __builtin_amdgcn_exp2f(S0[r]); S1[r] = __builtin_amdgcn_exp2f(S1[r]); \
            sacc += S0[r] + S1[r]; } \
        lsum += sacc; \
        _Pragma("unroll") for (int i = 0; i < 4; ++i) { pw[0][i] = cvtpk(S0[2 * i], S0[2 * i + 1]); pw[1][i] = cvtpk(S0[8 + 2 * i], S0[8 + 2 * i + 1]); \
                                                       pw[2][i] = cvtpk(S1[2 * i], S1[2 * i + 1]); pw[3][i] = cvtpk(S1[8 + 2 * i], S1[8 + 2 * i + 1]); } } while (0)
#define FA_PV() do { \
        _Pragma("unroll") for (int ks = 0; ks < 4; ++ks) { const bf16x8 vfrag = (bf16x8){vlo_[ks][0], vlo_[ks][1], vlo_[ks][2], vlo_[ks][3], vhi_[ks][0], vhi_[ks][1], vhi_[ks][2], vhi_[ks][3]}; \
            o0 = __builtin_amdgcn_mfma_f32_32x32x16_bf16(__builtin_bit_cast(bf16x8, pw[ks]), vfrag, o0, 0, 0, 0); } \
        _Pragma("unroll") for (int i = 0; i < 4; ++i) { vlo_[i] = vtr(vb_ + (4 + i) * 1024); vhi_[i] = vtr(vb_ + (4 + i) * 1024 + 512); } \
        _Pragma("unroll") for (int ks = 0; ks < 4; ++ks) { const bf16x8 vfrag = (bf16x8){vlo_[ks][0], vlo_[ks][1], vlo_[ks][2], vlo_[ks][3], vhi_[ks][0], vhi_[ks][1], vhi_[ks][2], vhi_[ks][3]}; \
            o1 = __builtin_amdgcn_mfma_f32_32x32x16_bf16(__builtin_bit_cast(bf16x8, pw[ks]), vfrag, o1, 0, 0, 0); } } while (0)
#define FA_KLOAD(ks_off) do { const LAS unsigned char* kb_ = kfb + (ks_off); \
        _Pragma("unroll") for (int d0 = 0; d0 < NQF; ++d0) { ka_[d0][0] = *(const LAS bf16x8*)(kb_ + d0 * 2 * KCS); ka_[d0][1] = *(const LAS bf16x8*)(kb_ + d0 * 2 * KCS + 512); } } while (0)
#define FA_QKMFMA(N0, N1, tt, MW0, MW1) do { \
        if (TYPE == 2) { const unsigned w0_ = MW0 >> (4 * hi), w1_ = MW1 >> (4 * hi); const unsigned nm_ = __float_as_uint(-mhat); unsigned neg_ = 0xF149F2CAu; asm volatile("" : "+v"(neg_)); \
            _Pragma("unroll") for (int r = 0; r < 16; ++r) { const int pos_ = (r & 3) + 8 * (r >> 2); \
                const unsigned k0m = (unsigned)((int)(w0_ << (31 - pos_)) >> 31), k1m = (unsigned)((int)(w1_ << (31 - pos_)) >> 31); \
                N0[r] = __uint_as_float(__builtin_amdgcn_bitop3_b32(k0m, nm_, neg_, 0xCA)); N1[r] = __uint_as_float(__builtin_amdgcn_bitop3_b32(k1m, nm_, neg_, 0xCA)); } }     \
        else if (fast) { N0 = __builtin_amdgcn_mfma_f32_32x32x16_bf16(ka_[0][0], qf[0], f32x16{}, 0, 0, 0); N1 = __builtin_amdgcn_mfma_f32_32x32x16_bf16(ka_[0][1], qf[0], f32x16{}, 0, 0, 0); } \
        else { const float nm_ = -mhat; N0 = (f32x16){nm_, nm_, nm_, nm_, nm_, nm_, nm_, nm_, nm_, nm_, nm_, nm_, nm_, nm_, nm_, nm_}; N1 = N0; \
            N0 = __builtin_amdgcn_mfma_f32_32x32x16_bf16(ka_[0][0], qf[0], N0, 0, 0, 0); N1 = __builtin_amdgcn_mfma_f32_32x32x16_bf16(ka_[0][1], qf[0], N1, 0, 0, 0); } \
        _Pragma("unroll") for (int d0 = (TYPE == 2) ? 0 : 1; d0 < NQF; ++d0) { \
            N0 = __builtin_amdgcn_mfma_f32_32x32x16_bf16(ka_[d0][0], qf[d0], N0, 0, 0, 0); \
            N1 = __builtin_amdgcn_mfma_f32_32x32x16_bf16(ka_[d0][1], qf[d0], N1, 0, 0, 0); } } while (0)
#define FA_VLOAD(vs_off) const LAS unsigned char* vb_ = vfb + (vs_off); \
        _Pragma("unroll") for (int i = 0; i < 4; ++i) { vlo_[i] = vtr(vb_ + i * 1024); vhi_[i] = vtr(vb_ + i * 1024 + 512); }
#define FA_MASKW(t)
#define FA_STEP_U(C0, C1, N0, N1, t, vs_off, nks_off, MW0, MW1) do { \
        bf16x8 ka_[NQF][2]; s16x4 vlo_[4], vhi_[4]; u32x4 pw[4]; \
        FA_KLOAD(nks_off); FA_VLOAD(vs_off); FA_MASKW(t); \
        FA_BIAS(C0, C1, t); FA_RESCALE(C0, C1, t); \
        FA_QKMFMA(N0, N1, (t) + 1, MW0, MW1); FA_EXP(C0, C1); FA_PV(); } while (0)
#define FA_STEP_C(C0, C1, N0, N1, t, vs_off, nks_off, MW0, MW1) do { \
        if ((t) + 1 < NTw) { bf16x8 ka_[NQF][2]; FA_KLOAD(nks_off); FA_QKMFMA(N0, N1, (t) + 1, MW0, MW1); } \
        if ((t) < NTw) { s16x4 vlo_[4], vhi_[4]; u32x4 pw[4]; FA_VLOAD(vs_off); FA_MASKW(t); \
            FA_BIAS(C0, C1, t); \
            if (!fast) { float rm; FA_ROWMAX(rm, C0, C1); \
              rm = xhalf_max(rm); \
              const bool first = ((t) == 0); \
              if (__any(first || rm > THR)) { \
                const float dl = first ? fmaxf(rm, -64.f) : fmaxf(rm, 0.f);     \
                mhat += dl; \
                _Pragma("unroll") for (int r = 0; r < 16; ++r) { C0[r] -= dl; C1[r] -= dl; N0[r] -= dl; N1[r] -= dl; } \
                if (!first) { const float f = __builtin_amdgcn_exp2f(-dl); lsum *= f; \
                    if (hi == 0) wsf[r32] = f; \
                    _Pragma("unroll") for (int r = 0; r < 16; ++r) { const float fr_ = wsf[crow(r, hi)]; o0[r] *= fr_; o1[r] *= fr_; } \
                    asm volatile("" ::: "memory"); } } } \
            FA_EXP(C0, C1); FA_PV(); } } while (0)
#define FA_LOADKV(tk, tv) do { if (FA_UNC || (tk) < NT) { kr0 = *(const u32x4*)kp0; if (has_k1) kr1 = *(const u32x4*)kp1; kp0 += kstep; kp1 += kstep; } \
        if (FA_UNC || (tv) < NT) { vr = *(const u32x4*)vp0; vp0 += vstep; } } while (0)
#define FA_COMMIT(tk, kslot, tv, vslot) do { if (FA_UNC || (tk) < NT) { *(LAS u32x4*)(lds + L_K0 + (kslot) + kl0) = kr0; if (has_k1) *(LAS u32x4*)(lds + L_K0 + (kslot) + kl1) = kr1; } \
        if (FA_UNC || (tv) < NT) *(LAS u32x4*)(lds + L_V0 + (vslot) + vl0) = vr; } while (0)
#define FA_UNC 0
    {
        FA_LOADKV(0, 0);
        const u32x4 ka0 = kr0, ka1 = kr1, va = vr;
        FA_LOADKV(1, 1);
        const u32x4 kb0 = kr0, kb1 = kr1, vb = vr;
        FA_LOADKV(2, NT);
        __syncthreads();
        *(LAS u32x4*)(lds + L_K0 + kl0) = ka0; if (has_k1) *(LAS u32x4*)(lds + L_K0 + kl1) = ka1; *(LAS u32x4*)(lds + L_V0 + vl0) = va;
        *(LAS u32x4*)(lds + L_K0 + KBUF + kl0) = kb0; if (has_k1) *(LAS u32x4*)(lds + L_K0 + KBUF + kl1) = kb1; *(LAS u32x4*)(lds + L_V0 + 8192 + vl0) = vb;
        FA_COMMIT(2, 2 * KBUF, NT, 0);
        if (fast && mp == 0 && tid == 0) *(volatile LAS unsigned*)(lds + L_FLAG) = 0u;
    }
    __syncthreads();
    f32x16 sA0, sA1, sB0, sB1;
    unsigned mwA0 = 0u, mwA1 = 0u, mwB0 = 0u, mwB1 = 0u;
#define FA_MLOAD(W0, W1, tt) do { if (TYPE == 2 && (FA_UNC || (tt) < NT)) { W0 = mrow[2 * (tt)]; W1 = mrow[2 * (tt) + 1]; } } while (0)
    FA_MLOAD(mwA0, mwA1, 0); FA_MLOAD(mwB0, mwB1, 1);
    { bf16x8 ka_[NQF][2]; FA_KLOAD(0); FA_QKMFMA(sA0, sA1, 0, mwA0, mwA1); }
    __syncthreads();
#pragma unroll
    for (int r = 0; r < 16; ++r) { sB0[r] = 0.f; sB1[r] = 0.f; }
#define FA_KS(tt) ((((tt)) & 3) * KBUF)
#define FA_VS(tt) ((((tt)) & 3) * 8192)
    int t = 0;
#undef FA_UNC
#define FA_UNC 1
    for (; t < TM; t += 2) {
        FA_LOADKV(t + 3, t + 2); FA_MLOAD(mwA0, mwA1, t + 2);
        FA_STEP_U(sA0, sA1, sB0, sB1, t, FA_VS(t), FA_KS(t + 1), mwB0, mwB1);
        FA_COMMIT(t + 3, FA_KS(t + 3), t + 2, FA_VS(t + 2));
        FA_LOADKV(t + 4, t + 3); FA_MLOAD(mwB0, mwB1, t + 3);
        FA_STEP_U(sB0, sB1, sA0, sA1, t + 1, FA_VS(t + 1), FA_KS(t + 2), mwA0, mwA1);
        FA_COMMIT(t + 4, FA_KS(t + 4), t + 3, FA_VS(t + 3));
        __syncthreads();
    }
#undef FA_UNC
#define FA_UNC 0
    for (; t < NT; t += 2) {
        FA_LOADKV(t + 3, t + 2); FA_MLOAD(mwA0, mwA1, t + 2);
        FA_STEP_C(sA0, sA1, sB0, sB1, t, FA_VS(t), FA_KS(t + 1), mwB0, mwB1);
        FA_COMMIT(t + 3, FA_KS(t + 3), t + 2, FA_VS(t + 2));
        FA_LOADKV(t + 4, t + 3); FA_MLOAD(mwB0, mwB1, t + 3);
        FA_STEP_C(sB0, sB1, sA0, sA1, t + 1, FA_VS(t + 1), FA_KS(t + 2), mwA0, mwA1);
        FA_COMMIT(t + 4, FA_KS(t + 4), t + 3, FA_VS(t + 3));
        __syncthreads();
    }
#undef FA_KS
#undef FA_UNC
#undef FA_MLOAD
#undef FA_VS
#undef FA_BIAS
#undef FA_RESCALE
#undef FA_EXP
#undef FA_PV
#undef FA_KLOAD
#undef FA_QKMFMA
#undef FA_VLOAD
#undef FA_MASKW
#undef FA_STEP_U
#undef FA_STEP_C
#undef FA_LOADKV
#undef FA_COMMIT
    {
        const float lt = xhalf_sum(lsum);
        if (fast) { if (!(lt >= 0x1p-90f && lt <= 0x1p90f)) *(volatile LAS unsigned*)(lds + L_FLAG) = 1u; }
        if (hi == 0) wsf[32 + r32] = __builtin_amdgcn_rcpf(lt);
#pragma unroll
        for (int r = 0; r < 16; ++r) { const float iv = wsf[32 + crow(r, hi)]; o0[r] *= iv; o1[r] *= iv; }
        asm volatile("" ::: "memory");
    }
    if (TYPE == 1 && mp == 0) {
#pragma unroll
        for (int r = 0; r < 16; ++r) { okl[r * 64] = o0[r]; okl[(16 + r) * 64] = o1[r]; }
    }
    }
    if (!fast) break;
    __syncthreads();
    if (__builtin_amdgcn_readfirstlane(*(volatile LAS unsigned*)(lds + L_FLAG)) == 0u) break;
    fast = 0;
    }
    const int gcol = (TYPE == 0) ? CA_G : (TYPE == 1) ? CB_G : CC_G;
    bf16_t* Y = (bf16_t*)(ws + WS_Y);
    float gs0[16], gs1[16];
    {
        bf16_t gr0[16], gr1[16];
#pragma unroll
        for (int r = 0; r < 16; ++r) { const bf16_t* gp = P + (row0 + qw + crow(r, hi)) * PC + gcol + h * 64; gr0[r] = gp[r32]; gr1[r] = gp[32 + r32]; }
#pragma unroll
        for (int r = 0; r < 16; ++r) { const float a0 = bf2f(gr0[r]), a1 = bf2f(gr1[r]);
            gs0[r] = a0 * __builtin_amdgcn_rcpf(1.f + __expf(-a0)); gs1[r] = a1 * __builtin_amdgcn_rcpf(1.f + __expf(-a1)); }
    }
    if (TYPE == 1) {
        const float* lamp = A->dlam + layer * 128;
        float s1 = 0.f, s2 = 0.f;
        for (int i = 0; i < 32; ++i) { s1 += lamp[i] * lamp[32 + i]; s2 += lamp[64 + i] * lamp[96 + i]; }
        const float lambda_init = A->lambda_init[layer];
        const float lam = __expf(s1) - __expf(s2) + lambda_init;
        const float g0 = A->subg[layer * 64 + r32], g1 = A->subg[layer * 64 + 32 + r32];
#pragma unroll
        for (int r = 0; r < 16; ++r) {
            const float v0 = okl[r * 64] - lam * o0[r];
            const float v1 = okl[(16 + r) * 64] - lam * o1[r];
            float ss = v0 * v0 + v1 * v1;
#pragma unroll
            for (int off = 1; off < 32; off <<= 1) ss += __shfl_xor(ss, off);
            const float rr = rsqrtf(ss * (1.f / 64.f) + EPS) * (1.f - lambda_init);
            bf16_t* yp = Y + (row0 + qw + crow(r, hi)) * D + 256 + h * 64;
            yp[r32] = f2bf(v0 * rr * g0 * gs0[r]);
            yp[32 + r32] = f2bf(v1 * rr * g1 * gs1[r]);
        }
    } else {
#pragma unroll
        for (int r = 0; r < 16; ++r) {
            bf16_t* yp = Y + (row0 + qw + crow(r, hi)) * D + TYPE * 256 + h * 64;
            yp[r32] = f2bf(o0[r] * gs0[r]);
            yp[32 + r32] = f2bf(o1[r] * gs1[r]);
        }
    }
}
__device__ __forceinline__ void attn_unit_diff(LAS unsigned char* lds, int b, int h, int qb, int layer) {
    ArgsP A = get_args();
    unsigned char* ws = A->ws;
    const bf16_t* P = (const bf16_t*)(ws + WS_P);
    const int tid = opaque_tid(), lane = tid & 63, r32 = lane & 31, hi = lane >> 5, wid = __builtin_amdgcn_readfirstlane(tid >> 6);
    const size_t row0 = (size_t)b * S;
    const int skey = tid >> 3, sch = tid & 7;
    const bf16_t* kg0 = P + (row0 + skey) * PC + CB_K + h * 64 + sch * 8;
    const bf16_t* vg0 = P + (row0 + skey) * PC + CB_V + h * 64 + sch * 8;
    const int kl0 = sch * KCS + skey * 16;
    const int vl0 = ((sch >> 2) * 4 + (skey >> 4)) * 1024 + (skey & 15) * 64 + (sch & 3) * 16;
    const int qw = qb * 256 + wid * 32;
    const size_t tq = row0 + qw + r32;
    const int NT = 4 * qb + 4, NTw = 4 * qb + (wid >> 1) + 1, TM = 4 * qb;
    LAS float* wsf = (LAS float*)(lds + L_WSF) + wid * 64;
    const LAS unsigned char* vfb = lds + L_V0 + ((lane >> 4) & 1) * 32 + (lane & 3) * 8 + (4 * hi + ((lane & 15) >> 2)) * 64;
    const LAS unsigned char* kfA = lds + L_K0 + hi * KCS + r32 * 16;
    const LAS unsigned char* kfB = kfA + 4 * KCS;
    const LAS unsigned char* btA = lds + L_BIAS + (256 + 4 * hi - r32 - qw) * 4 + (2 * h) * 1280;
    const LAS unsigned char* btB = btA + 1280;
    bf16x8 qA[2], qB[2];
#pragma unroll
    for (int d0 = 0; d0 < 2; ++d0) { qA[d0] = *(const bf16x8*)(P + tq * PC + CB_Q + h * 64 + 16 * d0 + 8 * hi); qB[d0] = *(const bf16x8*)(P + tq * PC + CB_Q + 32 + h * 64 + 16 * d0 + 8 * hi); }
    f32x16 oA0, oA1, oB0, oB1;
    float mA, mB, lA, lB;
    const size_t tstep = (size_t)64 * PC;
    int fast = 1; asm volatile("" : "+s"(fast));
#define DF_KS(tt) ((((tt)) & 3) * KBUF)
#define DF_VS(tt) ((((tt)) & 3) * 8192)
#define DF_QK(N0, N1, KF, ks_off, QF, MH) do { const LAS unsigned char* kb_ = (KF) + (ks_off); \
        const bf16x8 k00 = *(const LAS bf16x8*)kb_, k01 = *(const LAS bf16x8*)(kb_ + 512), k10 = *(const LAS bf16x8*)(kb_ + 2 * KCS), k11 = *(const LAS bf16x8*)(kb_ + 2 * KCS + 512); \
        if (fast) { N0 = __builtin_amdgcn_mfma_f32_32x32x16_bf16(k00, QF[0], f32x16{}, 0, 0, 0); N1 = __builtin_amdgcn_mfma_f32_32x32x16_bf16(k01, QF[0], f32x16{}, 0, 0, 0); } \
        else { const float nm_ = -(MH); N0 = (f32x16){nm_, nm_, nm_, nm_, nm_, nm_, nm_, nm_, nm_, nm_, nm_, nm_, nm_, nm_, nm_, nm_}; N1 = N0; \
            N0 = __builtin_amdgcn_mfma_f32_32x32x16_bf16(k00, QF[0], N0, 0, 0, 0); N1 = __builtin_amdgcn_mfma_f32_32x32x16_bf16(k01, QF[0], N1, 0, 0, 0); } \
        N0 = __builtin_amdgcn_mfma_f32_32x32x16_bf16(k10, QF[1], N0, 0, 0, 0); N1 = __builtin_amdgcn_mfma_f32_32x32x16_bf16(k11, QF[1], N1, 0, 0, 0); } while (0)
#define DF_SOFTMAX(S0, S1, O0, O1, MH, LS, BT, WOFF, t, PW) do { \
        if (64 * (t) > qw - 154) { const LAS float* bt = (const LAS float*)((BT) + (t) * 256); \
            _Pragma("unroll") for (int r = 0; r < 16; ++r) { S0[r] += bt[(r & 3) + 8 * (r >> 2)]; S1[r] += bt[32 + (r & 3) + 8 * (r >> 2)]; } } \
        if (!fast) { float rm; FA_ROWMAX(rm, S0, S1); rm = xhalf_max(rm); const bool first = ((t) == 0); \
            if (__any(first || rm > THR)) { const float dl = first ? fmaxf(rm, -64.f) : fmaxf(rm, 0.f); MH += dl; \
                _Pragma("unroll") for (int r = 0; r < 16; ++r) { S0[r] -= dl; S1[r] -= dl; } \
                if (!first) { const float f = __builtin_amdgcn_exp2f(-dl); LS *= f; if (hi == 0) wsf[(WOFF) + r32] = f; \
                    _Pragma("unroll") for (int r = 0; r < 16; ++r) { const float fr_ = wsf[(WOFF) + crow(r, hi)]; O0[r] *= fr_; O1[r] *= fr_; } \
                    asm volatile("" ::: "memory"); } } } \
        { float sacc = 0.f; \
          _Pragma("unroll") for (int r = 0; r < 16; ++r) { S0[r] = __builtin_amdgcn_exp2f(S0[r]); S1[r] = __builtin_amdgcn_exp2f(S1[r]); sacc += S0[r] + S1[r]; } \
          LS += sacc; } \
        _Pragma("unroll") for (int i = 0; i < 4; ++i) { PW[0][i] = cvtpk(S0[2 * i], S0[2 * i + 1]); PW[1][i] = cvtpk(S0[8 + 2 * i], S0[8 + 2 * i + 1]); \
                                                       PW[2][i] = cvtpk(S1[2 * i], S1[2 * i + 1]); PW[3][i] = cvtpk(S1[8 + 2 * i], S1[8 + 2 * i + 1]); } } while (0)
#define DF_VLOAD(vs_off, G0) do { const LAS unsigned char* vb_ = vfb + (vs_off); \
        _Pragma("unroll") for (int i = 0; i < 4; ++i) { vlo_[i] = vtr(vb_ + ((G0) + i) * 1024); vhi_[i] = vtr(vb_ + ((G0) + i) * 1024 + 512); } } while (0)
#define DF_PV(O0, O1, PW, vs_off) do { \
        DF_VLOAD(vs_off, 0); \
        _Pragma("unroll") for (int ks = 0; ks < 4; ++ks) { const bf16x8 vf = (bf16x8){vlo_[ks][0], vlo_[ks][1], vlo_[ks][2], vlo_[ks][3], vhi_[ks][0], vhi_[ks][1], vhi_[ks][2], vhi_[ks][3]}; \
            O0 = __builtin_amdgcn_mfma_f32_32x32x16_bf16(__builtin_bit_cast(bf16x8, PW[ks]), vf, O0, 0, 0, 0); } \
        DF_VLOAD(vs_off, 4); \
        _Pragma("unroll") for (int ks = 0; ks < 4; ++ks) { const bf16x8 vf = (bf16x8){vlo_[ks][0], vlo_[ks][1], vlo_[ks][2], vlo_[ks][3], vhi_[ks][0], vhi_[ks][1], vhi_[ks][2], vhi_[ks][3]}; \
            O1 = __builtin_amdgcn_mfma_f32_32x32x16_bf16(__builtin_bit_cast(bf16x8, PW[ks]), vf, O1, 0, 0, 0); } } while (0)
#define DF_STEP(COND, t) do { \
        if (!(COND) || (t) + 2 < NT) { kr = *(const u32x4*)kp; kp += tstep; } \
        if (!(COND) || (t) + 1 < NT) { vr = *(const u32x4*)vp; vp += tstep; } \
        if (!(COND) || (t) < NTw) { s16x4 vlo_[4], vhi_[4]; u32x4 pw[4]; \
            DF_QK(sB0, sB1, kfB, DF_KS(t), qB, mB); \
            DF_SOFTMAX(sA0, sA1, oA0, oA1, mA, lA, btA, 0, t, pw); \
            DF_PV(oA0, oA1, pw, DF_VS(t)); \
            DF_SOFTMAX(sB0, sB1, oB0, oB1, mB, lB, btB, 32, t, pw); \
            if (!(COND) || (t) + 1 < NTw) DF_QK(sA0, sA1, kfA, DF_KS((t) + 1), qA, mA); \
            DF_PV(oB0, oB1, pw, DF_VS(t)); } \
        if (!(COND) || (t) + 2 < NT) *(LAS u32x4*)(lds + L_K0 + DF_KS((t) + 2) + kl0) = kr; \
        if (!(COND) || (t) + 1 < NT) *(LAS u32x4*)(lds + L_V0 + DF_VS((t) + 1) + vl0) = vr; \
        __syncthreads(); } while (0)
#pragma unroll 1
    for (;;) {
        mA = 0.f; mB = 0.f; lA = 0.f; lB = 0.f; oA0 = f32x16{}; oA1 = f32x16{}; oB0 = f32x16{}; oB1 = f32x16{};
        const bf16_t* kp = kg0; const bf16_t* vp = vg0;
        u32x4 kr, vr;
        {
            const u32x4 ka = *(const u32x4*)kp; kp += tstep; const u32x4 va = *(const u32x4*)vp; vp += tstep; const u32x4 kb = *(const u32x4*)kp; kp += tstep;
            __syncthreads();
            *(LAS u32x4*)(lds + L_K0 + kl0) = ka; *(LAS u32x4*)(lds + L_V0 + vl0) = va; *(LAS u32x4*)(lds + L_K0 + KBUF + kl0) = kb;
            if (fast && tid == 0) *(volatile LAS unsigned*)(lds + L_FLAG) = 0u;
        }
        __syncthreads();
        f32x16 sA0, sA1, sB0, sB1;
        DF_QK(sA0, sA1, kfA, 0, qA, mA);
#pragma unroll
        for (int r = 0; r < 16; ++r) { sB0[r] = 0.f; sB1[r] = 0.f; }
        int t = 0;
        _Pragma("unroll 1") for (; t < TM; ++t) { DF_STEP(false, t); }
        _Pragma("unroll 1") for (; t < NT; ++t) { DF_STEP(true, t); }
        {
            const float ltA = xhalf_sum(lA), ltB = xhalf_sum(lB);
            if (fast) { if (!(ltA >= 0x1p-90f && ltA <= 0x1p90f && ltB >= 0x1p-90f && ltB <= 0x1p90f)) *(volatile LAS unsigned*)(lds + L_FLAG) = 1u; }
            if (hi == 0) { wsf[r32] = __builtin_amdgcn_rcpf(ltA); wsf[32 + r32] = __builtin_amdgcn_rcpf(ltB); }
#pragma unroll
            for (int r = 0; r < 16; ++r) { const float ia = wsf[crow(r, hi)], ib = wsf[32 + crow(r, hi)]; oA0[r] *= ia; oA1[r] *= ia; oB0[r] *= ib; oB1[r] *= ib; }
            asm volatile("" ::: "memory");
        }
        if (!fast) break;
        __syncthreads();
        if (__builtin_amdgcn_readfirstlane(*(volatile LAS unsigned*)(lds + L_FLAG)) == 0u) break;
        fast = 0;
    }
#undef DF_STEP
#undef DF_PV
#undef DF_VLOAD
#undef DF_SOFTMAX
#undef DF_QK
#undef DF_KS
#undef DF_VS
    bf16_t* Y = (bf16_t*)(ws + WS_Y);
    float gs0[16], gs1[16];
    {
        bf16_t gr0[16], gr1[16];
#pragma unroll
        for (int r = 0; r < 16; ++r) { const bf16_t* gp = P + (row0 + qw + crow(r, hi)) * PC + CB_G + h * 64; gr0[r] = gp[r32]; gr1[r] = gp[32 + r32]; }
#pragma unroll
        for (int r = 0; r < 16; ++r) { const float a0 = bf2f(gr0[r]), a1 = bf2f(gr1[r]);
            gs0[r] = a0 * __builtin_amdgcn_rcpf(1.f + __expf(-a0)); gs1[r] = a1 * __builtin_amdgcn_rcpf(1.f + __expf(-a1)); }
    }
    {
        const float* lamp = A->dlam + layer * 128;
        float s1 = 0.f, s2 = 0.f;
        for (int i = 0; i < 32; ++i) { s1 += lamp[i] * lamp[32 + i]; s2 += lamp[64 + i] * lamp[96 + i]; }
        const float lambda_init = A->lambda_init[layer];
        const float lam = __expf(s1) - __expf(s2) + lambda_init;
        const float g0 = A->subg[layer * 64 + r32], g1 = A->subg[layer * 64 + 32 + r32];
#pragma unroll
        for (int r = 0; r < 16; ++r) {
            const float v0 = oA0[r] - lam * oB0[r];
            const float v1 = oA1[r] - lam * oB1[r];
            float ss = v0 * v0 + v1 * v1;
#pragma unroll
            for (int off = 1; off < 32; off <<= 1) ss += __shfl_xor(ss, off);
            const float rr = rsqrtf(ss * (1.f / 64.f) + EPS) * (1.f - lambda_init);
            bf16_t* yp = Y + (row0 + qw + crow(r, hi)) * D + 256 + h * 64;
            yp[r32] = f2bf(v0 * rr * g0 * gs0[r]);
            yp[32 + r32] = f2bf(v1 * rr * g1 * gs1[r]);
        }
    }
}
}

namespace sel {
__device__ __forceinline__ float relu_s(float x) { const int i = __builtin_bit_cast(int, x); return __builtin_bit_cast(float, i > 0 ? i : 0); }
}

namespace sel2 {
typedef float f32x16 __attribute__((ext_vector_type(16)));
typedef short s16x2 __attribute__((ext_vector_type(2)));
typedef unsigned short u16x2 __attribute__((ext_vector_type(2)));
__device__ __forceinline__ unsigned pk_lt(unsigned v, unsigned c) {
    const s16x2 d = __builtin_elementwise_sub_sat(__builtin_bit_cast(s16x2, v), __builtin_bit_cast(s16x2, c));
    return __builtin_bit_cast(unsigned, __builtin_bit_cast(u16x2, d) >> 15);
}
__device__ __forceinline__ unsigned pk_add(unsigned a, unsigned b) { return __builtin_bit_cast(unsigned, __builtin_bit_cast(u16x2, a) + __builtin_bit_cast(u16x2, b)); }
__device__ __forceinline__ unsigned half_sum(unsigned x) {
    x = pk_add(x, (unsigned)__builtin_amdgcn_update_dpp(0, (int)x, 0xB1, 0xf, 0xf, false));
    x = pk_add(x, (unsigned)__builtin_amdgcn_update_dpp(0, (int)x, 0x4E, 0xf, 0xf, false));
    x = pk_add(x, (unsigned)__builtin_amdgcn_update_dpp(0, (int)x, 0x141, 0xf, 0xf, false));
    x = pk_add(x, (unsigned)__builtin_amdgcn_update_dpp(0, (int)x, 0x140, 0xf, 0xf, false));
    x = pk_add(x, (unsigned)__builtin_amdgcn_ds_swizzle((int)x, 0x401F));
    return x;
}
__device__ __forceinline__ void select_unit(LAS unsigned char* lds, int b, int c, int half) {
    ArgsP A = get_args();
    unsigned char* ws = A->ws;
    const bf16_t* P = (const bf16_t*)(ws + WS_P);
    unsigned* MASK = (unsigned*)(ws + WS_MASK);
    const int tid = opaque_tid(), lane = tid & 63, r32 = lane & 31, hi = lane >> 5; const int wid = __builtin_amdgcn_readfirstlane(tid >> 6);
    const int ni = c + 1, nb = 2 * ni;
    const size_t tq0 = (size_t)b * S + 64 * c + 32 * half + 4 * wid;
    if (c <= 3) {
        for (int e = lane; e < 4 * nb; e += 64) MASK[(tq0 + e / nb) * 128 + e % nb] = 0xffffffffu;
        return;
    }
    int nkeys_v = 64 * ni; asm volatile("" : "+v"(nkeys_v));
    unsigned vals[64];
    LAS unsigned* ldsv = (LAS unsigned*)lds + wid * 4096 + lane;
#define SVAL(blk) (((blk) < 64) ? vals[(blk) & 63] : ldsv[(((blk) - 64) & 63) * 64])
    {
        const int ql = 2 * ((r32 >> 2) & 1) + (r32 >> 4), hh = ((r32 >> 3) & 1) * 4 + (r32 & 3);
        const bf16x8 af0 = *(const bf16x8*)(P + (tq0 + ql) * PC + CC_QI + hh * 32 + 8 * hi), af1 = *(const bf16x8*)(P + (tq0 + ql) * PC + CC_QI + hh * 32 + 16 + 8 * hi);
        const float idx_scale = 0.35355339059327373f * 0.17677669529663687f * 0.125f;
        float wv[16];
#pragma unroll
        for (int qh = 0; qh < 2; ++qh) { const u16x8 w8 = *(const u16x8*)(P + (tq0 + 2 * hi + qh) * PC + CC_WI);
#pragma unroll
            for (int e = 0; e < 8; ++e) wv[8 * qh + e] = bf2f(w8[e]) * idx_scale; }
        const bf16_t* kbase = P + ((size_t)b * S + r32) * PC + CC_KI + 8 * hi;
        bf16x8 afc[2][2] = {{af0, af1}, {af0, af1}};
        bf16x8 pb0[3], pb1[3];
        pb0[0] = *(const bf16x8*)kbase; pb1[0] = *(const bf16x8*)(kbase + 16);
        pb0[1] = *(const bf16x8*)(kbase + (size_t)32 * PC); pb1[1] = *(const bf16x8*)(kbase + (size_t)32 * PC + 16);
        const int ng16i = (nb + 15) >> 4;
#pragma unroll
        for (int g = 0; g < 8; ++g) if (g < ng16i) {
#pragma unroll
            for (int jb = 0; jb < 16; ++jb) { const int blk = 16 * g + jb;
                pb0[(blk + 2) % 3] = *(const bf16x8*)(kbase + (size_t)(32 * (blk + 2)) * PC); pb1[(blk + 2) % 3] = *(const bf16x8*)(kbase + (size_t)(32 * (blk + 2)) * PC + 16);
                f32x16 acc = f32x16{};
                acc = __builtin_amdgcn_mfma_f32_32x32x16_bf16(afc[blk & 1][0], pb0[blk % 3], acc, 0, 0, 0);
                acc = __builtin_amdgcn_mfma_f32_32x32x16_bf16(afc[blk & 1][1], pb1[blk % 3], acc, 0, 0, 0);
                float pr_[16];
#pragma unroll
                for (int r = 0; r < 16; ++r) pr_[r] = sel::relu_s(acc[r]);
                const float v0 = ((wv[0] * pr_[0] + wv[1] * pr_[1]) + (wv[2] * pr_[2] + wv[3] * pr_[3])) + ((wv[4] * pr_[4] + wv[5] * pr_[5]) + (wv[6] * pr_[6] + wv[7] * pr_[7]));
                const float v1 = ((wv[8] * pr_[8] + wv[9] * pr_[9]) + (wv[10] * pr_[10] + wv[11] * pr_[11])) + ((wv[12] * pr_[12] + wv[13] * pr_[13]) + (wv[14] * pr_[14] + wv[15] * pr_[15]));
                unsigned sv_ = __builtin_bit_cast(unsigned, __builtin_amdgcn_cvt_pknorm_i16(v0, v1));
                sv_ = (32 * blk + r32 < nkeys_v) ? sv_ : 0x80008000u;
                asm volatile("" : "+v"(afc[blk & 1][0]) : "v"(sv_));
                if (blk < 64) vals[blk & 63] = sv_; else ldsv[((blk - 64) & 63) * 64] = sv_;
            }
        }
    }
    const int ng16 = (nb + 15) >> 4;
    const unsigned total = (unsigned)ng16 * 512u;
#define SEL2_COUNT_LT(res, c2) do { unsigned a0_ = 0u, a1_ = 0u, a2_ = 0u, a3_ = 0u; \
        _Pragma("unroll") for (int g = 0; g < 8; ++g) if (g < ng16) { \
            unsigned sv_[16]; _Pragma("unroll") for (int j = 0; j < 16; ++j) sv_[j] = SVAL(16 * g + j); \
            __builtin_amdgcn_sched_barrier(0); \
            s16x2 dd_[16]; _Pragma("unroll") for (int j = 0; j < 16; ++j) dd_[j] = __builtin_elementwise_sub_sat(__builtin_bit_cast(s16x2, sv_[j]), __builtin_bit_cast(s16x2, (unsigned)(c2))); \
            __builtin_amdgcn_sched_barrier(0); \
            u16x2 ss_[16]; _Pragma("unroll") for (int j = 0; j < 16; ++j) ss_[j] = __builtin_bit_cast(u16x2, dd_[j]) >> 15; \
            __builtin_amdgcn_sched_barrier(0); \
            _Pragma("unroll") for (int j = 0; j < 8; ++j) ss_[j] += ss_[j + 8]; \
            __builtin_amdgcn_sched_barrier(0); \
            _Pragma("unroll") for (int j = 0; j < 4; ++j) ss_[j] += ss_[j + 4]; \
            __builtin_amdgcn_sched_barrier(0); \
            a0_ = pk_add(a0_, __builtin_bit_cast(unsigned, ss_[0])); a1_ = pk_add(a1_, __builtin_bit_cast(unsigned, ss_[1])); a2_ = pk_add(a2_, __builtin_bit_cast(unsigned, ss_[2])); a3_ = pk_add(a3_, __builtin_bit_cast(unsigned, ss_[3])); \
            __builtin_amdgcn_sched_barrier(0); } \
        res = half_sum(pk_add(pk_add(a0_, a1_), pk_add(a2_, a3_))); } while (0)
    unsigned Tu2 = 0u;
    unsigned cge_lo = total, cge_hi = total;
#pragma unroll 1
    for (int bit = 15; bit >= 0; --bit) {
        const unsigned cand2 = Tu2 | ((1u << bit) * 0x10001u);
        unsigned clt; SEL2_COUNT_LT(clt, cand2 ^ 0x80008000u);
        const unsigned g_lo = total - (clt & 0xffffu), g_hi = total - (clt >> 16);
        if (g_lo >= 256u) { Tu2 = (Tu2 & 0xffff0000u) | (cand2 & 0x0000ffffu); cge_lo = g_lo; }
        if (g_hi >= 256u) { Tu2 = (Tu2 & 0x0000ffffu) | (cand2 & 0xffff0000u); cge_hi = g_hi; }
        if (__all((cge_lo == 256u) && (cge_hi == 256u))) break;
    }
    const unsigned Ts2 = Tu2 ^ 0x80008000u;
    const bool anytie = __any((cge_lo != 256u) || (cge_hi != 256u));
    LAS unsigned* m0 = (LAS unsigned*)(lds + 131072) + wid * 512; LAS unsigned* m1 = m0 + 128; LAS unsigned* m2 = m0 + 256; LAS unsigned* m3 = m0 + 384;
    if (!anytie) {
#pragma unroll
        for (int g = 0; g < 8; ++g) if (g < ng16)
#pragma unroll
        for (int jb = 0; jb < 16; ++jb) { const int blk = 16 * g + jb;
            const unsigned d = __builtin_bit_cast(unsigned, __builtin_elementwise_sub_sat(__builtin_bit_cast(s16x2, SVAL(blk)), __builtin_bit_cast(s16x2, Ts2)));
            const unsigned long long bl = __ballot((d & 0x8000u) == 0u), bh = __ballot((int)d >= 0);
            if (lane == 0) { m0[blk] = (unsigned)bl; m2[blk] = (unsigned)(bl >> 32); m1[blk] = (unsigned)bh; m3[blk] = (unsigned)(bh >> 32); }
        }
    } else {
        const s16x2 tp1 = __builtin_elementwise_add_sat(__builtin_bit_cast(s16x2, Ts2), (s16x2){1, 1});
        unsigned clt_u; SEL2_COUNT_LT(clt_u, __builtin_bit_cast(unsigned, tp1));
        const int cgt_lo = ((Ts2 & 0xffffu) == 0x7fffu) ? 0 : (int)(total - (clt_u & 0xffffu)), cgt_hi = ((Ts2 >> 16) == 0x7fffu) ? 0 : (int)(total - (clt_u >> 16));
        const int need_lo = 256 - cgt_lo, need_hi = 256 - cgt_hi;
        int taken_lo = 0, taken_hi = 0;
#pragma unroll
        for (int g = 0; g < 8; ++g) if (g < ng16)
#pragma unroll
        for (int jb = 0; jb < 16; ++jb) { const int blk = 16 * g + jb;
            const unsigned d = __builtin_bit_cast(unsigned, __builtin_elementwise_sub_sat(__builtin_bit_cast(s16x2, SVAL(blk)), __builtin_bit_cast(s16x2, Ts2)));
            const bool eq_lo = ((d & 0xffffu) == 0u), eq_hi = ((d >> 16) == 0u);
            const bool gt_lo = !eq_lo && ((d & 0x8000u) == 0u), gt_hi = !eq_hi && ((int)d >= 0);
            const unsigned long long el = __ballot(eq_lo), eh = __ballot(eq_hi);
            const int cl0 = __popc((unsigned)el), cl1 = __popc((unsigned)(el >> 32)), ch0 = __popc((unsigned)eh), ch1 = __popc((unsigned)(eh >> 32));
            const int pre_lo = (int)__builtin_amdgcn_mbcnt_hi((unsigned)(el >> 32), __builtin_amdgcn_mbcnt_lo((unsigned)el, 0u)) - (hi ? cl0 : 0);
            const int pre_hi = (int)__builtin_amdgcn_mbcnt_hi((unsigned)(eh >> 32), __builtin_amdgcn_mbcnt_lo((unsigned)eh, 0u)) - (hi ? ch0 : 0);
            const bool s_lo = gt_lo || (eq_lo && (taken_lo + pre_lo) < need_lo), s_hi = gt_hi || (eq_hi && (taken_hi + pre_hi) < need_hi);
            taken_lo += hi ? cl1 : cl0; taken_hi += hi ? ch1 : ch0;
            const unsigned long long bl = __ballot(s_lo), bh = __ballot(s_hi);
            if (lane == 0) { m0[blk] = (unsigned)bl; m2[blk] = (unsigned)(bl >> 32); m1[blk] = (unsigned)bh; m3[blk] = (unsigned)(bh >> 32); }
        }
    }
    asm volatile("s_waitcnt lgkmcnt(0)" ::: "memory");
#pragma unroll
    for (int q = 0; q < 4; ++q)
#pragma unroll
        for (int hf = 0; hf < 2; ++hf) { const int bw = lane + 64 * hf; if (bw < nb) MASK[(tq0 + q) * 128 + bw] = m0[q * 128 + bw]; }
#undef SEL2_COUNT_LT
#undef SVAL
}
}

namespace mp {
constexpr int AQ_STRIDE = 528, AKV_STRIDE = 272, L_AQ = 0, L_AKV = 128 * AQ_STRIDE;
constexpr int L_RK = L_AKV + 128 * AKV_STRIDE;
constexpr int ST_STRIDE = 208, L_ST = L_RK + 128 * 64;
__device__ __forceinline__ void stage4(LAS unsigned char* p, const f32x4 v) { u32x2 w; w.x = pg8::cvt_pk_bf16(v[0], v[1]); w.y = pg8::cvt_pk_bf16(v[2], v[3]); *(LAS u32x2*)p = w; }
__device__ __forceinline__ void store4(bf16_t* p, const f32x4 v) { uint2 w; w.x = pg8::cvt_pk_bf16(v[0], v[1]); w.y = pg8::cvt_pk_bf16(v[2], v[3]); *(uint2*)p = w; }
template <int CTRL> __device__ __forceinline__ float dppf(float v) { return __builtin_bit_cast(float, __builtin_amdgcn_update_dpp(0, __builtin_bit_cast(int, v), CTRL, 0xf, 0xf, false)); }
__device__ __forceinline__ float wave_sum64(float v) {
    v += dppf<0xB1>(v); v += dppf<0x4E>(v); v += dppf<0x141>(v); v += dppf<0x140>(v);
    v += __builtin_bit_cast(float, __builtin_amdgcn_ds_swizzle(__builtin_bit_cast(int, v), 0x401F));
    return fa::xhalf_sum(v);
}
__device__ __forceinline__ void mla_prep_unit(LAS unsigned char* lds, int tile, int l) {
    ArgsP A = get_args();
    unsigned char* ws = A->ws;
    const bf16_t* P = (const bf16_t*)(ws + WS_P);
    const float* ROPE = (const float*)(ws + WS_ROPE);
    bf16_t* QA = (bf16_t*)(ws + WS_QA); bf16_t* KA = (bf16_t*)(ws + WS_KA); bf16_t* VA = (bf16_t*)(ws + WS_VA);
    const int tid = opaque_tid(), lane = tid & 63, fr = lane & 15, fq = lane >> 4, wid = __builtin_amdgcn_readfirstlane(tid >> 6);
    const size_t t0 = (size_t)tile * 128;
    const int h = wid >> 1, half = wid & 1;
    bf16x8 wq[8][3];
    {
        const bf16_t* W = (const bf16_t*)(ws + WS_WTUQ) + (size_t)l * 384 * 256 + (size_t)(48 * wid + fr) * 256 + 8 * fq;
#pragma unroll
        for (int ks = 0; ks < 8; ++ks)
#pragma unroll
            for (int nf = 0; nf < 3; ++nf) wq[ks][nf] = *(const bf16x8*)(W + (size_t)(16 * nf) * 256 + 32 * ks);
    }
    __syncthreads();
    {
        const float* qg = A->qa_g + l * 256; const float* kg = A->kva_g + l * 128;
        float gq[4], gk[4];
#pragma unroll
        for (int j = 0; j < 4; ++j) { gq[j] = qg[4 * lane + j]; gk[j] = kg[(4 * lane + j) & 127]; }
#pragma unroll 1
        for (int bt = 0; bt < 4; ++bt) {
            uint2 cq[4], ck[4]; bf16_t kr1[4], kr2[4]; float rcs[4], rsn[4];
#pragma unroll
            for (int i = 0; i < 4; ++i) {
                const int row = 16 * wid + 4 * bt + i; const size_t t = t0 + row;
                const bf16_t* p = P + t * PC;
                cq[i] = *(const uint2*)(p + CA_CQ + 4 * lane);
                ck[i] = *(const uint2*)(p + CA_CKV + 4 * (lane & 31));
                if (lane < 16) { const int pos = (int)(t % S); kr1[i] = p[CA_KR + lane]; kr2[i] = p[CA_KR + 16 + lane]; rcs[i] = ROPE[pos * 16 + lane]; rsn[i] = ROPE[S * 16 + pos * 16 + lane]; }
            }
#pragma unroll
            for (int i = 0; i < 4; ++i) {
                const int row = 16 * wid + 4 * bt + i; const size_t t = t0 + row;
                float a[4] = {bf2f((bf16_t)(cq[i].x & 0xffff)), bf2f((bf16_t)(cq[i].x >> 16)), bf2f((bf16_t)(cq[i].y & 0xffff)), bf2f((bf16_t)(cq[i].y >> 16))};
                float c[4] = {bf2f((bf16_t)(ck[i].x & 0xffff)), bf2f((bf16_t)(ck[i].x >> 16)), bf2f((bf16_t)(ck[i].y & 0xffff)), bf2f((bf16_t)(ck[i].y >> 16))};
                float sa = a[0] * a[0] + a[1] * a[1] + a[2] * a[2] + a[3] * a[3];
                float sb = (lane < 32) ? (c[0] * c[0] + c[1] * c[1] + c[2] * c[2] + c[3] * c[3]) : 0.f;
                sa = wave_sum64(sa); sb = wave_sum64(sb);
                const float ra = rsqrtf(sa * (1.f / 256.f) + EPS), rb = rsqrtf(sb * (1.f / 128.f) + EPS);
                u32x2 w; w.x = pg8::cvt_pk_bf16(a[0] * ra * gq[0], a[1] * ra * gq[1]); w.y = pg8::cvt_pk_bf16(a[2] * ra * gq[2], a[3] * ra * gq[3]);
                *(LAS u32x2*)(lds + L_AQ + row * AQ_STRIDE + 8 * lane) = w;
                if (lane < 32) { u32x2 v; v.x = pg8::cvt_pk_bf16(c[0] * rb * gk[0], c[1] * rb * gk[1]); v.y = pg8::cvt_pk_bf16(c[2] * rb * gk[2], c[3] * rb * gk[3]);
                    *(LAS u32x2*)(lds + L_AKV + row * AKV_STRIDE + 8 * lane) = v; }
                if (lane < 16) {
                    const float k1 = bf2f(kr1[i]), k2 = bf2f(kr2[i]);
                    const bf16_t o1 = f2bf(k1 * rcs[i] - k2 * rsn[i]), o2 = f2bf(k2 * rcs[i] + k1 * rsn[i]);
                    LAS bf16_t* rk = (LAS bf16_t*)(lds + L_RK + row * 64); rk[lane] = o1; rk[16 + lane] = o2;
                }
            }
        }
    }
    __syncthreads();
    f32x4 acc[8][3];
#pragma unroll
    for (int mi = 0; mi < 8; ++mi)
#pragma unroll
        for (int nf = 0; nf < 3; ++nf) acc[mi][nf] = (f32x4){0.f, 0.f, 0.f, 0.f};
#pragma unroll
    for (int ks = 0; ks < 8; ++ks) {
#pragma unroll
        for (int mi = 0; mi < 8; ++mi) {
            const bf16x8 xf = *(const LAS bf16x8*)(lds + L_AQ + (16 * mi + fr) * AQ_STRIDE + 64 * ks + 16 * fq);
#pragma unroll
            for (int nf = 0; nf < 3; ++nf) acc[mi][nf] = __builtin_amdgcn_mfma_f32_16x16x32_bf16(wq[ks][nf], xf, acc[mi][nf], 0, 0, 0);
        }
    }
    __builtin_amdgcn_sched_barrier(0);
    bf16x8 wkv[4][4];
    {
        const bf16_t* W = (const bf16_t*)(ws + WS_WTUKV) + (size_t)l * 512 * 128 + (size_t)(64 * wid + fr) * 128 + 8 * fq;
#pragma unroll
        for (int ks = 0; ks < 4; ++ks)
#pragma unroll
            for (int nf = 0; nf < 4; ++nf) wkv[ks][nf] = *(const bf16x8*)(W + (size_t)(16 * nf) * 128 + 32 * ks);
    }
    LAS unsigned char* stg = lds + L_ST + wid * (16 * ST_STRIDE);
#pragma unroll
    for (int mb = 0; mb < 2; ++mb) {
        f32x4 cs[4], sn[4];
        if (half == 1) {
#pragma unroll
            for (int i = 0; i < 4; ++i) { const int pos = (int)((t0 + 16 * (4 * mb + i) + fr) % S);
                cs[i] = *(const f32x4*)(ROPE + pos * 16 + 4 * fq); sn[i] = *(const f32x4*)(ROPE + S * 16 + pos * 16 + 4 * fq); }
        }
#pragma unroll
        for (int i = 0; i < 4; ++i) { const int mi = 4 * mb + i;
            LAS unsigned char* sp = stg + fr * ST_STRIDE + 8 * fq;
            if (half == 0) { stage4(sp, acc[mi][0]); stage4(sp + 32, acc[mi][1]); stage4(sp + 64, acc[mi][2]); }
            else { const f32x4 x1 = acc[mi][1], x2 = acc[mi][2];
                stage4(sp, acc[mi][0]); stage4(sp + 32, x1 * cs[i] - x2 * sn[i]); stage4(sp + 64, x2 * cs[i] + x1 * sn[i]); }
            asm volatile("" ::: "memory");
#pragma unroll
            for (int j = 0; j < 2; ++j) { const int pc = lane + 64 * j; const int row = pc / 6, c = pc % 6;
                if (pc < 96) { const u32x4 v = *(const LAS u32x4*)(stg + row * ST_STRIDE + c * 16);
                    *(u32x4*)(QA + (t0 + 16 * mi + row) * 384 + h * 96 + 48 * half + c * 8) = v; } }
            asm volatile("" ::: "memory");
        }
    }
    {
        f32x4 ac2[8][4];
#pragma unroll
        for (int mi = 0; mi < 8; ++mi)
#pragma unroll
            for (int nf = 0; nf < 4; ++nf) ac2[mi][nf] = (f32x4){0.f, 0.f, 0.f, 0.f};
#pragma unroll
        for (int ks = 0; ks < 4; ++ks) {
#pragma unroll
            for (int mi = 0; mi < 8; ++mi) {
                const bf16x8 xf = *(const LAS bf16x8*)(lds + L_AKV + (16 * mi + fr) * AKV_STRIDE + 64 * ks + 16 * fq);
#pragma unroll
                for (int nf = 0; nf < 4; ++nf) ac2[mi][nf] = __builtin_amdgcn_mfma_f32_16x16x32_bf16(wkv[ks][nf], xf, ac2[mi][nf], 0, 0, 0);
            }
        }
#pragma unroll
        for (int mi = 0; mi < 8; ++mi) {
            LAS unsigned char* sp = stg + fr * ST_STRIDE + 8 * fq;
#pragma unroll
            for (int nf = 0; nf < 4; ++nf) stage4(sp + 32 * nf, ac2[mi][nf]);
            asm volatile("" ::: "memory");
            if (half == 0) {
#pragma unroll
                for (int j = 0; j < 3; ++j) { const int pc = lane + 64 * j; const int row = pc / 12, c = pc % 12;
                    const u32x4 v = (c < 8) ? *(const LAS u32x4*)(stg + row * ST_STRIDE + c * 16) : *(const LAS u32x4*)(lds + L_RK + (16 * mi + row) * 64 + (c - 8) * 16);
                    *(u32x4*)(KA + (t0 + 16 * mi + row) * 384 + h * 96 + c * 8) = v; }
            } else {
#pragma unroll
                for (int j = 0; j < 2; ++j) { const int pc = lane + 64 * j; const int row = pc >> 3, c = pc & 7;
                    const u32x4 v = *(const LAS u32x4*)(stg + row * ST_STRIDE + c * 16);
                    *(u32x4*)(VA + (t0 + 16 * mi + row) * 256 + h * 64 + c * 8) = v; }
            }
            asm volatile("" ::: "memory");
        }
    }
}
}

__device__ __forceinline__ void conv_tokens(int t, int cg, const bf16_t* P, const float* cw, bf16_t* Y) {
    const int pos = t % S, ch = cg * 8;
    const bf16_t* p = P + (size_t)t * PC;
    const u16x8 zero = (u16x8){0, 0, 0, 0, 0, 0, 0, 0};
    const u16x8 c2 = *(const u16x8*)(p + CD_C + ch), h2 = *(const u16x8*)(p + CD_H + ch);
    const u16x8 c1 = (pos >= 1) ? *(const u16x8*)(p - PC + CD_C + ch) : zero, h1 = (pos >= 1) ? *(const u16x8*)(p - PC + CD_H + ch) : zero;
    const u16x8 c0 = (pos >= 2) ? *(const u16x8*)(p - 2 * PC + CD_C + ch) : zero, h0 = (pos >= 2) ? *(const u16x8*)(p - 2 * PC + CD_H + ch) : zero;
    const u16x8 bb = *(const u16x8*)(p + CD_B + ch), gg = *(const u16x8*)(p + CD_G + ch);
    u16x8 out;
#pragma unroll
    for (int e = 0; e < 8; ++e) {
        const float y = cw[ch + e] * (bf2f(c0[e]) * bf2f(h0[e])) + cw[256 + ch + e] * (bf2f(c1[e]) * bf2f(h1[e])) + cw[512 + ch + e] * (bf2f(c2[e]) * bf2f(h2[e]));
        const float g = bf2f(gg[e]);
        out[e] = f2bf(bf2f(bb[e]) * y * (g * __builtin_amdgcn_rcpf(1.f + __expf(-g))));
    }
    *(u16x8*)(Y + (size_t)t * D + 768 + ch) = out;
}

#define PH_PRE const int tid = opaque_tid(), lane = tid & 63, wave = __builtin_amdgcn_readfirstlane(tid >> 6); const int G = opaque_grid(), bid = opaque_bid(); \
    ArgsP A = get_args(); unsigned char* ws = A->ws; (void)lane; (void)wave; (void)G; (void)bid; (void)ws;
__device__ __forceinline__ void ph_prologue(LAS unsigned char* lds) {
    PH_PRE
    const long gtid = (long)bid * NTHR + tid, gthreads = (long)G * NTHR;
    {
        LAS float* scr = (LAS float*)lds;
        constexpr int T_IN = 16 * 64, T_OUT = 16 * 16, T_UQ = 4 * 6, T_UKV = 2 * 8, T_L = T_IN + T_OUT + T_UQ + T_UKV;
        for (int it = bid; it < NL * T_L; it += G) {
            const int l = it / T_L; int r = it % T_L;
            if (r < T_IN) { convert_tile(scr, A->w_in + (size_t)l * 1024 * INC, (bf16_t*)(ws + WS_WTIN) + (size_t)l * PC * 1024, 1024, INC, 1, 1.f, (r >> 6) * 64, (r & 63) * 64, tid); continue; } r -= T_IN;
            if (r < T_OUT) { convert_tile(scr, A->w_out + (size_t)l * 1024 * 1024, (bf16_t*)(ws + WS_WTOUT) + (size_t)l * 1024 * 1024, 1024, 1024, 0, 1.f, (r >> 4) * 64, (r & 15) * 64, tid); continue; } r -= T_OUT;
            if (r < T_UQ) { convert_tile(scr, A->w_uq + (size_t)l * 256 * 384, (bf16_t*)(ws + WS_WTUQ) + (size_t)l * 384 * 256, 256, 384, 0, QS_MLA, (r / 6) * 64, (r % 6) * 64, tid); continue; } r -= T_UQ;
            convert_tile(scr, A->w_ukv + (size_t)l * 128 * 512, (bf16_t*)(ws + WS_WTUKV) + (size_t)l * 512 * 128, 128, 512, 0, 1.f, (r >> 3) * 64, (r & 7) * 64, tid);
        }
        __syncthreads();
    }
    float* ROPE = (float*)(ws + WS_ROPE);
    for (long i = gtid; i < S * 16; i += gthreads) {
        const int s = (int)(i >> 4), f = (int)(i & 15);
        const float inv = powf(10000.0f, -(float)f / 16.0f);
        const float ang = (float)s * inv;
        float sn, c; sincosf(ang, &sn, &c);
        ROPE[i] = c; ROPE[S * 16 + i] = sn;
    }
}
__device__ __forceinline__ void ph_rms(int l) {
    PH_PRE
    bf16_t* HN = (bf16_t*)(ws + WS_HN);
    const int NGW = G * NWAVE;
    if (l == 0) { for (int r = bid * NWAVE + wave; r < T; r += 4 * NGW) rms_rows4<true>(A->x + (size_t)r * D, (size_t)NGW * D, A->norm_g + l * D, HN + (size_t)r * D, nullptr, lane); }
    else { const bf16_t* XR = (const bf16_t*)(ws + WS_XR);
        for (int r = bid * NWAVE + wave; r < T; r += 4 * NGW) rms_rows4b<true>(XR + (size_t)r * D, (size_t)NGW * D, A->norm_g + l * D, HN + (size_t)r * D, nullptr, lane); }
}
__device__ __forceinline__ void ph_gemm_in(LAS unsigned char* lds, int l) {
    PH_PRE
    pg8::Gemm g{(const bf16_t*)(ws + WS_HN), (const bf16_t*)(ws + WS_WTIN) + (size_t)l * PC * 1024, T, PC, 1024}; pg8::StaticOrder So; So.init(T, PC, G, bid);
    pg8::EpiBf16 E{(bf16_t*)(ws + WS_P), PC};
    pg8::gemm_phase<pg8::EpiBf16, pg8::StaticOrder, true, true>(lds, g, So, E);
}
__device__ __forceinline__ void ph_mid(LAS unsigned char* lds, int l) {
    const int G = opaque_grid(), bid = opaque_bid();
    for (int u = bid; u < T / 128; u += G) mp::mla_prep_unit(lds, u, l);
    __syncthreads();
    {
        const int vcu = (bid & 7) * (G >> 3) + (bid >> 3);
        const int b = vcu >> 5, j = vcu & 31;
        for (int m = 0; m < 4; ++m) { const int c = ((m & 1) ? (15 - (j >> 1)) : (j >> 1)) + 16 * m; sel2::select_unit(lds, b, c, j & 1); }
    }
}
__device__ __forceinline__ void ph_attn(LAS unsigned char* lds, int l) {
    const int G = opaque_grid(), bid = opaque_bid();
    {
        const int vcu = (bid & 7) * (G >> 3) + (bid >> 3);
        const int b = vcu >> 5, h = (vcu >> 3) & 3, s = vcu & 7;
        { ArgsP A = get_args(); fa::build_bias(lds, A->rel_bias); }
#define ATTN_UNIT(TY) do { _Pragma("unroll 1") for (int u_ = 0; u_ < 2; ++u_) { int b_ = b, h_ = h, q_ = u_ ? s : 15 - s, l_ = l; asm volatile("" : "+s"(b_), "+s"(h_), "+s"(q_), "+s"(l_)); \
            fa::attn_unit<TY>(lds, b_, h_, q_, l_); } } while (0)
        ATTN_UNIT(0);
        { _Pragma("unroll 1") for (int u_ = 0; u_ < 2; ++u_) { int b_ = b, h_ = h, q_ = u_ ? s : 15 - s, l_ = l; asm volatile("" : "+s"(b_), "+s"(h_), "+s"(q_), "+s"(l_)); fa::attn_unit_diff(lds, b_, h_, q_, l_); } }
        ATTN_UNIT(2);
#undef ATTN_UNIT
        __syncthreads();
    }
    {
        PH_PRE
        for (int t = bid * 16 + (tid >> 5); t < T; t += 16 * G) conv_tokens(t, tid & 31, (const bf16_t*)(ws + WS_P), A->conv_w + l * 768, (bf16_t*)(ws + WS_Y));
    }
}
__device__ __forceinline__ void ph_gemm_out(LAS unsigned char* lds, int l) {
    PH_PRE
    pg8::Gemm g{(const bf16_t*)(ws + WS_Y), (const bf16_t*)(ws + WS_WTOUT) + (size_t)l * 1024 * 1024, T, 1024, 1024}; pg8::StaticOrder So; So.init(T, 1024, G, bid);
    bf16_t* XR = (bf16_t*)(ws + WS_XR);
    if (l == 0) { pg8::EpiResBf16<false> E{A->x, XR, 1024}; pg8::gemm_phase<pg8::EpiResBf16<false>, pg8::StaticOrder, true, true>(lds, g, So, E); }
    else { pg8::EpiResBf16<true> E{XR, XR, 1024}; pg8::gemm_phase<pg8::EpiResBf16<true>, pg8::StaticOrder, true, true>(lds, g, So, E); }
}
__device__ __forceinline__ void ph_final() {
    PH_PRE
    const int NGW = G * NWAVE;
    const bf16_t* XR = (const bf16_t*)(ws + WS_XR);
    for (int r = bid * NWAVE + wave; r < T; r += 4 * NGW) rms_rows4b<false>(XR + (size_t)r * D, (size_t)NGW * D, A->final_g, nullptr, A->out + (size_t)r * D, lane);
}

#define GRID_SYNC() xcd_barrier(lds)
__global__ void __launch_bounds__(NTHR, 2) mk_fwd(Args Akernarg) {
    extern __shared__ __attribute__((aligned(16))) unsigned char lds_raw[];
    LAS unsigned char* lds = (LAS unsigned char*)lds_raw;
    xcd_barrier_post(lds);
    ph_prologue(lds);
    for (int l = 0; l < NL; ++l) {
        ph_rms(l);
        GRID_SYNC();
        ph_gemm_in(lds, l);
        GRID_SYNC();
        ph_mid(lds, l);
        GRID_SYNC();
        ph_attn(lds, l);
        GRID_SYNC();
        ph_gemm_out(lds, l);
        GRID_SYNC();
    }
    ph_final();
}

extern "C" void kernel_launch(void* const* d_in, const int* in_sizes, int n_in, void* d_out, int out_size, void* d_ws, size_t ws_size, hipStream_t stream) {
    static int grid = 0;
    if (grid == 0) {
        if (ws_size < WS_END) { fprintf(stderr, "kernel_launch: workspace too small (%zu < %zu)\n", ws_size, (size_t)WS_END); grid = -1; return; }
        int dev = 0, cus = 0, per_cu = 0;
        hipGetDevice(&dev);
        hipDeviceGetAttribute(&cus, hipDeviceAttributeMultiprocessorCount, dev);
        hipFuncSetAttribute((const void*)mk_fwd, hipFuncAttributeMaxDynamicSharedMemorySize, LDS_BYTES);
        hipOccupancyMaxActiveBlocksPerMultiprocessor(&per_cu, (const void*)mk_fwd, NTHR, LDS_BYTES);
        if (per_cu < 1) fprintf(stderr, "kernel_launch: note: the occupancy query reports %d workgroups per CU; 145 KiB of LDS per workgroup admits exactly one\n", per_cu);
        (void)hipGetLastError();
        if (cus != 256) { fprintf(stderr, "kernel_launch: built for a 256-CU device (one workgroup per CU, 32 per batch); found %d CUs; nothing launched\n", cus); grid = -1; return; }
        grid = cus;
    }
    if (grid < 0) return;
    Args a{};
    a.x = (const float*)d_in[0]; a.norm_g = (const float*)d_in[1]; a.w_in = (const float*)d_in[2]; a.qa_g = (const float*)d_in[3];
    a.w_uq = (const float*)d_in[4]; a.kva_g = (const float*)d_in[5]; a.w_ukv = (const float*)d_in[6]; a.dlam = (const float*)d_in[7];
    a.subg = (const float*)d_in[8]; a.conv_w = (const float*)d_in[9]; a.w_out = (const float*)d_in[10]; a.rel_bias = (const float*)d_in[11];
    a.final_g = (const float*)d_in[12];
    a.out = (float*)d_out; a.ws = (unsigned char*)d_ws;
    a.lambda_init[0] = 0.8f - 0.6f * expf(-0.3f * 0.f); a.lambda_init[1] = 0.8f - 0.6f * expf(-0.3f * 1.f);
    if (hipMemsetAsync(d_ws, 0, 65536, stream) != hipSuccess) { fprintf(stderr, "kernel_launch: memset of the barrier words failed\n"); return; }
    hipLaunchKernelGGL(mk_fwd, dim3(grid), dim3(NTHR), LDS_BYTES, stream, a);
    const hipError_t e = hipPeekAtLastError();
    if (e != hipSuccess) fprintf(stderr, "launch failed: %s (grid %d)\n", hipGetErrorString(e), grid);
}
```

```cpp
#include <hip/hip_runtime.h>
#include <hip/hip_bf16.h>
#include <cstdint>
#include <cstdio>

#define LAS __attribute__((address_space(3)))
typedef unsigned short bf16_t;
typedef short bf16x8 __attribute__((ext_vector_type(8)));
typedef unsigned short u16x8 __attribute__((ext_vector_type(8)));
typedef float f32x4 __attribute__((ext_vector_type(4)));
typedef unsigned u32x4 __attribute__((ext_vector_type(4)));
typedef unsigned u32x2 __attribute__((ext_vector_type(2)));

constexpr int NB = 8, S = 4096, T = NB * S, D = 1024, NL = 2;
constexpr int PC = 4096;
constexpr int INC = 4040;
constexpr int CA_CQ = 0, CA_CKV = 256, CA_KR = 384, CA_G = 448;
constexpr int CB_Q = 704, CB_K = 960, CB_V = 1216, CB_G = 1472;
constexpr int CC_Q = 1728, CC_K = 1984, CC_V = 2240, CC_QI = 2496, CC_KI = 2752, CC_WI = 2784, CC_G = 2816;
constexpr int CD_B = 3072, CD_C = 3328, CD_H = 3584, CD_G = 3840;
constexpr float EPS = 1e-6f;
constexpr int NTHR = 512, NWAVE = 8;

constexpr size_t MiB = 1u << 20;
constexpr size_t WS_WTIN = 1 * MiB;
constexpr size_t WS_WTOUT = 17 * MiB;
constexpr size_t WS_WTUQ = 21 * MiB;
constexpr size_t WS_WTUKV = 22 * MiB;
constexpr size_t WS_ROPE = 23 * MiB;
constexpr size_t WS_HN = 24 * MiB;
constexpr size_t WS_Y = WS_HN;
constexpr size_t WS_Q384 = WS_HN;
constexpr size_t WS_KV512 = WS_HN + 24 * MiB;
constexpr size_t WS_P = 88 * MiB;
constexpr size_t WS_QA = 344 * MiB;
constexpr size_t WS_KA = 368 * MiB;
constexpr size_t WS_VA = 392 * MiB;
constexpr size_t WS_CQN = WS_VA;
constexpr size_t WS_MASK = 408 * MiB;
constexpr size_t WS_CKVN = WS_MASK;
constexpr size_t WS_OKL = 424 * MiB;
constexpr size_t WS_XR = 440 * MiB;
constexpr size_t WS_END = 504 * MiB;

constexpr int LDS_BYTES = 148480;

__device__ __forceinline__ bf16_t f2bf(float f) {
    unsigned u = __builtin_bit_cast(unsigned, f);
    return (bf16_t)((u + 0x7fffu + ((u >> 16) & 1u)) >> 16);
}
__device__ __forceinline__ float bf2f(bf16_t h) { return __builtin_bit_cast(float, (unsigned)h << 16); }
__device__ __forceinline__ float silu(float x) { return x / (1.f + __expf(-x)); }
__device__ __forceinline__ int orig_col(int pc) {
    if (pc < 416) return pc;
    if (pc < 448) return -1;
    if (pc < 2792) return pc - 32;
    if (pc < 2816) return -1;
    return pc - 56;
}
__device__ __forceinline__ int rel_bucket(int rel) {
    const int ret = rel > 0 ? 16 : 0;
    const int n = rel < 0 ? -rel : rel;
    if (n < 8) return ret + n;
    int large = 2 + (31 - __clz(n * n));
    if (large > 15) large = 15;
    return ret + large;
}

__device__ __forceinline__ int opaque_tid() { int t = threadIdx.x; asm volatile("" : "+v"(t)); return t; }
__device__ __forceinline__ int opaque_bid() { int b = blockIdx.x; asm volatile("" : "+s"(b)); return b; }
__device__ __forceinline__ int opaque_grid() { int g = gridDim.x; asm volatile("" : "+s"(g)); return g; }
namespace pg8 {
constexpr int BM = 256, BK = 64, HALF = 128, HTB = HALF * BK * 2, STAGE_BYTES = 8 * HTB, NXCD = 8, WGM = 8;
__host__ __device__ __forceinline__ int lds_byte(int r, int c) { const int st = (r >> 4) * 2 + (c >> 5), rr = r & 15, cc = c & 31, ob = rr * 64 + cc * 2; return st * 1024 + (ob ^ (((ob >> 9) & 1) << 5)); }
__host__ __device__ __forceinline__ void stage_rc(int b, int& R, int& C) { const int st = b / 1024, sb = b % 1024, swz = sb ^ (((sb >> 9) & 1) << 5); R = (st >> 1) * 16 + swz / 64; C = (st & 1) * 32 + (swz % 64) / 2; }
__host__ __device__ __forceinline__ int perm32(int rho) { const int n = rho >> 4, i = rho & 15; return 8 * (i >> 2) + 4 * n + (i & 3); }
struct Unit { int pm, pn; };
struct Gemm { const bf16_t* A; const bf16_t* Bt; int M, N, K; };
struct StaticOrder {
    int nM, nN, nwg, G, c;
    __host__ __device__ void init(int M, int N, int G_, int c_) { nM = M / BM; nN = N / BM; nwg = nM * nN; G = G_; c = c_; }
    __host__ __device__ bool next(int i, Unit& u) const {
        const long L = (long)i * G + c; if (L >= nwg) return false;
        int wgid = (int)L; { const int q = nwg / NXCD, r = nwg % NXCD, xcd = wgid % NXCD, off = wgid / NXCD; wgid = (xcd < r ? xcd * (q + 1) : r * (q + 1) + (xcd - r) * q) + off; }
        const int nig = WGM * nN, gid = wgid / nig, fm = gid * WGM, gsz = (nM - fm) < WGM ? (nM - fm) : WGM;
        u.pm = fm + ((wgid % nig) % gsz); u.pn = (wgid % nig) / gsz; return true;
    }
    __device__ __forceinline__ void a_ready(const Unit&) const {}
    __device__ __forceinline__ void done(const Unit&) const {}
};
__device__ __forceinline__ unsigned cvt_pk_bf16(float lo, float hi) { unsigned r; asm volatile("v_cvt_pk_bf16_f32 %0, %1, %2" : "=v"(r) : "v"(lo), "v"(hi)); return r; }
struct EpiBf16 {
    static constexpr bool PERM = true, AFTER_DRAIN = false;
    bf16_t* O; int ldc;
    __device__ __forceinline__ void operator()(const f32x4 (&acc)[2][2][4][2], const Unit& u, int wr, int wc, int fr, int fq) const {
        const int row0 = u.pm * BM + wr * 64 + fr; const int col0 = u.pn * BM + wc * 32 + 8 * fq;
#pragma unroll
        for (int ai = 0; ai < 2; ++ai)
#pragma unroll
            for (int m = 0; m < 4; ++m) { bf16_t* rowp = O + (size_t)(row0 + ai * HALF + m * 16) * ldc + col0;
#pragma unroll
                for (int bj = 0; bj < 2; ++bj) { const f32x4 v0 = acc[ai][bj][m][0], v1 = acc[ai][bj][m][1];
                    u32x4 w; w.x = cvt_pk_bf16(v0[0], v0[1]); w.y = cvt_pk_bf16(v0[2], v0[3]); w.z = cvt_pk_bf16(v1[0], v1[1]); w.w = cvt_pk_bf16(v1[2], v1[3]);
                    *(u32x4*)(rowp + bj * HALF) = w; } }
    }
};
struct EpiResF32 {
    static constexpr bool PERM = false, AFTER_DRAIN = false;
    const float* base; float* out; int ldc;
    __device__ __forceinline__ void operator()(const f32x4 (&acc)[2][2][4][2], const Unit& u, int wr, int wc, int fr, int fq) const {
        const int col0 = u.pn * BM + wc * 32 + 4 * fq;
#pragma unroll
        for (int ai = 0; ai < 2; ++ai)
#pragma unroll
            for (int m = 0; m < 4; ++m) { const size_t off = (size_t)(u.pm * BM + ai * HALF + wr * 64 + m * 16 + fr) * ldc + col0;
#pragma unroll
                for (int bj = 0; bj < 2; ++bj)
#pragma unroll
                    for (int n = 0; n < 2; ++n) { const f32x4 bs = *(const f32x4*)(base + off + bj * HALF + n * 16); *(f32x4*)(out + off + bj * HALF + n * 16) = bs + acc[ai][bj][m][n]; } }
    }
};
template <bool BASE_BF16>
struct EpiResBf16 {
    static constexpr bool PERM = true, AFTER_DRAIN = false;
    const void* base; bf16_t* out; int ldc;
    __device__ __forceinline__ void operator()(const f32x4 (&acc)[2][2][4][2], const Unit& u, int wr, int wc, int fr, int fq) const {
        const int row0 = u.pm * BM + wr * 64 + fr; const int col0 = u.pn * BM + wc * 32 + 8 * fq;
#pragma unroll
        for (int ai = 0; ai < 2; ++ai)
#pragma unroll
            for (int m = 0; m < 4; ++m) { const size_t ro = (size_t)(row0 + ai * HALF + m * 16) * ldc + col0;
#pragma unroll
                for (int bj = 0; bj < 2; ++bj) { const f32x4 v0 = acc[ai][bj][m][0], v1 = acc[ai][bj][m][1]; const size_t off = ro + bj * HALF;
                    f32x4 b0, b1;
                    if (BASE_BF16) { const u16x8 bb = *(const u16x8*)((const bf16_t*)base + off);
                        b0 = (f32x4){bf2f(bb[0]), bf2f(bb[1]), bf2f(bb[2]), bf2f(bb[3])}; b1 = (f32x4){bf2f(bb[4]), bf2f(bb[5]), bf2f(bb[6]), bf2f(bb[7])}; }
                    else { b0 = *(const f32x4*)((const float*)base + off); b1 = *(const f32x4*)((const float*)base + off + 4); }
                    const f32x4 s0 = b0 + v0, s1 = b1 + v1;
                    u32x4 w; w.x = cvt_pk_bf16(s0[0], s0[1]); w.y = cvt_pk_bf16(s0[2], s0[3]); w.z = cvt_pk_bf16(s1[0], s1[1]); w.w = cvt_pk_bf16(s1[2], s1[3]);
                    *(u32x4*)(out + off) = w; } }
    }
};
template <class Epi, class Sched, bool ALIGN_EPI = false, bool SP2 = false>
__device__ __forceinline__ void gemm_phase(LAS unsigned char* lds, const Gemm g, const Sched& S, const Epi& E) {
    const int tid = opaque_tid(), wid = __builtin_amdgcn_readfirstlane(tid >> 6), lane = tid & 63, wr = wid >> 2, wc = wid & 3, fr = lane & 15, fq = lane >> 4;
    const int K = g.K, nt = K / BK;
    unsigned voffA[2], voffB[2];
#pragma unroll
    for (int i = 0; i < 2; ++i) { int R, C; stage_rc(tid * 16 + i * 8192, R, C); const int Rb = Epi::PERM ? ((R & ~31) + perm32(R & 31)) : R;
        voffA[i] = (unsigned)(R * K + C) * 2u; voffB[i] = (unsigned)(Rb * K + C) * 2u; }
    const size_t kstep = (size_t)(BK * 2);
    const size_t hstep = (size_t)HALF * K * 2;
    const size_t tstep = 2 * hstep;
    const unsigned ldsw = (unsigned)wid * 1024u;
    const int aoff = lds_byte(wr * 64 + fr, fq * 8), boff = lds_byte(wc * 32 + fr, fq * 8);
#define PG8_SA(b, h) (((b) * 2 + (h)) * HTB)
#define PG8_SB(b, h) ((4 + (b) * 2 + (h)) * HTB)
#define PG8_STAGE(bufoff, gbase, voff) do { _Pragma("unroll") for (int _i = 0; _i < 2; ++_i) \
        __builtin_amdgcn_global_load_lds((const unsigned*)((const char*)(gbase) + (voff)[_i]), (LAS unsigned*)(lds + (bufoff) + ldsw + _i * 8192), 16, 0, 0); } while (0)
#define PG8_LDA(dst, b, h) do { _Pragma("unroll") for (int m = 0; m < 4; ++m) _Pragma("unroll") for (int k = 0; k < 2; ++k) dst[m][k] = *(const LAS bf16x8*)(lds + PG8_SA(b, h) + aoff + m * 2048 + k * 1024); } while (0)
#define PG8_LDB(dst, b, h) do { _Pragma("unroll") for (int n = 0; n < 2; ++n) _Pragma("unroll") for (int k = 0; k < 2; ++k) dst[n][k] = *(const LAS bf16x8*)(lds + PG8_SB(b, h) + boff + n * 2048 + k * 1024); } while (0)
#define PG8_MMA(ai, bj, At, Bt) do { __builtin_amdgcn_s_setprio(1); _Pragma("unroll") for (int m = 0; m < 4; ++m) _Pragma("unroll") for (int n = 0; n < 2; ++n) _Pragma("unroll") for (int k = 0; k < 2; ++k) \
        acc[ai][bj][m][n] = __builtin_amdgcn_mfma_f32_16x16x32_bf16(Bt[n][k], At[m][k], acc[ai][bj][m][n], 0, 0, 0); __builtin_amdgcn_s_setprio(0); } while (0)
#define PG8_WAIT_V(n) asm volatile("s_waitcnt vmcnt(" #n ")" ::: "memory")
#define PG8_WAIT_L(n) asm volatile("s_waitcnt lgkmcnt(" #n ")" ::: "memory")
#define PG8_BAR __builtin_amdgcn_s_barrier()
#define PG8_SCHED __builtin_amdgcn_sched_barrier(0)
    Unit cur, nxt; int ui = 0;
    if (!S.next(0, cur)) return;
    f32x4 acc[2][2][4][2];
#pragma unroll
    for (int a = 0; a < 2; ++a)
#pragma unroll
        for (int b = 0; b < 2; ++b)
#pragma unroll
            for (int m = 0; m < 4; ++m)
#pragma unroll
                for (int n = 0; n < 2; ++n) acc[a][b][m][n] = (f32x4){0.f, 0.f, 0.f, 0.f};
    bf16x8 At[4][2], B0[2][2], B1[2][2];
    const char* cA = (const char*)g.A + (size_t)cur.pm * tstep; const char* cB = (const char*)g.Bt + (size_t)cur.pn * tstep;
    S.a_ready(cur);
    if constexpr (SP2) {
        PG8_STAGE(PG8_SB(0, 0), cB, voffB); PG8_STAGE(PG8_SB(0, 1), cB + hstep, voffB); PG8_STAGE(PG8_SA(0, 0), cA, voffA); PG8_STAGE(PG8_SA(0, 1), cA + hstep, voffA);
        if (wr == 1) PG8_BAR;
        PG8_WAIT_V(2); PG8_BAR;
        PG8_STAGE(PG8_SB(1, 0), cB + kstep, voffB); PG8_STAGE(PG8_SA(1, 0), cA + kstep, voffA); PG8_STAGE(PG8_SB(1, 1), cB + hstep + kstep, voffB);
        PG8_WAIT_V(6); PG8_BAR;
    } else {
        PG8_STAGE(PG8_SB(0, 0), cB, voffB); PG8_STAGE(PG8_SA(0, 0), cA, voffA); PG8_STAGE(PG8_SB(0, 1), cB + hstep, voffB); PG8_STAGE(PG8_SA(0, 1), cA + hstep, voffA);
        if (wr == 1) PG8_BAR;
        PG8_WAIT_V(4); PG8_BAR;
        PG8_STAGE(PG8_SB(1, 0), cB + kstep, voffB); PG8_STAGE(PG8_SA(1, 0), cA + kstep, voffA); PG8_STAGE(PG8_SB(1, 1), cB + hstep + kstep, voffB);
        PG8_WAIT_V(6); PG8_BAR;
    }
    for (;;) {
        const bool has_next = S.next(ui + 1, nxt);
        const char* nA = has_next ? (const char*)g.A + (size_t)nxt.pm * tstep : cA; const char* nB = has_next ? (const char*)g.Bt + (size_t)nxt.pn * tstep : cB;
        for (int t = 0; t < nt; t += 2) {
            const bool last = (t == nt - 2);
            const char* a1 = cA + (size_t)(t + 1) * kstep;
            const char* a2 = last ? nA : cA + (size_t)(t + 2) * kstep; const char* b2 = last ? nB : cB + (size_t)(t + 2) * kstep;
            const char* a3 = a2 + kstep; const char* b3 = b2 + kstep;
            if (last && has_next) S.a_ready(nxt);
            if constexpr (SP2) {
            PG8_LDB(B0, 0, 0); PG8_LDB(B1, 0, 1); PG8_SCHED; PG8_LDA(At, 0, 0); PG8_STAGE(PG8_SA(1, 1), a1 + hstep, voffA);
            PG8_WAIT_V(8); PG8_WAIT_L(0); PG8_BAR; PG8_MMA(0, 0, At, B0); PG8_MMA(0, 1, At, B1); PG8_BAR; PG8_SCHED;
            PG8_LDA(At, 0, 1); PG8_STAGE(PG8_SB(0, 0), b2, voffB); PG8_STAGE(PG8_SB(0, 1), b2 + hstep, voffB); PG8_STAGE(PG8_SA(0, 0), a2, voffA);
            PG8_WAIT_V(8); PG8_WAIT_L(0); PG8_BAR; PG8_MMA(1, 0, At, B0); PG8_MMA(1, 1, At, B1); PG8_BAR; PG8_SCHED;
            PG8_LDB(B0, 1, 0); PG8_LDB(B1, 1, 1); PG8_SCHED; PG8_LDA(At, 1, 0); PG8_STAGE(PG8_SA(0, 1), a2 + hstep, voffA);
            PG8_WAIT_V(8); PG8_WAIT_L(0); PG8_BAR; PG8_MMA(0, 0, At, B0); PG8_MMA(0, 1, At, B1); PG8_BAR; PG8_SCHED;
            PG8_LDA(At, 1, 1); PG8_STAGE(PG8_SB(1, 0), b3, voffB); PG8_STAGE(PG8_SB(1, 1), b3 + hstep, voffB); PG8_STAGE(PG8_SA(1, 0), a3, voffA);
            PG8_WAIT_V(8); PG8_WAIT_L(0); PG8_BAR; PG8_MMA(1, 0, At, B0); PG8_MMA(1, 1, At, B1); PG8_BAR; PG8_SCHED;
            } else {
            PG8_LDB(B0, 0, 0); PG8_SCHED; PG8_LDA(At, 0, 0); PG8_STAGE(PG8_SA(1, 1), a1 + hstep, voffA);
            PG8_WAIT_L(8); PG8_BAR; PG8_WAIT_L(0); PG8_MMA(0, 0, At, B0); PG8_BAR; PG8_SCHED;
            PG8_LDB(B1, 0, 1); PG8_STAGE(PG8_SB(0, 0), b2, voffB);
            PG8_BAR; PG8_WAIT_L(0); PG8_MMA(0, 1, At, B1); PG8_BAR;
            PG8_LDA(At, 0, 1); PG8_STAGE(PG8_SA(0, 0), a2, voffA);
            PG8_BAR; PG8_WAIT_L(0); PG8_MMA(1, 0, At, B0); PG8_BAR; PG8_SCHED;
            PG8_STAGE(PG8_SB(0, 1), b2 + hstep, voffB);
            PG8_WAIT_V(6); PG8_BAR; PG8_MMA(1, 1, At, B1); PG8_BAR;
            PG8_LDB(B0, 1, 0); PG8_SCHED; PG8_LDA(At, 1, 0); PG8_STAGE(PG8_SA(0, 1), a2 + hstep, voffA);
            PG8_WAIT_L(8); PG8_BAR; PG8_WAIT_L(0); PG8_MMA(0, 0, At, B0); PG8_BAR; PG8_SCHED;
            PG8_LDB(B1, 1, 1); PG8_STAGE(PG8_SB(1, 0), b3, voffB);
            PG8_BAR; PG8_WAIT_L(0); PG8_MMA(0, 1, At, B1); PG8_BAR;
            PG8_LDA(At, 1, 1); PG8_STAGE(PG8_SA(1, 0), a3, voffA);
            PG8_BAR; PG8_WAIT_L(0); PG8_MMA(1, 0, At, B0); PG8_BAR; PG8_SCHED;
            PG8_STAGE(PG8_SB(1, 1), b3 + hstep, voffB);
            PG8_WAIT_V(6); PG8_BAR; PG8_MMA(1, 1, At, B1); PG8_BAR;
            }
        }
        if constexpr (ALIGN_EPI) { if (wr == 0) PG8_BAR; }
        if constexpr (!Epi::AFTER_DRAIN) { E(acc, cur, wr, wc, fr, fq); S.done(cur); }
        if (!has_next) break;
#pragma unroll
        for (int a = 0; a < 2; ++a)
#pragma unroll
            for (int b = 0; b < 2; ++b)
#pragma unroll
                for (int m = 0; m < 4; ++m)
#pragma unroll
                    for (int n = 0; n < 2; ++n) acc[a][b][m][n] = (f32x4){0.f, 0.f, 0.f, 0.f};
        cur = nxt; cA = nA; cB = nB; ++ui;
        if constexpr (ALIGN_EPI) { if (wr == 1) PG8_BAR; }
    }
    PG8_WAIT_V(0);
    if constexpr (!ALIGN_EPI) { if (wr == 0) PG8_BAR; }
    PG8_BAR;
#undef PG8_SA
#undef PG8_SB
#undef PG8_STAGE
#undef PG8_LDA
#undef PG8_LDB
#undef PG8_MMA
#undef PG8_WAIT_V
#undef PG8_WAIT_L
#undef PG8_BAR
#undef PG8_SCHED
}
}

struct Args {
    const float* x; const float* norm_g; const float* w_in; const float* qa_g; const float* w_uq; const float* kva_g; const float* w_ukv;
    const float* dlam; const float* subg; const float* conv_w; const float* w_out; const float* rel_bias; const float* final_g;
    float* out; unsigned char* ws;
    float lambda_init[2]; int pad[2];
};

typedef const __attribute__((address_space(4))) Args* ArgsP;
__device__ __forceinline__ ArgsP get_args() { ArgsP p = (ArgsP)__builtin_amdgcn_kernarg_segment_ptr(); asm volatile("" : "+s"(p)); return p; }

#define XB_TMO      128
#define XB_XCNT(j)  (256  + 64 * (j))
#define XB_XSUB(j)  (1280 + 64 * (j))
#define XB_XGEN(j)  (2304 + 64 * (j))
#define XB_TOP      3328
#define XB_TOPGEN   3392
#define XCD_BAR_WORDS 3456
#define XB_SPIN_CAP (1u << 18)
constexpr int LDS_XB = 148464;
__device__ __forceinline__ unsigned xb_ld(unsigned* p)              { return __hip_atomic_load(p, __ATOMIC_RELAXED, __HIP_MEMORY_SCOPE_AGENT); }
__device__ __forceinline__ unsigned xb_add(unsigned* p, unsigned v) { return __hip_atomic_fetch_add(p, v, __ATOMIC_RELAXED, __HIP_MEMORY_SCOPE_AGENT); }
__device__ __forceinline__ unsigned xb_xcc_id() { return (unsigned)__builtin_amdgcn_s_getreg((3 << 11) | 20) & 0xFu; }
#define XB_SPIN(cond, bar) do { unsigned _sp = 0; while (cond) { __builtin_amdgcn_s_sleep(1); \
    if ((++_sp & 255u) == 0u) { if (xb_ld(&(bar)[XB_TMO])) break; if (_sp > XB_SPIN_CAP) { atomicAdd(&(bar)[XB_TMO], 1u); break; } } } } while (0)
__device__ __forceinline__ void xcd_barrier_complete(unsigned* bar, unsigned x, unsigned& nloc, unsigned& nx) {
    const unsigned G = gridDim.x * gridDim.y * gridDim.z;
    unsigned sum, cnt, mine, sp = 0u;
    for (;;) {
        sum = 0u; cnt = 0u; mine = 0u;
#pragma unroll
        for (unsigned j = 0; j < 16; ++j) { const unsigned c = xb_ld(&bar[XB_XCNT(j)]); sum += c; cnt += (c > 0u) ? 1u : 0u; mine = (j == x) ? c : mine; }
        if (sum == G) break;
        __builtin_amdgcn_s_sleep(1);
        if ((++sp & 255u) == 0u) { if (xb_ld(&bar[XB_TMO])) break; if (sp > XB_SPIN_CAP) { atomicAdd(&bar[XB_TMO], 1u); break; } }
    }
    nloc = mine > 0u ? mine : 1u; nx = cnt > 0u ? cnt : 1u;
}
__device__ __forceinline__ void xcd_barrier_post(LAS unsigned char* lds) {
    ArgsP A = get_args(); unsigned* bar = (unsigned*)A->ws;
    if (threadIdx.x == 0) { ((volatile LAS unsigned*)(lds + LDS_XB))[0] = 0u; ((volatile LAS unsigned*)(lds + LDS_XB))[1] = 0u;
        (void)xb_add(&bar[XB_XCNT(xb_xcc_id())], 1u); }
    __syncthreads();
}
__device__ __forceinline__ void xcd_barrier(LAS unsigned char* lds) {
    ArgsP A = get_args(); unsigned* bar = (unsigned*)A->ws;
    asm volatile("s_waitcnt vmcnt(0)" ::: "memory");
    __syncthreads();
    if (threadIdx.x == 0) {
        const unsigned x = xb_xcc_id();
        volatile LAS unsigned* st = (volatile LAS unsigned*)(lds + LDS_XB);
        __builtin_amdgcn_s_waitcnt(0);
        unsigned nloc = st[0], nx = st[1];
        if (nloc == 0u) { xcd_barrier_complete(bar, x, nloc, nx); st[0] = nloc; st[1] = nx; }
        const unsigned old = xb_add(&bar[XB_XSUB(x)], 1u);
        const unsigned gen = old / nloc;
        if (old + 1u == (gen + 1u) * nloc) {
            __builtin_amdgcn_fence(__ATOMIC_RELEASE, "agent");
            asm volatile("s_waitcnt vmcnt(0)" ::: "memory");
            const unsigned og = xb_add(&bar[XB_TOP], 1u);
            const unsigned tg = og / nx;
            if (og + 1u == (tg + 1u) * nx) xb_add(&bar[XB_TOPGEN], 1u);
            else XB_SPIN(xb_ld(&bar[XB_TOPGEN]) == tg, bar);
            __builtin_amdgcn_fence(__ATOMIC_ACQUIRE, "agent");
            xb_add(&bar[XB_XGEN(x)], 1u);
            asm volatile("s_waitcnt vmcnt(0)" ::: "memory");
        } else {
            XB_SPIN(xb_ld(&bar[XB_XGEN(x)]) == gen, bar);
            __builtin_amdgcn_fence(__ATOMIC_ACQUIRE, "agent");
            asm volatile("s_waitcnt vmcnt(0)" ::: "memory");
        }
    }
    __syncthreads();
}

constexpr float QS_MLA = 0.10206207261596575f * 1.4426950408889634f;
constexpr float QS_DIFF = 0.17677669529663687f * 1.4426950408889634f;
constexpr float QS_DSA = 0.125f * 1.4426950408889634f;
template <bool OUT_BF16>
__device__ __forceinline__ void rms_rows4(const float* xbase, size_t rstride, const float* g, bf16_t* obase, float* fbase, int lane) {
    f32x4 v[4][4]; float ss[4];
#pragma unroll
    for (int k = 0; k < 4; ++k) { const f32x4* xr = (const f32x4*)(xbase + k * rstride) + lane;
#pragma unroll
        for (int j = 0; j < 4; ++j) v[k][j] = xr[64 * j]; }
#pragma unroll
    for (int k = 0; k < 4; ++k) { float s = 0.f;
#pragma unroll
        for (int j = 0; j < 4; ++j) s += v[k][j].x * v[k][j].x + v[k][j].y * v[k][j].y + v[k][j].z * v[k][j].z + v[k][j].w * v[k][j].w;
        ss[k] = s; }
#pragma unroll
    for (int o = 1; o < 64; o <<= 1) {
#pragma unroll
        for (int k = 0; k < 4; ++k) ss[k] += __shfl_xor(ss[k], o); }
    f32x4 gv[4];
#pragma unroll
    for (int j = 0; j < 4; ++j) gv[j] = ((const f32x4*)g)[lane + 64 * j];
#pragma unroll
    for (int k = 0; k < 4; ++k) { const float r = rsqrtf(ss[k] * (1.f / D) + EPS);
#pragma unroll
        for (int j = 0; j < 4; ++j) {
            const f32x4 o = (f32x4){v[k][j].x * r * gv[j].x, v[k][j].y * r * gv[j].y, v[k][j].z * r * gv[j].z, v[k][j].w * r * gv[j].w};
            if (OUT_BF16) { u32x2 w; w.x = pg8::cvt_pk_bf16(o.x, o.y); w.y = pg8::cvt_pk_bf16(o.z, o.w); ((u32x2*)(obase + k * rstride))[lane + 64 * j] = w; }
            else ((f32x4*)(fbase + k * rstride))[lane + 64 * j] = o;
        } }
}
template <bool OUT_BF16>
__device__ __forceinline__ void rms_rows4b(const bf16_t* xbase, size_t rstride, const float* g, bf16_t* obase, float* fbase, int lane) {
    u16x8 v[4][2]; float ss[4];
#pragma unroll
    for (int k = 0; k < 4; ++k) { const u16x8* xr = (const u16x8*)(xbase + k * rstride) + lane;
#pragma unroll
        for (int j = 0; j < 2; ++j) v[k][j] = xr[64 * j]; }
#pragma unroll
    for (int k = 0; k < 4; ++k) { float s = 0.f;
#pragma unroll
        for (int j = 0; j < 2; ++j)
#pragma unroll
            for (int e = 0; e < 8; ++e) { const float f = bf2f(v[k][j][e]); s += f * f; }
        ss[k] = s; }
#pragma unroll
    for (int o = 1; o < 64; o <<= 1) {
#pragma unroll
        for (int k = 0; k < 4; ++k) ss[k] += __shfl_xor(ss[k], o); }
    f32x4 gv[2][2];
#pragma unroll
    for (int j = 0; j < 2; ++j) { gv[j][0] = ((const f32x4*)g)[2 * lane + 128 * j]; gv[j][1] = ((const f32x4*)g)[2 * lane + 1 + 128 * j]; }
#pragma unroll
    for (int k = 0; k < 4; ++k) { const float r = rsqrtf(ss[k] * (1.f / D) + EPS);
#pragma unroll
        for (int j = 0; j < 2; ++j) {
            f32x4 o0, o1;
#pragma unroll
            for (int e = 0; e < 4; ++e) { o0[e] = bf2f(v[k][j][e]) * r * gv[j][0][e]; o1[e] = bf2f(v[k][j][4 + e]) * r * gv[j][1][e]; }
            if (OUT_BF16) { u32x4 w; w.x = pg8::cvt_pk_bf16(o0[0], o0[1]); w.y = pg8::cvt_pk_bf16(o0[2], o0[3]); w.z = pg8::cvt_pk_bf16(o1[0], o1[1]); w.w = pg8::cvt_pk_bf16(o1[2], o1[3]);
                ((u32x4*)(obase + k * rstride))[lane + 64 * j] = w; }
            else { ((f32x4*)(fbase + k * rstride))[2 * lane + 128 * j] = o0; ((f32x4*)(fbase + k * rstride))[2 * lane + 1 + 128 * j] = o1; }
        } }
}
__device__ __forceinline__ void convert_tile(LAS float* scr, const float* W, bf16_t* Wt, int K, int Nsrc, int remap, float uscale, int k0, int n0, int tid) {
    __syncthreads();
#pragma unroll
    for (int i = 0; i < 8; ++i) { const int e = tid + 512 * i, kk = e >> 6, nn = e & 63, n = n0 + nn;
        const int sc = remap ? orig_col(n) : n;
        float s = uscale;
        if (remap) { if (n >= CB_Q && n < CB_Q + 256) s = QS_DIFF; if (n >= CC_Q && n < CC_Q + 256) s = QS_DSA; }
        scr[kk * 65 + nn] = (sc >= 0) ? W[(size_t)(k0 + kk) * Nsrc + sc] * s : 0.f; }
    __syncthreads();
    { const int nn = tid >> 3, kc = (tid & 7) * 8;
        u32x4 w; w.x = pg8::cvt_pk_bf16(scr[(kc + 0) * 65 + nn], scr[(kc + 1) * 65 + nn]); w.y = pg8::cvt_pk_bf16(scr[(kc + 2) * 65 + nn], scr[(kc + 3) * 65 + nn]);
        w.z = pg8::cvt_pk_bf16(scr[(kc + 4) * 65 + nn], scr[(kc + 5) * 65 + nn]); w.w = pg8::cvt_pk_bf16(scr[(kc + 6) * 65 + nn], scr[(kc + 7) * 65 + nn]);
        *(u32x4*)(Wt + (size_t)(n0 + nn) * K + k0 + kc) = w; }
}
namespace fa {
typedef short ps16x2 __attribute__((ext_vector_type(2)));
typedef unsigned short pu16x2 __attribute__((ext_vector_type(2)));
__device__ __forceinline__ unsigned ppk_lt(unsigned v, unsigned c) { const ps16x2 d = __builtin_elementwise_sub_sat(__builtin_bit_cast(ps16x2, v), __builtin_bit_cast(ps16x2, c)); return __builtin_bit_cast(unsigned, __builtin_bit_cast(pu16x2, d) >> 15); }
__device__ __forceinline__ unsigned ppk_add(unsigned a, unsigned b) { return __builtin_bit_cast(unsigned, __builtin_bit_cast(pu16x2, a) + __builtin_bit_cast(pu16x2, b)); }
typedef float f32x16 __attribute__((ext_vector_type(16)));
typedef short s16x4 __attribute__((ext_vector_type(4)));
typedef short v4i16_t __attribute__((ext_vector_type(4)));
constexpr int KCS = 1040;
constexpr int KBUF = 12 * KCS + 64;
constexpr int L_K0 = 0, L_V0 = 4 * KBUF, L_WSF = L_V0 + 4 * 8192, L_BIAS = L_WSF + 8 * 256, L_END = L_BIAS + 12 * 320 * 4, L_FLAG = L_END;
constexpr float THR = 6.0f;
constexpr float LOG2E = 1.4426950408889634f;
__device__ __forceinline__ int crow(int r, int hi) { return (r & 3) + 8 * (r >> 2) + 4 * hi; }
__device__ __forceinline__ unsigned cvtpk(float lo, float hi) { typedef float f2 __attribute__((ext_vector_type(2))); typedef __bf16 b2 __attribute__((ext_vector_type(2)));
    f2 v = {lo, hi}; b2 r = __builtin_convertvector(v, b2); return __builtin_bit_cast(unsigned, r); }
__device__ __forceinline__ s16x4 vtr(const LAS unsigned char* p) { return __builtin_bit_cast(s16x4, __builtin_amdgcn_ds_read_tr16_b64_v4i16((LAS v4i16_t*)p)); }
__device__ __forceinline__ float max3f(float a, float b, float c) { float r; asm("v_max3_f32 %0, %1, %2, %3" : "=v"(r) : "v"(a), "v"(b), "v"(c)); return r; }
__device__ __forceinline__ float max2f(float a, float b) { float r; asm("v_max_f32_e32 %0, %1, %2" : "=v"(r) : "v"(a), "v"(b)); return r; }
#define FA_ROWMAX(rm, S0, S1) do { asm volatile("s_nop 15\n\ts_nop 7" : "+v"(S0), "+v"(S1)); \
        float a_ = max3f(S0[0], S0[1], S1[0]), b_ = max3f(S0[2], S0[3], S1[1]); a_ = max3f(a_, S1[2], S1[3]); \
        _Pragma("unroll") for (int r = 4; r < 16; r += 4) { a_ = max3f(a_, S0[r], S0[r + 1]); b_ = max3f(b_, S0[r + 2], S0[r + 3]); a_ = max3f(a_, S1[r], S1[r + 1]); b_ = max3f(b_, S1[r + 2], S1[r + 3]); } \
        rm = max2f(a_, b_); } while (0)
__device__ __forceinline__ float xhalf_max(float v) { auto rr = __builtin_amdgcn_permlane32_swap(__float_as_uint(v), __float_as_uint(v), false, false); return fmaxf(__uint_as_float(rr[0]), __uint_as_float(rr[1])); }
__device__ __forceinline__ float xhalf_sum(float v) { auto rr = __builtin_amdgcn_permlane32_swap(__float_as_uint(v), __float_as_uint(v), false, false); return __uint_as_float(rr[0]) + __uint_as_float(rr[1]); }

__device__ __forceinline__ void build_bias(LAS unsigned char* lds, const float* rel_bias) {
    LAS float* bt = (LAS float*)(lds + L_BIAS);
    for (int e = opaque_tid(); e < 12 * 320; e += NTHR) { const int col = e / 320, i = e % 320;
        bt[e] = (rel_bias[rel_bucket(i - 256) * 12 + col] - rel_bias[15 * 12 + col]) * LOG2E; }
}

template <int TYPE>
__device__ __forceinline__ void attn_unit(LAS unsigned char* lds, int b, int h, int qb, int layer) {
    ArgsP A = get_args();
    unsigned char* ws = A->ws;
    const bf16_t* P = (const bf16_t*)(ws + WS_P);
    const int tid = opaque_tid(), lane = tid & 63, r32 = lane & 31, hi = lane >> 5, wid = __builtin_amdgcn_readfirstlane(tid >> 6);
    constexpr int DK = (TYPE == 0) ? 96 : 64, NCH = DK / 8, NPASS = (TYPE == 1) ? 2 : 1, DQ = (TYPE == 0) ? 96 : (TYPE == 1) ? 32 : 64, NQF = DQ / 16;
    const size_t row0 = (size_t)b * S;
    const bf16_t* Kg; const bf16_t* Vg; int kpitch, vpitch;
    if (TYPE == 0) { Kg = (const bf16_t*)(ws + WS_KA) + row0 * 384 + h * 96; kpitch = 384; Vg = (const bf16_t*)(ws + WS_VA) + row0 * 256 + h * 64; vpitch = 256; }
    else { Kg = P + row0 * PC + ((TYPE == 1) ? CB_K : CC_K) + h * 64; kpitch = PC; Vg = P + row0 * PC + ((TYPE == 1) ? CB_V : CC_V) + h * 64; vpitch = PC; }
    const int k0key = tid / NCH, k0ch = tid % NCH;
    const int k1key = (tid + 512) / NCH, k1ch = (tid + 512) % NCH;
    const bool has_k1 = (NCH == 12) && (tid < 256);
    const int vkey = tid >> 3, vc8 = tid & 7;
    const bf16_t* kg0 = Kg + (size_t)k0key * kpitch + k0ch * 8;
    const bf16_t* kg1 = Kg + (size_t)k1key * kpitch + k1ch * 8;
    const bf16_t* vg0 = Vg + (size_t)vkey * vpitch + vc8 * 8;
    const int kl0 = k0ch * KCS + k0key * 16, kl1 = k1ch * KCS + k1key * 16;
    const int vl0 = ((vc8 >> 2) * 4 + (vkey >> 4)) * 1024 + (vkey & 15) * 64 + (vc8 & 3) * 16;
    const int qw = qb * 256 + wid * 32;
    const size_t tq = row0 + qw + r32;
    const int NT = 4 * qb + 4, NTw = 4 * qb + (wid >> 1) + 1, TM = 4 * qb;
    LAS float* wsf = (LAS float*)(lds + L_WSF) + wid * 64;
    const LAS unsigned char* vfb = lds + L_V0 + ((lane >> 4) & 1) * 32 + (lane & 3) * 8 + (4 * hi + ((lane & 15) >> 2)) * 64;
    const unsigned* mrow = (const unsigned*)(ws + WS_MASK) + tq * 128;
    float* okl = (float*)(ws + WS_OKL) + ((size_t)opaque_bid() * 8 + wid) * 2048 + lane;
    f32x16 o0 = f32x16{}, o1 = f32x16{};
    float mhat = 0.f, lsum = 0.f;
    int fast = 1; asm volatile("" : "+s"(fast));
#pragma unroll 1
    for (;;) {
#pragma unroll 1
    for (int mp = 0; mp < NPASS; ++mp) {
    bf16x8 qf[NQF];
#pragma unroll
    for (int d0 = 0; d0 < NQF; ++d0) {
        const bf16_t* qp = (TYPE == 0) ? (const bf16_t*)(ws + WS_QA) + tq * 384 + h * 96 + 16 * d0 + 8 * hi
                                       : P + tq * PC + ((TYPE == 1) ? CB_Q + mp * 32 : CC_Q) + h * 64 + 16 * d0 + 8 * hi;
        qf[d0] = *(const bf16x8*)qp;
    }
    mhat = 0.f; lsum = 0.f; o0 = f32x16{}; o1 = f32x16{};
    const LAS unsigned char* kfb = lds + L_K0 + hi * KCS + r32 * 16 + ((TYPE == 1) ? mp * 4 * KCS : 0);
    const LAS unsigned char* btb = lds + L_BIAS + (256 + 4 * hi - r32 - qw) * 4 + ((TYPE == 1) ? 2 * h + mp : 8 + h) * 1280;
    u32x4 kr0, kr1, vr;
    const bf16_t* kp0 = kg0; const bf16_t* kp1 = kg1; const bf16_t* vp0 = vg0;
    const size_t kstep = (size_t)64 * kpitch, vstep = (size_t)64 * vpitch;
#define FA_BIAS(S0, S1, t) do { if (TYPE != 0) { if (64 * (t) > qw - 154) { const LAS float* bt = (const LAS float*)(btb + (t) * 256); \
            _Pragma("unroll") for (int r = 0; r < 16; ++r) { S0[r] += bt[(r & 3) + 8 * (r >> 2)]; S1[r] += bt[32 + (r & 3) + 8 * (r >> 2)]; } } } } while (0)
#define FA_RESCALE(S0, S1, t) do { if (fast) break; \
        float rm; FA_ROWMAX(rm, S0, S1); \
        rm = xhalf_max(rm); \
        const bool first = ((t) == 0); \
        if (__any(first || rm > THR)) { \
            const float dl = first ? fmaxf(rm, -64.f) : fmaxf(rm, 0.f);     \
            mhat += dl; \
            _Pragma("unroll") for (int r = 0; r < 16; ++r) { S0[r] -= dl; S1[r] -= dl; } \
            if (!first) { const float f = __builtin_amdgcn_exp2f(-dl); lsum *= f; \
                if (hi == 0) wsf[r32] = f; \
                _Pragma("unroll") for (int r = 0; r < 16; ++r) { const float fr_ = wsf[crow(r, hi)]; o0[r] *= fr_; o1[r] *= fr_; } \
                asm volatile("" ::: "memory"); } \
        } } while (0)
#define FA_EXP(S0, S1) do { float sacc = 0.f; \
        _Pragma("unroll") for (int r = 0; r < 16; ++r) { \
            S0[r] = __builtin_amdgcn_exp2f(S0[r]); S1[r] = __builtin_amdgcn_exp2f(S1[r]); \
            sacc += S0[r] + S1[r]; } \
        lsum += sacc; \
        _Pragma("unroll") for (int i = 0; i < 4; ++i) { pw[0][i] = cvtpk(S0[2 * i], S0[2 * i + 1]); pw[1][i] = cvtpk(S0[8 + 2 * i], S0[8 + 2 * i + 1]); \
                                                       pw[2][i] = cvtpk(S1[2 * i], S1[2 * i + 1]); pw[3][i] = cvtpk(S1[8 + 2 * i], S1[8 + 2 * i + 1]); } } while (0)
#define FA_PV() do { \
        _Pragma("unroll") for (int ks = 0; ks < 4; ++ks) { const bf16x8 vfrag = (bf16x8){vlo_[ks][0], vlo_[ks][1], vlo_[ks][2], vlo_[ks][3], vhi_[ks][0], vhi_[ks][1], vhi_[ks][2], vhi_[ks][3]}; \
            o0 = __builtin_amdgcn_mfma_f32_32x32x16_bf16(__builtin_bit_cast(bf16x8, pw[ks]), vfrag, o0, 0, 0, 0); } \
        _Pragma("unroll") for (int i = 0; i < 4; ++i) { vlo_[i] = vtr(vb_ + (4 + i) * 1024); vhi_[i] = vtr(vb_ + (4 + i) * 1024 + 512); } \
        _Pragma("unroll") for (int ks = 0; ks < 4; ++ks) { const bf16x8 vfrag = (bf16x8){vlo_[ks][0], vlo_[ks][1], vlo_[ks][2], vlo_[ks][3], vhi_[ks][0], vhi_[ks][1], vhi_[ks][2], vhi_[ks][3]}; \
            o1 = __builtin_amdgcn_mfma_f32_32x32x16_bf16(__builtin_bit_cast(bf16x8, pw[ks]), vfrag, o1, 0, 0, 0); } } while (0)
#define FA_KLOAD(ks_off) do { const LAS unsigned char* kb_ = kfb + (ks_off); \
        _Pragma("unroll") for (int d0 = 0; d0 < NQF; ++d0) { ka_[d0][0] = *(const LAS bf16x8*)(kb_ + d0 * 2 * KCS); ka_[d0][1] = *(const LAS bf16x8*)(kb_ + d0 * 2 * KCS + 512); } } while (0)
#define FA_QKMFMA(N0, N1, tt, MW0, MW1) do { \
        if (TYPE == 2) { const unsigned w0_ = MW0 >> (4 * hi), w1_ = MW1 >> (4 * hi); const unsigned nm_ = __float_as_uint(-mhat); unsigned neg_ = 0xF149F2CAu; asm volatile("" : "+v"(neg_)); \
            _Pragma("unroll") for (int r = 0; r < 16; ++r) { const int pos_ = (r & 3) + 8 * (r >> 2); \
                const unsigned k0m = (unsigned)((int)(w0_ << (31 - pos_)) >> 31), k1m = (unsigned)((int)(w1_ << (31 - pos_)) >> 31); \
                N0[r] = __uint_as_float(__builtin_amdgcn_bitop3_b32(k0m, nm_, neg_, 0xCA)); N1[r] = __uint_as_float(__builtin_amdgcn_bitop3_b32(k1m, nm_, neg_, 0xCA)); } }     \
        else if (fast) { N0 = __builtin_amdgcn_mfma_f32_32x32x16_bf16(ka_[0][0], qf[0], f32x16{}, 0, 0, 0); N1 = __builtin_amdgcn_mfma_f32_32x32x16_bf16(ka_[0][1], qf[0], f32x16{}, 0, 0, 0); } \
        else { const float nm_ = -mhat; N0 = (f32x16){nm_, nm_, nm_, nm_, nm_, nm_, nm_, nm_, nm_, nm_, nm_, nm_, nm_, nm_, nm_, nm_}; N1 = N0; \
            N0 = __builtin_amdgcn_mfma_f32_32x32x16_bf16(ka_[0][0], qf[0], N0, 0, 0, 0); N1 = __builtin_amdgcn_mfma_f32_32x32x16_bf16(ka_[0][1], qf[0], N1, 0, 0, 0); } \
        _Pragma("unroll") for (int d0 = (TYPE == 2) ? 0 : 1; d0 < NQF; ++d0) { \
            N0 = __builtin_amdgcn_mfma_f32_32x32x16_bf16(ka_[d0][0], qf[d0], N0, 0, 0, 0); \
            N1 = __builtin_amdgcn_mfma_f32_32x32x16_bf16(ka_[d0][1], qf[d0], N1, 0, 0, 0); } } while (0)
#define FA_VLOAD(vs_off) const LAS unsigned char* vb_ = vfb + (vs_off); \
        _Pragma("unroll") for (int i = 0; i < 4; ++i) { vlo_[i] = vtr(vb_ + i * 1024); vhi_[i] = vtr(vb_ + i * 1024 + 512); }
#define FA_MASKW(t)
#define FA_STEP_U(C0, C1, N0, N1, t, vs_off, nks_off, MW0, MW1) do { \
        bf16x8 ka_[NQF][2]; s16x4 vlo_[4], vhi_[4]; u32x4 pw[4]; \
        FA_KLOAD(nks_off); FA_VLOAD(vs_off); FA_MASKW(t); \
        FA_BIAS(C0, C1, t); FA_RESCALE(C0, C1, t); \
        FA_QKMFMA(N0, N1, (t) + 1, MW0, MW1); FA_EXP(C0, C1); FA_PV(); } while (0)
#define FA_STEP_C(C0, C1, N0, N1, t, vs_off, nks_off, MW0, MW1) do { \
        if ((t) + 1 < NTw) { bf16x8 ka_[NQF][2]; FA_KLOAD(nks_off); FA_QKMFMA(N0, N1, (t) + 1, MW0, MW1); } \
        if ((t) < NTw) { s16x4 vlo_[4], vhi_[4]; u32x4 pw[4]; FA_VLOAD(vs_off); FA_MASKW(t); \
            FA_BIAS(C0, C1, t); \
            if (!fast) { float rm; FA_ROWMAX(rm, C0, C1); \
              rm = xhalf_max(rm); \
              const bool first = ((t) == 0); \
              if (__any(first || rm > THR)) { \
                const float dl = first ? fmaxf(rm, -64.f) : fmaxf(rm, 0.f);     \
                mhat += dl; \
                _Pragma("unroll") for (int r = 0; r < 16; ++r) { C0[r] -= dl; C1[r] -= dl; N0[r] -= dl; N1[r] -= dl; } \
                if (!first) { const float f = __builtin_amdgcn_exp2f(-dl); lsum *= f; \
                    if (hi == 0) wsf[r32] = f; \
                    _Pragma("unroll") for (int r = 0; r < 16; ++r) { const float fr_ = wsf[crow(r, hi)]; o0[r] *= fr_; o1[r] *= fr_; } \
                    asm volatile("" ::: "memory"); } } } \
            FA_EXP(C0, C1); FA_PV(); } } while (0)
#define FA_LOADKV(tk, tv) do { if (FA_UNC || (tk) < NT) { kr0 = *(const u32x4*)kp0; if (has_k1) kr1 = *(const u32x4*)kp1; kp0 += kstep; kp1 += kstep; } \
        if (FA_UNC || (tv) < NT) { vr = *(const u32x4*)vp0; vp0 += vstep; } } while (0)
#define FA_COMMIT(tk, kslot, tv, vslot) do { if (FA_UNC || (tk) < NT) { *(LAS u32x4*)(lds + L_K0 + (kslot) + kl0) = kr0; if (has_k1) *(LAS u32x4*)(lds + L_K0 + (kslot) + kl1) = kr1; } \
        if (FA_UNC || (tv) < NT) *(LAS u32x4*)(lds + L_V0 + (vslot) + vl0) = vr; } while (0)
#define FA_UNC 0
    {
        FA_LOADKV(0, 0);
        const u32x4 ka0 = kr0, ka1 = kr1, va = vr;
        FA_LOADKV(1, 1);
        const u32x4 kb0 = kr0, kb1 = kr1, vb = vr;
        FA_LOADKV(2, NT);
        __syncthreads();
        *(LAS u32x4*)(lds + L_K0 + kl0) = ka0; if (has_k1) *(LAS u32x4*)(lds + L_K0 + kl1) = ka1; *(LAS u32x4*)(lds + L_V0 + vl0) = va;
        *(LAS u32x4*)(lds + L_K0 + KBUF + kl0) = kb0; if (has_k1) *(LAS u32x4*)(lds + L_K0 + KBUF + kl1) = kb1; *(LAS u32x4*)(lds + L_V0 + 8192 + vl0) = vb;
        FA_COMMIT(2, 2 * KBUF, NT, 0);
        if (fast && mp == 0 && tid == 0) *(volatile LAS unsigned*)(lds + L_FLAG) = 0u;
    }
    __syncthreads();
    f32x16 sA0, sA1, sB0, sB1;
    unsigned mwA0 = 0u, mwA1 = 0u, mwB0 = 0u, mwB1 = 0u;
#define FA_MLOAD(W0, W1, tt) do { if (TYPE == 2 && (FA_UNC || (tt) < NT)) { W0 = mrow[2 * (tt)]; W1 = mrow[2 * (tt) + 1]; } } while (0)
    FA_MLOAD(mwA0, mwA1, 0); FA_MLOAD(mwB0, mwB1, 1);
    { bf16x8 ka_[NQF][2]; FA_KLOAD(0); FA_QKMFMA(sA0, sA1, 0, mwA0, mwA1); }
    __syncthreads();
#pragma unroll
    for (int r = 0; r < 16; ++r) { sB0[r] = 0.f; sB1[r] = 0.f; }
#define FA_KS(tt) ((((tt)) & 3) * KBUF)
#define FA_VS(tt) ((((tt)) & 3) * 8192)
    int t = 0;
#undef FA_UNC
#define FA_UNC 1
    for (; t < TM; t += 2) {
        FA_LOADKV(t + 3, t + 2); FA_MLOAD(mwA0, mwA1, t + 2);
        FA_STEP_U(sA0, sA1, sB0, sB1, t, FA_VS(t), FA_KS(t + 1), mwB0, mwB1);
        FA_COMMIT(t + 3, FA_KS(t + 3), t + 2, FA_VS(t + 2));
        FA_LOADKV(t + 4, t + 3); FA_MLOAD(mwB0, mwB1, t + 3);
        FA_STEP_U(sB0, sB1, sA0, sA1, t + 1, FA_VS(t + 1), FA_KS(t + 2), mwA0, mwA1);
        FA_COMMIT(t + 4, FA_KS(t + 4), t + 3, FA_VS(t + 3));
        __syncthreads();
    }
#undef FA_UNC
#define FA_UNC 0
    for (; t < NT; t += 2) {
        FA_LOADKV(t + 3, t + 2); FA_MLOAD(mwA0, mwA1, t + 2);
        FA_STEP_C(sA0, sA1, sB0, sB1, t, FA_VS(t), FA_KS(t + 1), mwB0, mwB1);
        FA_COMMIT(t + 3, FA_KS(t + 3), t + 2, FA_VS(t + 2));
        FA_LOADKV(t + 4, t + 3); FA_MLOAD(mwB0, mwB1, t + 3);
        FA_STEP_C(sB0, sB1, sA0, sA1, t + 1, FA_VS(t + 1), FA_KS(t + 2), mwA0, mwA1);
        FA_COMMIT(t + 4, FA_KS(t + 4), t + 3, FA_VS(t + 3));
        __syncthreads();
    }
#undef FA_KS
#undef FA_UNC
#undef FA_MLOAD
#undef FA_VS
#undef FA_BIAS
#undef FA_RESCALE
#undef FA_EXP
#undef FA_PV
#undef FA_KLOAD
#undef FA_QKMFMA
#undef FA_VLOAD
#undef FA_MASKW
#undef FA_STEP_U
#undef FA_STEP_C
#undef FA_LOADKV
#undef FA_COMMIT
    {
        const float lt = xhalf_sum(lsum);
        if (fast) { if (!(lt >= 0x1p-90f && lt <= 0x1p90f)) *(volatile LAS unsigned*)(lds + L_FLAG) = 1u; }
        if (hi == 0) wsf[32 + r32] = __builtin_amdgcn_rcpf(lt);
#pragma unroll
        for (int r = 0; r < 16; ++r) { const float iv = wsf[32 + crow(r, hi)]; o0[r] *= iv; o1[r] *= iv; }
        asm volatile("" ::: "memory");
    }
    if (TYPE == 1 && mp == 0) {
#pragma unroll
        for (int r = 0; r < 16; ++r) { okl[r * 64] = o0[r]; okl[(16 + r) * 64] = o1[r]; }
    }
    }
    if (!fast) break;
    __syncthreads();
    if (__builtin_amdgcn_readfirstlane(*(volatile LAS unsigned*)(lds + L_FLAG)) == 0u) break;
    fast = 0;
    }
    const int gcol = (TYPE == 0) ? CA_G : (TYPE == 1) ? CB_G : CC_G;
    bf16_t* Y = (bf16_t*)(ws + WS_Y);
    float gs0[16], gs1[16];
    {
        bf16_t gr0[16], gr1[16];
#pragma unroll
        for (int r = 0; r < 16; ++r) { const bf16_t* gp = P + (row0 + qw + crow(r, hi)) * PC + gcol + h * 64; gr0[r] = gp[r32]; gr1[r] = gp[32 + r32]; }
#pragma unroll
        for (int r = 0; r < 16; ++r) { const float a0 = bf2f(gr0[r]), a1 = bf2f(gr1[r]);
            gs0[r] = a0 * __builtin_amdgcn_rcpf(1.f + __expf(-a0)); gs1[r] = a1 * __builtin_amdgcn_rcpf(1.f + __expf(-a1)); }
    }
    if (TYPE == 1) {
        const float* lamp = A->dlam + layer * 128;
        float s1 = 0.f, s2 = 0.f;
        for (int i = 0; i < 32; ++i) { s1 += lamp[i] * lamp[32 + i]; s2 += lamp[64 + i] * lamp[96 + i]; }
        const float lambda_init = A->lambda_init[layer];
        const float lam = __expf(s1) - __expf(s2) + lambda_init;
        const float g0 = A->subg[layer * 64 + r32], g1 = A->subg[layer * 64 + 32 + r32];
#pragma unroll
        for (int r = 0; r < 16; ++r) {
            const float v0 = okl[r * 64] - lam * o0[r];
            const float v1 = okl[(16 + r) * 64] - lam * o1[r];
            float ss = v0 * v0 + v1 * v1;
#pragma unroll
            for (int off = 1; off < 32; off <<= 1) ss += __shfl_xor(ss, off);
            const float rr = rsqrtf(ss * (1.f / 64.f) + EPS) * (1.f - lambda_init);
            bf16_t* yp = Y + (row0 + qw + crow(r, hi)) * D + 256 + h * 64;
            yp[r32] = f2bf(v0 * rr * g0 * gs0[r]);
            yp[32 + r32] = f2bf(v1 * rr * g1 * gs1[r]);
        }
    } else {
#pragma unroll
        for (int r = 0; r < 16; ++r) {
            bf16_t* yp = Y + (row0 + qw + crow(r, hi)) * D + TYPE * 256 + h * 64;
            yp[r32] = f2bf(o0[r] * gs0[r]);
            yp[32 + r32] = f2bf(o1[r] * gs1[r]);
        }
    }
}
__device__ __forceinline__ void attn_unit_diff(LAS unsigned char* lds, int b, int h, int qb, int layer) {
    ArgsP A = get_args();
    unsigned char* ws = A->ws;
    const bf16_t* P = (const bf16_t*)(ws + WS_P);
    const int tid = opaque_tid(), lane = tid & 63, r32 = lane & 31, hi = lane >> 5, wid = __builtin_amdgcn_readfirstlane(tid >> 6);
    const size_t row0 = (size_t)b * S;
    const int skey = tid >> 3, sch = tid & 7;
    const bf16_t* kg0 = P + (row0 + skey) * PC + CB_K + h * 64 + sch * 8;
    const bf16_t* vg0 = P + (row0 + skey) * PC + CB_V + h * 64 + sch * 8;
    const int kl0 = sch * KCS + skey * 16;
    const int vl0 = ((sch >> 2) * 4 + (skey >> 4)) * 1024 + (skey & 15) * 64 + (sch & 3) * 16;
    const int qw = qb * 256 + wid * 32;
    const size_t tq = row0 + qw + r32;
    const int NT = 4 * qb + 4, NTw = 4 * qb + (wid >> 1) + 1, TM = 4 * qb;
    LAS float* wsf = (LAS float*)(lds + L_WSF) + wid * 64;
    const LAS unsigned char* vfb = lds + L_V0 + ((lane >> 4) & 1) * 32 + (lane & 3) * 8 + (4 * hi + ((lane & 15) >> 2)) * 64;
    const LAS unsigned char* kfA = lds + L_K0 + hi * KCS + r32 * 16;
    const LAS unsigned char* kfB = kfA + 4 * KCS;
    const LAS unsigned char* btA = lds + L_BIAS + (256 + 4 * hi - r32 - qw) * 4 + (2 * h) * 1280;
    const LAS unsigned char* btB = btA + 1280;
    bf16x8 qA[2], qB[2];
#pragma unroll
    for (int d0 = 0; d0 < 2; ++d0) { qA[d0] = *(const bf16x8*)(P + tq * PC + CB_Q + h * 64 + 16 * d0 + 8 * hi); qB[d0] = *(const bf16x8*)(P + tq * PC + CB_Q + 32 + h * 64 + 16 * d0 + 8 * hi); }
    f32x16 oA0, oA1, oB0, oB1;
    float mA, mB, lA, lB;
    const size_t tstep = (size_t)64 * PC;
    int fast = 1; asm volatile("" : "+s"(fast));
#define DF_KS(tt) ((((tt)) & 3) * KBUF)
#define DF_VS(tt) ((((tt)) & 3) * 8192)
#define DF_QK(N0, N1, KF, ks_off, QF, MH) do { const LAS unsigned char* kb_ = (KF) + (ks_off); \
        const bf16x8 k00 = *(const LAS bf16x8*)kb_, k01 = *(const LAS bf16x8*)(kb_ + 512), k10 = *(const LAS bf16x8*)(kb_ + 2 * KCS), k11 = *(const LAS bf16x8*)(kb_ + 2 * KCS + 512); \
        if (fast) { N0 = __builtin_amdgcn_mfma_f32_32x32x16_bf16(k00, QF[0], f32x16{}, 0, 0, 0); N1 = __builtin_amdgcn_mfma_f32_32x32x16_bf16(k01, QF[0], f32x16{}, 0, 0, 0); } \
        else { const float nm_ = -(MH); N0 = (f32x16){nm_, nm_, nm_, nm_, nm_, nm_, nm_, nm_, nm_, nm_, nm_, nm_, nm_, nm_, nm_, nm_}; N1 = N0; \
            N0 = __builtin_amdgcn_mfma_f32_32x32x16_bf16(k00, QF[0], N0, 0, 0, 0); N1 = __builtin_amdgcn_mfma_f32_32x32x16_bf16(k01, QF[0], N1, 0, 0, 0); } \
        N0 = __builtin_amdgcn_mfma_f32_32x32x16_bf16(k10, QF[1], N0, 0, 0, 0); N1 = __builtin_amdgcn_mfma_f32_32x32x16_bf16(k11, QF[1], N1, 0, 0, 0); } while (0)
#define DF_SOFTMAX(S0, S1, O0, O1, MH, LS, BT, WOFF, t, PW) do { \
        if (64 * (t) > qw - 154) { const LAS float* bt = (const LAS float*)((BT) + (t) * 256); \
            _Pragma("unroll") for (int r = 0; r < 16; ++r) { S0[r] += bt[(r & 3) + 8 * (r >> 2)]; S1[r] += bt[32 + (r & 3) + 8 * (r >> 2)]; } } \
        if (!fast) { float rm; FA_ROWMAX(rm, S0, S1); rm = xhalf_max(rm); const bool first = ((t) == 0); \
            if (__any(first || rm > THR)) { const float dl = first ? fmaxf(rm, -64.f) : fmaxf(rm, 0.f); MH += dl; \
                _Pragma("unroll") for (int r = 0; r < 16; ++r) { S0[r] -= dl; S1[r] -= dl; } \
                if (!first) { const float f = __builtin_amdgcn_exp2f(-dl); LS *= f; if (hi == 0) wsf[(WOFF) + r32] = f; \
                    _Pragma("unroll") for (int r = 0; r < 16; ++r) { const float fr_ = wsf[(WOFF) + crow(r, hi)]; O0[r] *= fr_; O1[r] *= fr_; } \
                    asm volatile("" ::: "memory"); } } } \
        { float sacc = 0.f; \
          _Pragma("unroll") for (int r = 0; r < 16; ++r) { S0[r] = __builtin_amdgcn_exp2f(S0[r]); S1[r] = __builtin_amdgcn_exp2f(S1[r]); sacc += S0[r] + S1[r]; } \
          LS += sacc; } \
        _Pragma("unroll") for (int i = 0; i < 4; ++i) { PW[0][i] = cvtpk(S0[2 * i], S0[2 * i + 1]); PW[1][i] = cvtpk(S0[8 + 2 * i], S0[8 + 2 * i + 1]); \
                                                       PW[2][i] = cvtpk(S1[2 * i], S1[2 * i + 1]); PW[3][i] = cvtpk(S1[8 + 2 * i], S1[8 + 2 * i + 1]); } } while (0)
#define DF_VLOAD(vs_off, G0) do { const LAS unsigned char* vb_ = vfb + (vs_off); \
        _Pragma("unroll") for (int i = 0; i < 4; ++i) { vlo_[i] = vtr(vb_ + ((G0) + i) * 1024); vhi_[i] = vtr(vb_ + ((G0) + i) * 1024 + 512); } } while (0)
#define DF_PV(O0, O1, PW, vs_off) do { \
        DF_VLOAD(vs_off, 0); \
        _Pragma("unroll") for (int ks = 0; ks < 4; ++ks) { const bf16x8 vf = (bf16x8){vlo_[ks][0], vlo_[ks][1], vlo_[ks][2], vlo_[ks][3], vhi_[ks][0], vhi_[ks][1], vhi_[ks][2], vhi_[ks][3]}; \
            O0 = __builtin_amdgcn_mfma_f32_32x32x16_bf16(__builtin_bit_cast(bf16x8, PW[ks]), vf, O0, 0, 0, 0); } \
        DF_VLOAD(vs_off, 4); \
        _Pragma("unroll") for (int ks = 0; ks < 4; ++ks) { const bf16x8 vf = (bf16x8){vlo_[ks][0], vlo_[ks][1], vlo_[ks][2], vlo_[ks][3], vhi_[ks][0], vhi_[ks][1], vhi_[ks][2], vhi_[ks][3]}; \
            O1 = __builtin_amdgcn_mfma_f32_32x32x16_bf16(__builtin_bit_cast(bf16x8, PW[ks]), vf, O1, 0, 0, 0); } } while (0)
#define DF_STEP(COND, t) do { \
        if (!(COND) || (t) + 2 < NT) { kr = *(const u32x4*)kp; kp += tstep; } \
        if (!(COND) || (t) + 1 < NT) { vr = *(const u32x4*)vp; vp += tstep; } \
        if (!(COND) || (t) < NTw) { s16x4 vlo_[4], vhi_[4]; u32x4 pw[4]; \
            DF_QK(sB0, sB1, kfB, DF_KS(t), qB, mB); \
            DF_SOFTMAX(sA0, sA1, oA0, oA1, mA, lA, btA, 0, t, pw); \
            DF_PV(oA0, oA1, pw, DF_VS(t)); \
            DF_SOFTMAX(sB0, sB1, oB0, oB1, mB, lB, btB, 32, t, pw); \
            if (!(COND) || (t) + 1 < NTw) DF_QK(sA0, sA1, kfA, DF_KS((t) + 1), qA, mA); \
            DF_PV(oB0, oB1, pw, DF_VS(t)); } \
        if (!(COND) || (t) + 2 < NT) *(LAS u32x4*)(lds + L_K0 + DF_KS((t) + 2) + kl0) = kr; \
        if (!(COND) || (t) + 1 < NT) *(LAS u32x4*)(lds + L_V0 + DF_VS((t) + 1) + vl0) = vr; \
        __syncthreads(); } while (0)
#pragma unroll 1
    for (;;) {
        mA = 0.f; mB = 0.f; lA = 0.f; lB = 0.f; oA0 = f32x16{}; oA1 = f32x16{}; oB0 = f32x16{}; oB1 = f32x16{};
        const bf16_t* kp = kg0; const bf16_t* vp = vg0;
        u32x4 kr, vr;
        {
            const u32x4 ka = *(const u32x4*)kp; kp += tstep; const u32x4 va = *(const u32x4*)vp; vp += tstep; const u32x4 kb = *(const u32x4*)kp; kp += tstep;
            __syncthreads();
            *(LAS u32x4*)(lds + L_K0 + kl0) = ka; *(LAS u32x4*)(lds + L_V0 + vl0) = va; *(LAS u32x4*)(lds + L_K0 + KBUF + kl0) = kb;
            if (fast && tid == 0) *(volatile LAS unsigned*)(lds + L_FLAG) = 0u;
        }
        __syncthreads();
        f32x16 sA0, sA1, sB0, sB1;
        DF_QK(sA0, sA1, kfA, 0, qA, mA);
#pragma unroll
        for (int r = 0; r < 16; ++r) { sB0[r] = 0.f; sB1[r] = 0.f; }
        int t = 0;
        _Pragma("unroll 1") for (; t < TM; ++t) { DF_STEP(false, t); }
        _Pragma("unroll 1") for (; t < NT; ++t) { DF_STEP(true, t); }
        {
            const float ltA = xhalf_sum(lA), ltB = xhalf_sum(lB);
            if (fast) { if (!(ltA >= 0x1p-90f && ltA <= 0x1p90f && ltB >= 0x1p-90f && ltB <= 0x1p90f)) *(volatile LAS unsigned*)(lds + L_FLAG) = 1u; }
            if (hi == 0) { wsf[r32] = __builtin_amdgcn_rcpf(ltA); wsf[32 + r32] = __builtin_amdgcn_rcpf(ltB); }
#pragma unroll
            for (int r = 0; r < 16; ++r) { const float ia = wsf[crow(r, hi)], ib = wsf[32 + crow(r, hi)]; oA0[r] *= ia; oA1[r] *= ia; oB0[r] *= ib; oB1[r] *= ib; }
            asm volatile("" ::: "memory");
        }
        if (!fast) break;
        __syncthreads();
        if (__builtin_amdgcn_readfirstlane(*(volatile LAS unsigned*)(lds + L_FLAG)) == 0u) break;
        fast = 0;
    }
#undef DF_STEP
#undef DF_PV
#undef DF_VLOAD
#undef DF_SOFTMAX
#undef DF_QK
#undef DF_KS
#undef DF_VS
    bf16_t* Y = (bf16_t*)(ws + WS_Y);
    float gs0[16], gs1[16];
    {
        bf16_t gr0[16], gr1[16];
#pragma unroll
        for (int r = 0; r < 16; ++r) { const bf16_t* gp = P + (row0 + qw + crow(r, hi)) * PC + CB_G + h * 64; gr0[r] = gp[r32]; gr1[r] = gp[32 + r32]; }
#pragma unroll
        for (int r = 0; r < 16; ++r) { const float a0 = bf2f(gr0[r]), a1 = bf2f(gr1[r]);
            gs0[r] = a0 * __builtin_amdgcn_rcpf(1.f + __expf(-a0)); gs1[r] = a1 * __builtin_amdgcn_rcpf(1.f + __expf(-a1)); }
    }
    {
        const float* lamp = A->dlam + layer * 128;
        float s1 = 0.f, s2 = 0.f;
        for (int i = 0; i < 32; ++i) { s1 += lamp[i] * lamp[32 + i]; s2 += lamp[64 + i] * lamp[96 + i]; }
        const float lambda_init = A->lambda_init[layer];
        const float lam = __expf(s1) - __expf(s2) + lambda_init;
        const float g0 = A->subg[layer * 64 + r32], g1 = A->subg[layer * 64 + 32 + r32];
#pragma unroll
        for (int r = 0; r < 16; ++r) {
            const float v0 = oA0[r] - lam * oB0[r];
            const float v1 = oA1[r] - lam * oB1[r];
            float ss = v0 * v0 + v1 * v1;
#pragma unroll
            for (int off = 1; off < 32; off <<= 1) ss += __shfl_xor(ss, off);
            const float rr = rsqrtf(ss * (1.f / 64.f) + EPS) * (1.f - lambda_init);
            bf16_t* yp = Y + (row0 + qw + crow(r, hi)) * D + 256 + h * 64;
            yp[r32] = f2bf(v0 * rr * g0 * gs0[r]);
            yp[32 + r32] = f2bf(v1 * rr * g1 * gs1[r]);
        }
    }
}
}

namespace sel {
__device__ __forceinline__ float relu_s(float x) { const int i = __builtin_bit_cast(int, x); return __builtin_bit_cast(float, i > 0 ? i : 0); }
}

namespace sel2 {
typedef float f32x16 __attribute__((ext_vector_type(16)));
typedef short s16x2 __attribute__((ext_vector_type(2)));
typedef unsigned short u16x2 __attribute__((ext_vector_type(2)));
__device__ __forceinline__ unsigned pk_lt(unsigned v, unsigned c) {
    const s16x2 d = __builtin_elementwise_sub_sat(__builtin_bit_cast(s16x2, v), __builtin_bit_cast(s16x2, c));
    return __builtin_bit_cast(unsigned, __builtin_bit_cast(u16x2, d) >> 15);
}
__device__ __forceinline__ unsigned pk_add(unsigned a, unsigned b) { return __builtin_bit_cast(unsigned, __builtin_bit_cast(u16x2, a) + __builtin_bit_cast(u16x2, b)); }
__device__ __forceinline__ unsigned half_sum(unsigned x) {
    x = pk_add(x, (unsigned)__builtin_amdgcn_update_dpp(0, (int)x, 0xB1, 0xf, 0xf, false));
    x = pk_add(x, (unsigned)__builtin_amdgcn_update_dpp(0, (int)x, 0x4E, 0xf, 0xf, false));
    x = pk_add(x, (unsigned)__builtin_amdgcn_update_dpp(0, (int)x, 0x141, 0xf, 0xf, false));
    x = pk_add(x, (unsigned)__builtin_amdgcn_update_dpp(0, (int)x, 0x140, 0xf, 0xf, false));
    x = pk_add(x, (unsigned)__builtin_amdgcn_ds_swizzle((int)x, 0x401F));
    return x;
}
__device__ __forceinline__ void select_unit(LAS unsigned char* lds, int b, int c, int half) {
    ArgsP A = get_args();
    unsigned char* ws = A->ws;
    const bf16_t* P = (const bf16_t*)(ws + WS_P);
    unsigned* MASK = (unsigned*)(ws + WS_MASK);
    const int tid = opaque_tid(), lane = tid & 63, r32 = lane & 31, hi = lane >> 5; const int wid = __builtin_amdgcn_readfirstlane(tid >> 6);
    const int ni = c + 1, nb = 2 * ni;
    const size_t tq0 = (size_t)b * S + 64 * c + 32 * half + 4 * wid;
    if (c <= 3) {
        for (int e = lane; e < 4 * nb; e += 64) MASK[(tq0 + e / nb) * 128 + e % nb] = 0xffffffffu;
        return;
    }
    int nkeys_v = 64 * ni; asm volatile("" : "+v"(nkeys_v));
    unsigned vals[64];
    LAS unsigned* ldsv = (LAS unsigned*)lds + wid * 4096 + lane;
#define SVAL(blk) (((blk) < 64) ? vals[(blk) & 63] : ldsv[(((blk) - 64) & 63) * 64])
    {
        const int ql = 2 * ((r32 >> 2) & 1) + (r32 >> 4), hh = ((r32 >> 3) & 1) * 4 + (r32 & 3);
        const bf16x8 af0 = *(const bf16x8*)(P + (tq0 + ql) * PC + CC_QI + hh * 32 + 8 * hi), af1 = *(const bf16x8*)(P + (tq0 + ql) * PC + CC_QI + hh * 32 + 16 + 8 * hi);
        const float idx_scale = 0.35355339059327373f * 0.17677669529663687f * 0.125f;
        float wv[16];
#pragma unroll
        for (int qh = 0; qh < 2; ++qh) { const u16x8 w8 = *(const u16x8*)(P + (tq0 + 2 * hi + qh) * PC + CC_WI);
#pragma unroll
            for (int e = 0; e < 8; ++e) wv[8 * qh + e] = bf2f(w8[e]) * idx_scale; }
        const bf16_t* kgl = P + ((size_t)b * S) * PC + CC_KI;
        LAS unsigned char* kch = lds + 131072;
        const int sk0 = tid >> 2, sq = tid & 3;
        const bf16_t* sg = kgl + (size_t)sk0 * PC + sq * 8;
        const int sl0 = sk0 * 64 + ((sq ^ ((sk0 >> 2) & 3)) * 16), sl1 = sl0 + 128 * 64;
        const int sw = (r32 >> 2) & 3;
        const LAS unsigned char* rd0 = kch + r32 * 64 + ((hi ^ sw) * 16);
        const LAS unsigned char* rd1 = kch + r32 * 64 + (((2 + hi) ^ sw) * 16);
        bf16x8 afc[2][2] = {{af0, af1}, {af0, af1}};
        u32x4 st0 = *(const u32x4*)sg, st1 = *(const u32x4*)(sg + (size_t)128 * PC);
        const int ngc = 2 * ((nb + 15) >> 4);
#define SEL_BAR() do { asm volatile("s_waitcnt lgkmcnt(0)" ::: "memory"); __builtin_amdgcn_s_barrier(); asm volatile("" ::: "memory"); } while (0)
#pragma unroll
        for (int g = 0; g < 16; ++g) if (g < ngc) {
            SEL_BAR();
            *(LAS u32x4*)(kch + sl0) = st0; *(LAS u32x4*)(kch + sl1) = st1;
            SEL_BAR();
            if (g + 1 < ngc) { st0 = *(const u32x4*)(sg + (size_t)(256 * (g + 1)) * PC); st1 = *(const u32x4*)(sg + (size_t)(256 * (g + 1) + 128) * PC); }
            bf16x8 pb[2][2];
            pb[0][0] = *(const LAS bf16x8*)rd0; pb[0][1] = *(const LAS bf16x8*)rd1;
#pragma unroll
            for (int jb = 0; jb < 8; ++jb) { const int blk = 8 * g + jb;
                if (jb + 1 < 8) { pb[(jb + 1) & 1][0] = *(const LAS bf16x8*)(rd0 + (jb + 1) * 2048); pb[(jb + 1) & 1][1] = *(const LAS bf16x8*)(rd1 + (jb + 1) * 2048); }
                f32x16 acc = f32x16{};
                acc = __builtin_amdgcn_mfma_f32_32x32x16_bf16(afc[blk & 1][0], pb[jb & 1][0], acc, 0, 0, 0);
                acc = __builtin_amdgcn_mfma_f32_32x32x16_bf16(afc[blk & 1][1], pb[jb & 1][1], acc, 0, 0, 0);
                float pr_[16];
#pragma unroll
                for (int r = 0; r < 16; ++r) pr_[r] = sel::relu_s(acc[r]);
                const float v0 = ((wv[0] * pr_[0] + wv[1] * pr_[1]) + (wv[2] * pr_[2] + wv[3] * pr_[3])) + ((wv[4] * pr_[4] + wv[5] * pr_[5]) + (wv[6] * pr_[6] + wv[7] * pr_[7]));
                const float v1 = ((wv[8] * pr_[8] + wv[9] * pr_[9]) + (wv[10] * pr_[10] + wv[11] * pr_[11])) + ((wv[12] * pr_[12] + wv[13] * pr_[13]) + (wv[14] * pr_[14] + wv[15] * pr_[15]));
                unsigned sv_ = __builtin_bit_cast(unsigned, __builtin_amdgcn_cvt_pknorm_i16(v0, v1));
                sv_ = (32 * blk + r32 < nkeys_v) ? sv_ : 0x80008000u;
                asm volatile("" : "+v"(afc[blk & 1][0]) : "v"(sv_));
                if (blk < 64) vals[blk & 63] = sv_; else ldsv[((blk - 64) & 63) * 64] = sv_;
            }
        }
        SEL_BAR();
#undef SEL_BAR
    }
    const int ng16 = (nb + 15) >> 4;
    const unsigned total = (unsigned)ng16 * 512u;
#define SEL2_COUNT_LT(res, c2) do { unsigned a0_ = 0u, a1_ = 0u, a2_ = 0u, a3_ = 0u; \
        _Pragma("unroll") for (int g = 0; g < 8; ++g) if (g < ng16) { \
            unsigned sv_[16]; _Pragma("unroll") for (int j = 0; j < 16; ++j) sv_[j] = SVAL(16 * g + j); \
            __builtin_amdgcn_sched_barrier(0); \
            s16x2 dd_[16]; _Pragma("unroll") for (int j = 0; j < 16; ++j) dd_[j] = __builtin_elementwise_sub_sat(__builtin_bit_cast(s16x2, sv_[j]), __builtin_bit_cast(s16x2, (unsigned)(c2))); \
            __builtin_amdgcn_sched_barrier(0); \
            u16x2 ss_[16]; _Pragma("unroll") for (int j = 0; j < 16; ++j) ss_[j] = __builtin_bit_cast(u16x2, dd_[j]) >> 15; \
            __builtin_amdgcn_sched_barrier(0); \
            _Pragma("unroll") for (int j = 0; j < 8; ++j) ss_[j] += ss_[j + 8]; \
            __builtin_amdgcn_sched_barrier(0); \
            _Pragma("unroll") for (int j = 0; j < 4; ++j) ss_[j] += ss_[j + 4]; \
            __builtin_amdgcn_sched_barrier(0); \
            a0_ = pk_add(a0_, __builtin_bit_cast(unsigned, ss_[0])); a1_ = pk_add(a1_, __builtin_bit_cast(unsigned, ss_[1])); a2_ = pk_add(a2_, __builtin_bit_cast(unsigned, ss_[2])); a3_ = pk_add(a3_, __builtin_bit_cast(unsigned, ss_[3])); \
            __builtin_amdgcn_sched_barrier(0); } \
        res = half_sum(pk_add(pk_add(a0_, a1_), pk_add(a2_, a3_))); } while (0)
    unsigned Tu2 = 0u;
    unsigned cge_lo = total, cge_hi = total;
#pragma unroll 1
    for (int bit = 15; bit >= 0; --bit) {
        const unsigned cand2 = Tu2 | ((1u << bit) * 0x10001u);
        unsigned clt; SEL2_COUNT_LT(clt, cand2 ^ 0x80008000u);
        const unsigned g_lo = total - (clt & 0xffffu), g_hi = total - (clt >> 16);
        if (g_lo >= 256u) { Tu2 = (Tu2 & 0xffff0000u) | (cand2 & 0x0000ffffu); cge_lo = g_lo; }
        if (g_hi >= 256u) { Tu2 = (Tu2 & 0x0000ffffu) | (cand2 & 0xffff0000u); cge_hi = g_hi; }
        if (__all((cge_lo == 256u) && (cge_hi == 256u))) break;
    }
    const unsigned Ts2 = Tu2 ^ 0x80008000u;
    const bool anytie = __any((cge_lo != 256u) || (cge_hi != 256u));
    LAS unsigned* m0 = (LAS unsigned*)(lds + 131072) + wid * 512; LAS unsigned* m1 = m0 + 128; LAS unsigned* m2 = m0 + 256; LAS unsigned* m3 = m0 + 384;
    if (!anytie) {
#pragma unroll
        for (int g = 0; g < 8; ++g) if (g < ng16)
#pragma unroll
        for (int jb = 0; jb < 16; ++jb) { const int blk = 16 * g + jb;
            const unsigned d = __builtin_bit_cast(unsigned, __builtin_elementwise_sub_sat(__builtin_bit_cast(s16x2, SVAL(blk)), __builtin_bit_cast(s16x2, Ts2)));
            const unsigned long long bl = __ballot((d & 0x8000u) == 0u), bh = __ballot((int)d >= 0);
            if (lane == 0) { m0[blk] = (unsigned)bl; m2[blk] = (unsigned)(bl >> 32); m1[blk] = (unsigned)bh; m3[blk] = (unsigned)(bh >> 32); }
        }
    } else {
        const s16x2 tp1 = __builtin_elementwise_add_sat(__builtin_bit_cast(s16x2, Ts2), (s16x2){1, 1});
        unsigned clt_u; SEL2_COUNT_LT(clt_u, __builtin_bit_cast(unsigned, tp1));
        const int cgt_lo = ((Ts2 & 0xffffu) == 0x7fffu) ? 0 : (int)(total - (clt_u & 0xffffu)), cgt_hi = ((Ts2 >> 16) == 0x7fffu) ? 0 : (int)(total - (clt_u >> 16));
        const int need_lo = 256 - cgt_lo, need_hi = 256 - cgt_hi;
        int taken_lo = 0, taken_hi = 0;
#pragma unroll
        for (int g = 0; g < 8; ++g) if (g < ng16)
#pragma unroll
        for (int jb = 0; jb < 16; ++jb) { const int blk = 16 * g + jb;
            const unsigned d = __builtin_bit_cast(unsigned, __builtin_elementwise_sub_sat(__builtin_bit_cast(s16x2, SVAL(blk)), __builtin_bit_cast(s16x2, Ts2)));
            const bool eq_lo = ((d & 0xffffu) == 0u), eq_hi = ((d >> 16) == 0u);
            const bool gt_lo = !eq_lo && ((d & 0x8000u) == 0u), gt_hi = !eq_hi && ((int)d >= 0);
            const unsigned long long el = __ballot(eq_lo), eh = __ballot(eq_hi);
            const int cl0 = __popc((unsigned)el), cl1 = __popc((unsigned)(el >> 32)), ch0 = __popc((unsigned)eh), ch1 = __popc((unsigned)(eh >> 32));
            const int pre_lo = (int)__builtin_amdgcn_mbcnt_hi((unsigned)(el >> 32), __builtin_amdgcn_mbcnt_lo((unsigned)el, 0u)) - (hi ? cl0 : 0);
            const int pre_hi = (int)__builtin_amdgcn_mbcnt_hi((unsigned)(eh >> 32), __builtin_amdgcn_mbcnt_lo((unsigned)eh, 0u)) - (hi ? ch0 : 0);
            const bool s_lo = gt_lo || (eq_lo && (taken_lo + pre_lo) < need_lo), s_hi = gt_hi || (eq_hi && (taken_hi + pre_hi) < need_hi);
            taken_lo += hi ? cl1 : cl0; taken_hi += hi ? ch1 : ch0;
            const unsigned long long bl = __ballot(s_lo), bh = __ballot(s_hi);
            if (lane == 0) { m0[blk] = (unsigned)bl; m2[blk] = (unsigned)(bl >> 32); m1[blk] = (unsigned)bh; m3[blk] = (unsigned)(bh >> 32); }
        }
    }
    asm volatile("s_waitcnt lgkmcnt(0)" ::: "memory");
#pragma unroll
    for (int q = 0; q < 4; ++q)
#pragma unroll
        for (int hf = 0; hf < 2; ++hf) { const int bw = lane + 64 * hf; if (bw < nb) MASK[(tq0 + q) * 128 + bw] = m0[q * 128 + bw]; }
#undef SEL2_COUNT_LT
#undef SVAL
}
}

namespace mp {
constexpr int AQ_STRIDE = 528, AKV_STRIDE = 272, L_AQ = 0, L_AKV = 128 * AQ_STRIDE;
constexpr int L_RK = L_AKV + 128 * AKV_STRIDE;
constexpr int ST_STRIDE = 208, L_ST = L_RK + 128 * 64;
__device__ __forceinline__ void stage4(LAS unsigned char* p, const f32x4 v) { u32x2 w; w.x = pg8::cvt_pk_bf16(v[0], v[1]); w.y = pg8::cvt_pk_bf16(v[2], v[3]); *(LAS u32x2*)p = w; }
__device__ __forceinline__ void store4(bf16_t* p, const f32x4 v) { uint2 w; w.x = pg8::cvt_pk_bf16(v[0], v[1]); w.y = pg8::cvt_pk_bf16(v[2], v[3]); *(uint2*)p = w; }
template <int CTRL> __device__ __forceinline__ float dppf(float v) { return __builtin_bit_cast(float, __builtin_amdgcn_update_dpp(0, __builtin_bit_cast(int, v), CTRL, 0xf, 0xf, false)); }
__device__ __forceinline__ float wave_sum64(float v) {
    v += dppf<0xB1>(v); v += dppf<0x4E>(v); v += dppf<0x141>(v); v += dppf<0x140>(v);
    v += __builtin_bit_cast(float, __builtin_amdgcn_ds_swizzle(__builtin_bit_cast(int, v), 0x401F));
    return fa::xhalf_sum(v);
}
__device__ __forceinline__ void mla_prep_unit(LAS unsigned char* lds, int tile, int l) {
    ArgsP A = get_args();
    unsigned char* ws = A->ws;
    const bf16_t* P = (const bf16_t*)(ws + WS_P);
    const float* ROPE = (const float*)(ws + WS_ROPE);
    bf16_t* QA = (bf16_t*)(ws + WS_QA); bf16_t* KA = (bf16_t*)(ws + WS_KA); bf16_t* VA = (bf16_t*)(ws + WS_VA);
    const int tid = opaque_tid(), lane = tid & 63, fr = lane & 15, fq = lane >> 4, wid = __builtin_amdgcn_readfirstlane(tid >> 6);
    const size_t t0 = (size_t)tile * 128;
    const int h = wid >> 1, half = wid & 1;
    bf16x8 wq[8][3];
    {
        const bf16_t* W = (const bf16_t*)(ws + WS_WTUQ) + (size_t)l * 384 * 256 + (size_t)(48 * wid + fr) * 256 + 8 * fq;
#pragma unroll
        for (int ks = 0; ks < 8; ++ks)
#pragma unroll
            for (int nf = 0; nf < 3; ++nf) wq[ks][nf] = *(const bf16x8*)(W + (size_t)(16 * nf) * 256 + 32 * ks);
    }
    __syncthreads();
    {
        const float* qg = A->qa_g + l * 256; const float* kg = A->kva_g + l * 128;
        float gq[4], gk[4];
#pragma unroll
        for (int j = 0; j < 4; ++j) { gq[j] = qg[4 * lane + j]; gk[j] = kg[(4 * lane + j) & 127]; }
#pragma unroll 1
        for (int bt = 0; bt < 4; ++bt) {
            uint2 cq[4], ck[4]; bf16_t kr1[4], kr2[4]; float rcs[4], rsn[4];
#pragma unroll
            for (int i = 0; i < 4; ++i) {
                const int row = 16 * wid + 4 * bt + i; const size_t t = t0 + row;
                const bf16_t* p = P + t * PC;
                cq[i] = *(const uint2*)(p + CA_CQ + 4 * lane);
                ck[i] = *(const uint2*)(p + CA_CKV + 4 * (lane & 31));
                if (lane < 16) { const int pos = (int)(t % S); kr1[i] = p[CA_KR + lane]; kr2[i] = p[CA_KR + 16 + lane]; rcs[i] = ROPE[pos * 16 + lane]; rsn[i] = ROPE[S * 16 + pos * 16 + lane]; }
            }
#pragma unroll
            for (int i = 0; i < 4; ++i) {
                const int row = 16 * wid + 4 * bt + i; const size_t t = t0 + row;
                float a[4] = {bf2f((bf16_t)(cq[i].x & 0xffff)), bf2f((bf16_t)(cq[i].x >> 16)), bf2f((bf16_t)(cq[i].y & 0xffff)), bf2f((bf16_t)(cq[i].y >> 16))};
                float c[4] = {bf2f((bf16_t)(ck[i].x & 0xffff)), bf2f((bf16_t)(ck[i].x >> 16)), bf2f((bf16_t)(ck[i].y & 0xffff)), bf2f((bf16_t)(ck[i].y >> 16))};
                float sa = a[0] * a[0] + a[1] * a[1] + a[2] * a[2] + a[3] * a[3];
                float sb = (lane < 32) ? (c[0] * c[0] + c[1] * c[1] + c[2] * c[2] + c[3] * c[3]) : 0.f;
                sa = wave_sum64(sa); sb = wave_sum64(sb);
                const float ra = rsqrtf(sa * (1.f / 256.f) + EPS), rb = rsqrtf(sb * (1.f / 128.f) + EPS);
                u32x2 w; w.x = pg8::cvt_pk_bf16(a[0] * ra * gq[0], a[1] * ra * gq[1]); w.y = pg8::cvt_pk_bf16(a[2] * ra * gq[2], a[3] * ra * gq[3]);
                *(LAS u32x2*)(lds + L_AQ + row * AQ_STRIDE + 8 * lane) = w;
                if (lane < 32) { u32x2 v; v.x = pg8::cvt_pk_bf16(c[0] * rb * gk[0], c[1] * rb * gk[1]); v.y = pg8::cvt_pk_bf16(c[2] * rb * gk[2], c[3] * rb * gk[3]);
                    *(LAS u32x2*)(lds + L_AKV + row * AKV_STRIDE + 8 * lane) = v; }
                if (lane < 16) {
                    const float k1 = bf2f(kr1[i]), k2 = bf2f(kr2[i]);
                    const bf16_t o1 = f2bf(k1 * rcs[i] - k2 * rsn[i]), o2 = f2bf(k2 * rcs[i] + k1 * rsn[i]);
                    LAS bf16_t* rk = (LAS bf16_t*)(lds + L_RK + row * 64); rk[lane] = o1; rk[16 + lane] = o2;
                }
            }
        }
    }
    __syncthreads();
    f32x4 acc[8][3];
#pragma unroll
    for (int mi = 0; mi < 8; ++mi)
#pragma unroll
        for (int nf = 0; nf < 3; ++nf) acc[mi][nf] = (f32x4){0.f, 0.f, 0.f, 0.f};
#pragma unroll
    for (int ks = 0; ks < 8; ++ks) {
#pragma unroll
        for (int mi = 0; mi < 8; ++mi) {
            const bf16x8 xf = *(const LAS bf16x8*)(lds + L_AQ + (16 * mi + fr) * AQ_STRIDE + 64 * ks + 16 * fq);
#pragma unroll
            for (int nf = 0; nf < 3; ++nf) acc[mi][nf] = __builtin_amdgcn_mfma_f32_16x16x32_bf16(wq[ks][nf], xf, acc[mi][nf], 0, 0, 0);
        }
    }
    __builtin_amdgcn_sched_barrier(0);
    bf16x8 wkv[4][4];
    {
        const bf16_t* W = (const bf16_t*)(ws + WS_WTUKV) + (size_t)l * 512 * 128 + (size_t)(64 * wid + fr) * 128 + 8 * fq;
#pragma unroll
        for (int ks = 0; ks < 4; ++ks)
#pragma unroll
            for (int nf = 0; nf < 4; ++nf) wkv[ks][nf] = *(const bf16x8*)(W + (size_t)(16 * nf) * 128 + 32 * ks);
    }
    LAS unsigned char* stg = lds + L_ST + wid * (16 * ST_STRIDE);
#pragma unroll
    for (int mb = 0; mb < 2; ++mb) {
        f32x4 cs[4], sn[4];
        if (half == 1) {
#pragma unroll
            for (int i = 0; i < 4; ++i) { const int pos = (int)((t0 + 16 * (4 * mb + i) + fr) % S);
                cs[i] = *(const f32x4*)(ROPE + pos * 16 + 4 * fq); sn[i] = *(const f32x4*)(ROPE + S * 16 + pos * 16 + 4 * fq); }
        }
#pragma unroll
        for (int i = 0; i < 4; ++i) { const int mi = 4 * mb + i;
            LAS unsigned char* sp = stg + fr * ST_STRIDE + 8 * fq;
            if (half == 0) { stage4(sp, acc[mi][0]); stage4(sp + 32, acc[mi][1]); stage4(sp + 64, acc[mi][2]); }
            else { const f32x4 x1 = acc[mi][1], x2 = acc[mi][2];
                stage4(sp, acc[mi][0]); stage4(sp + 32, x1 * cs[i] - x2 * sn[i]); stage4(sp + 64, x2 * cs[i] + x1 * sn[i]); }
            asm volatile("" ::: "memory");
#pragma unroll
            for (int j = 0; j < 2; ++j) { const int pc = lane + 64 * j; const int row = pc / 6, c = pc % 6;
                if (pc < 96) { const u32x4 v = *(const LAS u32x4*)(stg + row * ST_STRIDE + c * 16);
                    *(u32x4*)(QA + (t0 + 16 * mi + row) * 384 + h * 96 + 48 * half + c * 8) = v; } }
            asm volatile("" ::: "memory");
        }
    }
    {
        f32x4 ac2[8][4];
#pragma unroll
        for (int mi = 0; mi < 8; ++mi)
#pragma unroll
            for (int nf = 0; nf < 4; ++nf) ac2[mi][nf] = (f32x4){0.f, 0.f, 0.f, 0.f};
#pragma unroll
        for (int ks = 0; ks < 4; ++ks) {
#pragma unroll
            for (int mi = 0; mi < 8; ++mi) {
                const bf16x8 xf = *(const LAS bf16x8*)(lds + L_AKV + (16 * mi + fr) * AKV_STRIDE + 64 * ks + 16 * fq);
#pragma unroll
                for (int nf = 0; nf < 4; ++nf) ac2[mi][nf] = __builtin_amdgcn_mfma_f32_16x16x32_bf16(wkv[ks][nf], xf, ac2[mi][nf], 0, 0, 0);
            }
        }
#pragma unroll
        for (int mi = 0; mi < 8; ++mi) {
            LAS unsigned char* sp = stg + fr * ST_STRIDE + 8 * fq;
#pragma unroll
            for (int nf = 0; nf < 4; ++nf) stage4(sp + 32 * nf, ac2[mi][nf]);
            asm volatile("" ::: "memory");
            if (half == 0) {
#pragma unroll
                for (int j = 0; j < 3; ++j) { const int pc = lane + 64 * j; const int row = pc / 12, c = pc % 12;
                    const u32x4 v = (c < 8) ? *(const LAS u32x4*)(stg + row * ST_STRIDE + c * 16) : *(const LAS u32x4*)(lds + L_RK + (16 * mi + row) * 64 + (c - 8) * 16);
                    *(u32x4*)(KA + (t0 + 16 * mi + row) * 384 + h * 96 + c * 8) = v; }
            } else {
#pragma unroll
                for (int j = 0; j < 2; ++j) { const int pc = lane + 64 * j; const int row = pc >> 3, c = pc & 7;
                    const u32x4 v = *(const LAS u32x4*)(stg + row * ST_STRIDE + c * 16);
                    *(u32x4*)(VA + (t0 + 16 * mi + row) * 256 + h * 64 + c * 8) = v; }
            }
            asm volatile("" ::: "memory");
        }
    }
}
}

__device__ __forceinline__ void conv_tokens(int t, int cg, const bf16_t* P, const float* cw, bf16_t* Y) {
    const int pos = t % S, ch = cg * 8;
    const bf16_t* p = P + (size_t)t * PC;
    const u16x8 zero = (u16x8){0, 0, 0, 0, 0, 0, 0, 0};
    const u16x8 c2 = *(const u16x8*)(p + CD_C + ch), h2 = *(const u16x8*)(p + CD_H + ch);
    const u16x8 c1 = (pos >= 1) ? *(const u16x8*)(p - PC + CD_C + ch) : zero, h1 = (pos >= 1) ? *(const u16x8*)(p - PC + CD_H + ch) : zero;
    const u16x8 c0 = (pos >= 2) ? *(const u16x8*)(p - 2 * PC + CD_C + ch) : zero, h0 = (pos >= 2) ? *(const u16x8*)(p - 2 * PC + CD_H + ch) : zero;
    const u16x8 bb = *(const u16x8*)(p + CD_B + ch), gg = *(const u16x8*)(p + CD_G + ch);
    u16x8 out;
#pragma unroll
    for (int e = 0; e < 8; ++e) {
        const float y = cw[ch + e] * (bf2f(c0[e]) * bf2f(h0[e])) + cw[256 + ch + e] * (bf2f(c1[e]) * bf2f(h1[e])) + cw[512 + ch + e] * (bf2f(c2[e]) * bf2f(h2[e]));
        const float g = bf2f(gg[e]);
        out[e] = f2bf(bf2f(bb[e]) * y * (g * __builtin_amdgcn_rcpf(1.f + __expf(-g))));
    }
    *(u16x8*)(Y + (size_t)t * D + 768 + ch) = out;
}

#define PH_PRE const int tid = opaque_tid(), lane = tid & 63, wave = __builtin_amdgcn_readfirstlane(tid >> 6); const int G = opaque_grid(), bid = opaque_bid(); \
    ArgsP A = get_args(); unsigned char* ws = A->ws; (void)lane; (void)wave; (void)G; (void)bid; (void)ws;
__device__ __forceinline__ void ph_prologue(LAS unsigned char* lds) {
    PH_PRE
    const long gtid = (long)bid * NTHR + tid, gthreads = (long)G * NTHR;
    {
        LAS float* scr = (LAS float*)lds;
        constexpr int T_IN = 16 * 64, T_OUT = 16 * 16, T_UQ = 4 * 6, T_UKV = 2 * 8, T_L = T_IN + T_OUT + T_UQ + T_UKV;
        for (int it = bid; it < NL * T_L; it += G) {
            const int l = it / T_L; int r = it % T_L;
            if (r < T_IN) { convert_tile(scr, A->w_in + (size_t)l * 1024 * INC, (bf16_t*)(ws + WS_WTIN) + (size_t)l * PC * 1024, 1024, INC, 1, 1.f, (r >> 6) * 64, (r & 63) * 64, tid); continue; } r -= T_IN;
            if (r < T_OUT) { convert_tile(scr, A->w_out + (size_t)l * 1024 * 1024, (bf16_t*)(ws + WS_WTOUT) + (size_t)l * 1024 * 1024, 1024, 1024, 0, 1.f, (r >> 4) * 64, (r & 15) * 64, tid); continue; } r -= T_OUT;
            if (r < T_UQ) { convert_tile(scr, A->w_uq + (size_t)l * 256 * 384, (bf16_t*)(ws + WS_WTUQ) + (size_t)l * 384 * 256, 256, 384, 0, QS_MLA, (r / 6) * 64, (r % 6) * 64, tid); continue; } r -= T_UQ;
            convert_tile(scr, A->w_ukv + (size_t)l * 128 * 512, (bf16_t*)(ws + WS_WTUKV) + (size_t)l * 512 * 128, 128, 512, 0, 1.f, (r >> 3) * 64, (r & 7) * 64, tid);
        }
        __syncthreads();
    }
    float* ROPE = (float*)(ws + WS_ROPE);
    for (long i = gtid; i < S * 16; i += gthreads) {
        const int s = (int)(i >> 4), f = (int)(i & 15);
        const float inv = powf(10000.0f, -(float)f / 16.0f);
        const float ang = (float)s * inv;
        float sn, c; sincosf(ang, &sn, &c);
        ROPE[i] = c; ROPE[S * 16 + i] = sn;
    }
}
__device__ __forceinline__ void ph_rms(int l) {
    PH_PRE
    bf16_t* HN = (bf16_t*)(ws + WS_HN);
    const int NGW = G * NWAVE;
    if (l == 0) { for (int r = bid * NWAVE + wave; r < T; r += 4 * NGW) rms_rows4<true>(A->x + (size_t)r * D, (size_t)NGW * D, A->norm_g + l * D, HN + (size_t)r * D, nullptr, lane); }
    else { const bf16_t* XR = (const bf16_t*)(ws + WS_XR);
        for (int r = bid * NWAVE + wave; r < T; r += 4 * NGW) rms_rows4b<true>(XR + (size_t)r * D, (size_t)NGW * D, A->norm_g + l * D, HN + (size_t)r * D, nullptr, lane); }
}
__device__ __forceinline__ void ph_gemm_in(LAS unsigned char* lds, int l) {
    PH_PRE
    pg8::Gemm g{(const bf16_t*)(ws + WS_HN), (const bf16_t*)(ws + WS_WTIN) + (size_t)l * PC * 1024, T, PC, 1024}; pg8::StaticOrder So; So.init(T, PC, G, bid);
    pg8::EpiBf16 E{(bf16_t*)(ws + WS_P), PC};
    pg8::gemm_phase<pg8::EpiBf16, pg8::StaticOrder, true, true>(lds, g, So, E);
}
__device__ __forceinline__ void ph_mid(LAS unsigned char* lds, int l) {
    const int G = opaque_grid(), bid = opaque_bid();
    for (int u = bid; u < T / 128; u += G) mp::mla_prep_unit(lds, u, l);
    __syncthreads();
    {
        const int vcu = (bid & 7) * (G >> 3) + (bid >> 3);
        const int b = vcu >> 5, j = vcu & 31;
        for (int m = 0; m < 4; ++m) { const int c = ((m & 1) ? (15 - (j >> 1)) : (j >> 1)) + 16 * m; sel2::select_unit(lds, b, c, j & 1); }
    }
}
__device__ __forceinline__ void ph_attn(LAS unsigned char* lds, int l) {
    const int G = opaque_grid(), bid = opaque_bid();
    {
        const int vcu = (bid & 7) * (G >> 3) + (bid >> 3);
        const int b = vcu >> 5, h = (vcu >> 3) & 3, s = vcu & 7;
        { ArgsP A = get_args(); fa::build_bias(lds, A->rel_bias); }
#define ATTN_UNIT(TY) do { _Pragma("unroll 1") for (int u_ = 0; u_ < 2; ++u_) { int b_ = b, h_ = h, q_ = u_ ? s : 15 - s, l_ = l; asm volatile("" : "+s"(b_), "+s"(h_), "+s"(q_), "+s"(l_)); \
            fa::attn_unit<TY>(lds, b_, h_, q_, l_); } } while (0)
        ATTN_UNIT(0);
        { _Pragma("unroll 1") for (int u_ = 0; u_ < 2; ++u_) { int b_ = b, h_ = h, q_ = u_ ? s : 15 - s, l_ = l; asm volatile("" : "+s"(b_), "+s"(h_), "+s"(q_), "+s"(l_)); fa::attn_unit_diff(lds, b_, h_, q_, l_); } }
        ATTN_UNIT(2);
#undef ATTN_UNIT
        __syncthreads();
    }
    {
        PH_PRE
        for (int t = bid * 16 + (tid >> 5); t < T; t += 16 * G) conv_tokens(t, tid & 31, (const bf16_t*)(ws + WS_P), A->conv_w + l * 768, (bf16_t*)(ws + WS_Y));
    }
}
__device__ __forceinline__ void ph_gemm_out(LAS unsigned char* lds, int l) {
    PH_PRE
    pg8::Gemm g{(const bf16_t*)(ws + WS_Y), (const bf16_t*)(ws + WS_WTOUT) + (size_t)l * 1024 * 1024, T, 1024, 1024}; pg8::StaticOrder So; So.init(T, 1024, G, bid);
    bf16_t* XR = (bf16_t*)(ws + WS_XR);
    if (l == 0) { pg8::EpiResBf16<false> E{A->x, XR, 1024}; pg8::gemm_phase<pg8::EpiResBf16<false>, pg8::StaticOrder, true, true>(lds, g, So, E); }
    else { pg8::EpiResBf16<true> E{XR, XR, 1024}; pg8::gemm_phase<pg8::EpiResBf16<true>, pg8::StaticOrder, true, true>(lds, g, So, E); }
}
__device__ __forceinline__ void ph_final() {
    PH_PRE
    const int NGW = G * NWAVE;
    const bf16_t* XR = (const bf16_t*)(ws + WS_XR);
    for (int r = bid * NWAVE + wave; r < T; r += 4 * NGW) rms_rows4b<false>(XR + (size_t)r * D, (size_t)NGW * D, A->final_g, nullptr, A->out + (size_t)r * D, lane);
}

#define GRID_SYNC() xcd_barrier(lds)
__global__ void __launch_bounds__(NTHR, 2) mk_fwd(Args Akernarg) {
    extern __shared__ __attribute__((aligned(16))) unsigned char lds_raw[];
    LAS unsigned char* lds = (LAS unsigned char*)lds_raw;
    xcd_barrier_post(lds);
    ph_prologue(lds);
    for (int l = 0; l < NL; ++l) {
        ph_rms(l);
        GRID_SYNC();
        ph_gemm_in(lds, l);
        GRID_SYNC();
        ph_mid(lds, l);
        GRID_SYNC();
        ph_attn(lds, l);
        GRID_SYNC();
        ph_gemm_out(lds, l);
        GRID_SYNC();
    }
    ph_final();
}

extern "C" void kernel_launch(void* const* d_in, const int* in_sizes, int n_in, void* d_out, int out_size, void* d_ws, size_t ws_size, hipStream_t stream) {
    static int grid = 0;
    if (grid == 0) {
        if (ws_size < WS_END) { fprintf(stderr, "kernel_launch: workspace too small (%zu < %zu)\n", ws_size, (size_t)WS_END); grid = -1; return; }
        int dev = 0, cus = 0, per_cu = 0;
        hipGetDevice(&dev);
        hipDeviceGetAttribute(&cus, hipDeviceAttributeMultiprocessorCount, dev);
        hipFuncSetAttribute((const void*)mk_fwd, hipFuncAttributeMaxDynamicSharedMemorySize, LDS_BYTES);
        hipOccupancyMaxActiveBlocksPerMultiprocessor(&per_cu, (const void*)mk_fwd, NTHR, LDS_BYTES);
        if (per_cu < 1) fprintf(stderr, "kernel_launch: note: the occupancy query reports %d workgroups per CU; 145 KiB of LDS per workgroup admits exactly one\n", per_cu);
        (void)hipGetLastError();
        if (cus != 256) { fprintf(stderr, "kernel_launch: built for a 256-CU device (one workgroup per CU, 32 per batch); found %d CUs; nothing launched\n", cus); grid = -1; return; }
        grid = cus;
    }
    if (grid < 0) return;
    Args a{};
    a.x = (const float*)d_in[0]; a.norm_g = (const float*)d_in[1]; a.w_in = (const float*)d_in[2]; a.qa_g = (const float*)d_in[3];
    a.w_uq = (const float*)d_in[4]; a.kva_g = (const float*)d_in[5]; a.w_ukv = (const float*)d_in[6]; a.dlam = (const float*)d_in[7];
    a.subg = (const float*)d_in[8]; a.conv_w = (const float*)d_in[9]; a.w_out = (const float*)d_in[10]; a.rel_bias = (const float*)d_in[11];
    a.final_g = (const float*)d_in[12];
    a.out = (float*)d_out; a.ws = (unsigned char*)d_ws;
    a.lambda_init[0] = 0.8f - 0.6f * expf(-0.3f * 0.f); a.lambda_init[1] = 0.8f - 0.6f * expf(-0.3f * 1.f);
    if (hipMemsetAsync(d_ws, 0, 65536, stream) != hipSuccess) { fprintf(stderr, "kernel_launch: memset of the barrier words failed\n"); return; }
    hipLaunchKernelGGL(mk_fwd, dim3(grid), dim3(NTHR), LDS_BYTES, stream, a);
    const hipError_t e = hipPeekAtLastError();
    if (e != hipSuccess) fprintf(stderr, "launch failed: %s (grid %d)\n", hipGetErrorString(e), grid);
}
```

```cpp
#include <hip/hip_runtime.h>
#include <hip/hip_bf16.h>
#include <cstdint>
#include <cstdio>

#define LAS __attribute__((address_space(3)))
typedef unsigned short bf16_t;
typedef short bf16x8 __attribute__((ext_vector_type(8)));
typedef unsigned short u16x8 __attribute__((ext_vector_type(8)));
typedef float f32x4 __attribute__((ext_vector_type(4)));
typedef unsigned u32x4 __attribute__((ext_vector_type(4)));
typedef unsigned u32x2 __attribute__((ext_vector_type(2)));

constexpr int NB = 8, S = 4096, T = NB * S, D = 1024, NL = 2;
constexpr int PC = 4096;
constexpr int INC = 4040;
constexpr int CA_CQ = 0, CA_CKV = 256, CA_KR = 384, CA_G = 448;
constexpr int CB_Q = 704, CB_K = 960, CB_V = 1216, CB_G = 1472;
constexpr int CC_Q = 1728, CC_K = 1984, CC_V = 2240, CC_QI = 2496, CC_KI = 2752, CC_WI = 2784, CC_G = 2816;
constexpr int CD_B = 3072, CD_C = 3328, CD_H = 3584, CD_G = 3840;
constexpr float EPS = 1e-6f;
constexpr int NTHR = 512, NWAVE = 8;

constexpr size_t MiB = 1u << 20;
constexpr size_t WS_WTIN = 1 * MiB;
constexpr size_t WS_WTOUT = 17 * MiB;
constexpr size_t WS_WTUQ = 21 * MiB;
constexpr size_t WS_WTUKV = 22 * MiB;
constexpr size_t WS_ROPE = 23 * MiB;
constexpr size_t WS_HN = 24 * MiB;
constexpr size_t WS_Y = WS_HN;
constexpr size_t WS_Q384 = WS_HN;
constexpr size_t WS_KV512 = WS_HN + 24 * MiB;
constexpr size_t WS_P = 88 * MiB;
constexpr size_t WS_QA = 344 * MiB;
constexpr size_t WS_KA = 368 * MiB;
constexpr size_t WS_VA = 392 * MiB;
constexpr size_t WS_CQN = WS_VA;
constexpr size_t WS_MASK = 408 * MiB;
constexpr size_t WS_CKVN = WS_MASK;
constexpr size_t WS_OKL = 424 * MiB;
constexpr size_t WS_XR = 440 * MiB;
constexpr size_t WS_END = 504 * MiB;

constexpr int LDS_BYTES = 148480;

__device__ __forceinline__ bf16_t f2bf(float f) {
    unsigned u = __builtin_bit_cast(unsigned, f);
    return (bf16_t)((u + 0x7fffu + ((u >> 16) & 1u)) >> 16);
}
__device__ __forceinline__ float bf2f(bf16_t h) { return __builtin_bit_cast(float, (unsigned)h << 16); }
__device__ __forceinline__ float silu(float x) { return x / (1.f + __expf(-x)); }
__device__ __forceinline__ int orig_col(int pc) {
    if (pc < 416) return pc;
    if (pc < 448) return -1;
    if (pc < 2792) return pc - 32;
    if (pc < 2816) return -1;
    return pc - 56;
}
__device__ __forceinline__ int rel_bucket(int rel) {
    const int ret = rel > 0 ? 16 : 0;
    const int n = rel < 0 ? -rel : rel;
    if (n < 8) return ret + n;
    int large = 2 + (31 - __clz(n * n));
    if (large > 15) large = 15;
    return ret + large;
}

__device__ __forceinline__ int opaque_tid() { int t = threadIdx.x; asm volatile("" : "+v"(t)); return t; }
__device__ __forceinline__ int opaque_bid() { int b = blockIdx.x; asm volatile("" : "+s"(b)); return b; }
__device__ __forceinline__ int opaque_grid() { int g = gridDim.x; asm volatile("" : "+s"(g)); return g; }
namespace pg8 {
constexpr int BM = 256, BK = 64, HALF = 128, HTB = HALF * BK * 2, STAGE_BYTES = 8 * HTB, NXCD = 8, WGM = 8;
__host__ __device__ __forceinline__ int lds_byte(int r, int c) { const int st = (r >> 4) * 2 + (c >> 5), rr = r & 15, cc = c & 31, ob = rr * 64 + cc * 2; return st * 1024 + (ob ^ (((ob >> 9) & 1) << 5)); }
__host__ __device__ __forceinline__ void stage_rc(int b, int& R, int& C) { const int st = b / 1024, sb = b % 1024, swz = sb ^ (((sb >> 9) & 1) << 5); R = (st >> 1) * 16 + swz / 64; C = (st & 1) * 32 + (swz % 64) / 2; }
__host__ __device__ __forceinline__ int perm32(int rho) { const int n = rho >> 4, i = rho & 15; return 8 * (i >> 2) + 4 * n + (i & 3); }
struct Unit { int pm, pn; };
struct Gemm { const bf16_t* A; const bf16_t* Bt; int M, N, K; };
struct StaticOrder {
    int nM, nN, nwg, G, c;
    __host__ __device__ void init(int M, int N, int G_, int c_) { nM = M / BM; nN = N / BM; nwg = nM * nN; G = G_; c = c_; }
    __host__ __device__ bool next(int i, Unit& u) const {
        const long L = (long)i * G + c; if (L >= nwg) return false;
        int wgid = (int)L; { const int q = nwg / NXCD, r = nwg % NXCD, xcd = wgid % NXCD, off = wgid / NXCD; wgid = (xcd < r ? xcd * (q + 1) : r * (q + 1) + (xcd - r) * q) + off; }
        const int nig = WGM * nN, gid = wgid / nig, fm = gid * WGM, gsz = (nM - fm) < WGM ? (nM - fm) : WGM;
        u.pm = fm + ((wgid % nig) % gsz); u.pn = (wgid % nig) / gsz; return true;
    }
    __device__ __forceinline__ void a_ready(const Unit&) const {}
    __device__ __forceinline__ void done(const Unit&) const {}
};
__device__ __forceinline__ unsigned cvt_pk_bf16(float lo, float hi) { unsigned r; asm volatile("v_cvt_pk_bf16_f32 %0, %1, %2" : "=v"(r) : "v"(lo), "v"(hi)); return r; }
struct EpiBf16 {
    static constexpr bool PERM = true, AFTER_DRAIN = false;
    bf16_t* O; int ldc;
    __device__ __forceinline__ void operator()(const f32x4 (&acc)[2][2][4][2], const Unit& u, int wr, int wc, int fr, int fq) const {
        const int row0 = u.pm * BM + wr * 64 + fr; const int col0 = u.pn * BM + wc * 32 + 8 * fq;
#pragma unroll
        for (int ai = 0; ai < 2; ++ai)
#pragma unroll
            for (int m = 0; m < 4; ++m) { bf16_t* rowp = O + (size_t)(row0 + ai * HALF + m * 16) * ldc + col0;
#pragma unroll
                for (int bj = 0; bj < 2; ++bj) { const f32x4 v0 = acc[ai][bj][m][0], v1 = acc[ai][bj][m][1];
                    u32x4 w; w.x = cvt_pk_bf16(v0[0], v0[1]); w.y = cvt_pk_bf16(v0[2], v0[3]); w.z = cvt_pk_bf16(v1[0], v1[1]); w.w = cvt_pk_bf16(v1[2], v1[3]);
                    *(u32x4*)(rowp + bj * HALF) = w; } }
    }
};
struct EpiResF32 {
    static constexpr bool PERM = false, AFTER_DRAIN = false;
    const float* base; float* out; int ldc;
    __device__ __forceinline__ void operator()(const f32x4 (&acc)[2][2][4][2], const Unit& u, int wr, int wc, int fr, int fq) const {
        const int col0 = u.pn * BM + wc * 32 + 4 * fq;
#pragma unroll
        for (int ai = 0; ai < 2; ++ai)
#pragma unroll
            for (int m = 0; m < 4; ++m) { const size_t off = (size_t)(u.pm * BM + ai * HALF + wr * 64 + m * 16 + fr) * ldc + col0;
#pragma unroll
                for (int bj = 0; bj < 2; ++bj)
#pragma unroll
                    for (int n = 0; n < 2; ++n) { const f32x4 bs = *(const f32x4*)(base + off + bj * HALF + n * 16); *(f32x4*)(out + off + bj * HALF + n * 16) = bs + acc[ai][bj][m][n]; } }
    }
};
template <bool BASE_BF16>
struct EpiResBf16 {
    static constexpr bool PERM = true, AFTER_DRAIN = false;
    const void* base; bf16_t* out; int ldc;
    __device__ __forceinline__ void operator()(const f32x4 (&acc)[2][2][4][2], const Unit& u, int wr, int wc, int fr, int fq) const {
        const int row0 = u.pm * BM + wr * 64 + fr; const int col0 = u.pn * BM + wc * 32 + 8 * fq;
#pragma unroll
        for (int ai = 0; ai < 2; ++ai)
#pragma unroll
            for (int m = 0; m < 4; ++m) { const size_t ro = (size_t)(row0 + ai * HALF + m * 16) * ldc + col0;
#pragma unroll
                for (int bj = 0; bj < 2; ++bj) { const f32x4 v0 = acc[ai][bj][m][0], v1 = acc[ai][bj][m][1]; const size_t off = ro + bj * HALF;
                    f32x4 b0, b1;
                    if (BASE_BF16) { const u16x8 bb = *(const u16x8*)((const bf16_t*)base + off);
                        b0 = (f32x4){bf2f(bb[0]), bf2f(bb[1]), bf2f(bb[2]), bf2f(bb[3])}; b1 = (f32x4){bf2f(bb[4]), bf2f(bb[5]), bf2f(bb[6]), bf2f(bb[7])}; }
                    else { b0 = *(const f32x4*)((const float*)base + off); b1 = *(const f32x4*)((const float*)base + off + 4); }
                    const f32x4 s0 = b0 + v0, s1 = b1 + v1;
                    u32x4 w; w.x = cvt_pk_bf16(s0[0], s0[1]); w.y = cvt_pk_bf16(s0[2], s0[3]); w.z = cvt_pk_bf16(s1[0], s1[1]); w.w = cvt_pk_bf16(s1[2], s1[3]);
                    *(u32x4*)(out + off) = w; } }
    }
};
template <class Epi, class Sched, bool ALIGN_EPI = false, bool SP2 = false>
__device__ __forceinline__ void gemm_phase(LAS unsigned char* lds, const Gemm g, const Sched& S, const Epi& E) {
    const int tid = opaque_tid(), wid = __builtin_amdgcn_readfirstlane(tid >> 6), lane = tid & 63, wr = wid >> 2, wc = wid & 3, fr = lane & 15, fq = lane >> 4;
    const int K = g.K, nt = K / BK;
    unsigned voffA[2], voffB[2];
#pragma unroll
    for (int i = 0; i < 2; ++i) { int R, C; stage_rc(tid * 16 + i * 8192, R, C); const int Rb = Epi::PERM ? ((R & ~31) + perm32(R & 31)) : R;
        voffA[i] = (unsigned)(R * K + C) * 2u; voffB[i] = (unsigned)(Rb * K + C) * 2u; }
    const size_t kstep = (size_t)(BK * 2);
    const size_t hstep = (size_t)HALF * K * 2;
    const size_t tstep = 2 * hstep;
    const unsigned ldsw = (unsigned)wid * 1024u;
    const int aoff = lds_byte(wr * 64 + fr, fq * 8), boff = lds_byte(wc * 32 + fr, fq * 8);
#define PG8_SA(b, h) (((b) * 2 + (h)) * HTB)
#define PG8_SB(b, h) ((4 + (b) * 2 + (h)) * HTB)
#define PG8_STAGE(bufoff, gbase, voff) do { _Pragma("unroll") for (int _i = 0; _i < 2; ++_i) \
        __builtin_amdgcn_global_load_lds((const unsigned*)((const char*)(gbase) + (voff)[_i]), (LAS unsigned*)(lds + (bufoff) + ldsw + _i * 8192), 16, 0, 0); } while (0)
#define PG8_LDA(dst, b, h) do { _Pragma("unroll") for (int m = 0; m < 4; ++m) _Pragma("unroll") for (int k = 0; k < 2; ++k) dst[m][k] = *(const LAS bf16x8*)(lds + PG8_SA(b, h) + aoff + m * 2048 + k * 1024); } while (0)
#define PG8_LDB(dst, b, h) do { _Pragma("unroll") for (int n = 0; n < 2; ++n) _Pragma("unroll") for (int k = 0; k < 2; ++k) dst[n][k] = *(const LAS bf16x8*)(lds + PG8_SB(b, h) + boff + n * 2048 + k * 1024); } while (0)
#define PG8_MMA(ai, bj, At, Bt) do { __builtin_amdgcn_s_setprio(1); _Pragma("unroll") for (int m = 0; m < 4; ++m) _Pragma("unroll") for (int n = 0; n < 2; ++n) _Pragma("unroll") for (int k = 0; k < 2; ++k) \
        acc[ai][bj][m][n] = __builtin_amdgcn_mfma_f32_16x16x32_bf16(Bt[n][k], At[m][k], acc[ai][bj][m][n], 0, 0, 0); __builtin_amdgcn_s_setprio(0); } while (0)
#define PG8_WAIT_V(n) asm volatile("s_waitcnt vmcnt(" #n ")" ::: "memory")
#define PG8_WAIT_L(n) asm volatile("s_waitcnt lgkmcnt(" #n ")" ::: "memory")
#define PG8_BAR __builtin_amdgcn_s_barrier()
#define PG8_SCHED __builtin_amdgcn_sched_barrier(0)
    Unit cur, nxt; int ui = 0;
    if (!S.next(0, cur)) return;
    f32x4 acc[2][2][4][2];
#pragma unroll
    for (int a = 0; a < 2; ++a)
#pragma unroll
        for (int b = 0; b < 2; ++b)
#pragma unroll
            for (int m = 0; m < 4; ++m)
#pragma unroll
                for (int n = 0; n < 2; ++n) acc[a][b][m][n] = (f32x4){0.f, 0.f, 0.f, 0.f};
    bf16x8 At[4][2], B0[2][2], B1[2][2];
    const char* cA = (const char*)g.A + (size_t)cur.pm * tstep; const char* cB = (const char*)g.Bt + (size_t)cur.pn * tstep;
    S.a_ready(cur);
    if constexpr (SP2) {
        PG8_STAGE(PG8_SB(0, 0), cB, voffB); PG8_STAGE(PG8_SB(0, 1), cB + hstep, voffB); PG8_STAGE(PG8_SA(0, 0), cA, voffA); PG8_STAGE(PG8_SA(0, 1), cA + hstep, voffA);
        if (wr == 1) PG8_BAR;
        PG8_WAIT_V(2); PG8_BAR;
        PG8_STAGE(PG8_SB(1, 0), cB + kstep, voffB); PG8_STAGE(PG8_SA(1, 0), cA + kstep, voffA); PG8_STAGE(PG8_SB(1, 1), cB + hstep + kstep, voffB);
        PG8_WAIT_V(6); PG8_BAR;
    } else {
        PG8_STAGE(PG8_SB(0, 0), cB, voffB); PG8_STAGE(PG8_SA(0, 0), cA, voffA); PG8_STAGE(PG8_SB(0, 1), cB + hstep, voffB); PG8_STAGE(PG8_SA(0, 1), cA + hstep, voffA);
        if (wr == 1) PG8_BAR;
        PG8_WAIT_V(4); PG8_BAR;
        PG8_STAGE(PG8_SB(1, 0), cB + kstep, voffB); PG8_STAGE(PG8_SA(1, 0), cA + kstep, voffA); PG8_STAGE(PG8_SB(1, 1), cB + hstep + kstep, voffB);
        PG8_WAIT_V(6); PG8_BAR;
    }
    for (;;) {
        const bool has_next = S.next(ui + 1, nxt);
        const char* nA = has_next ? (const char*)g.A + (size_t)nxt.pm * tstep : cA; const char* nB = has_next ? (const char*)g.Bt + (size_t)nxt.pn * tstep : cB;
        for (int t = 0; t < nt; t += 2) {
            const bool last = (t == nt - 2);
            const char* a1 = cA + (size_t)(t + 1) * kstep;
            const char* a2 = last ? nA : cA + (size_t)(t + 2) * kstep; const char* b2 = last ? nB : cB + (size_t)(t + 2) * kstep;
            const char* a3 = a2 + kstep; const char* b3 = b2 + kstep;
            if (last && has_next) S.a_ready(nxt);
            if constexpr (SP2) {
            PG8_LDB(B0, 0, 0); PG8_LDB(B1, 0, 1); PG8_SCHED; PG8_LDA(At, 0, 0); PG8_STAGE(PG8_SA(1, 1), a1 + hstep, voffA);
            PG8_WAIT_V(8); PG8_WAIT_L(0); PG8_BAR; PG8_MMA(0, 0, At, B0); PG8_MMA(0, 1, At, B1); PG8_BAR; PG8_SCHED;
            PG8_LDA(At, 0, 1); PG8_STAGE(PG8_SB(0, 0), b2, voffB); PG8_STAGE(PG8_SB(0, 1), b2 + hstep, voffB); PG8_STAGE(PG8_SA(0, 0), a2, voffA);
            PG8_WAIT_V(8); PG8_WAIT_L(0); PG8_BAR; PG8_MMA(1, 0, At, B0); PG8_MMA(1, 1, At, B1); PG8_BAR; PG8_SCHED;
            PG8_LDB(B0, 1, 0); PG8_LDB(B1, 1, 1); PG8_SCHED; PG8_LDA(At, 1, 0); PG8_STAGE(PG8_SA(0, 1), a2 + hstep, voffA);
            PG8_WAIT_V(8); PG8_WAIT_L(0); PG8_BAR; PG8_MMA(0, 0, At, B0); PG8_MMA(0, 1, At, B1); PG8_BAR; PG8_SCHED;
            PG8_LDA(At, 1, 1); PG8_STAGE(PG8_SB(1, 0), b3, voffB); PG8_STAGE(PG8_SB(1, 1), b3 + hstep, voffB); PG8_STAGE(PG8_SA(1, 0), a3, voffA);
            PG8_WAIT_V(8); PG8_WAIT_L(0); PG8_BAR; PG8_MMA(1, 0, At, B0); PG8_MMA(1, 1, At, B1); PG8_BAR; PG8_SCHED;
            } else {
            PG8_LDB(B0, 0, 0); PG8_SCHED; PG8_LDA(At, 0, 0); PG8_STAGE(PG8_SA(1, 1), a1 + hstep, voffA);
            PG8_WAIT_L(8); PG8_BAR; PG8_WAIT_L(0); PG8_MMA(0, 0, At, B0); PG8_BAR; PG8_SCHED;
            PG8_LDB(B1, 0, 1); PG8_STAGE(PG8_SB(0, 0), b2, voffB);
            PG8_BAR; PG8_WAIT_L(0); PG8_MMA(0, 1, At, B1); PG8_BAR;
            PG8_LDA(At, 0, 1); PG8_STAGE(PG8_SA(0, 0), a2, voffA);
            PG8_BAR; PG8_WAIT_L(0); PG8_MMA(1, 0, At, B0); PG8_BAR; PG8_SCHED;
            PG8_STAGE(PG8_SB(0, 1), b2 + hstep, voffB);
            PG8_WAIT_V(6); PG8_BAR; PG8_MMA(1, 1, At, B1); PG8_BAR;
            PG8_LDB(B0, 1, 0); PG8_SCHED; PG8_LDA(At, 1, 0); PG8_STAGE(PG8_SA(0, 1), a2 + hstep, voffA);
            PG8_WAIT_L(8); PG8_BAR; PG8_WAIT_L(0); PG8_MMA(0, 0, At, B0); PG8_BAR; PG8_SCHED;
            PG8_LDB(B1, 1, 1); PG8_STAGE(PG8_SB(1, 0), b3, voffB);
            PG8_BAR; PG8_WAIT_L(0); PG8_MMA(0, 1, At, B1); PG8_BAR;
            PG8_LDA(At, 1, 1); PG8_STAGE(PG8_SA(1, 0), a3, voffA);
            PG8_BAR; PG8_WAIT_L(0); PG8_MMA(1, 0, At, B0); PG8_BAR; PG8_SCHED;
            PG8_STAGE(PG8_SB(1, 1), b3 + hstep, voffB);
            PG8_WAIT_V(6); PG8_BAR; PG8_MMA(1, 1, At, B1); PG8_BAR;
            }
        }
        if constexpr (ALIGN_EPI) { if (wr == 0) PG8_BAR; }
        if constexpr (!Epi::AFTER_DRAIN) { E(acc, cur, wr, wc, fr, fq); S.done(cur); }
        if (!has_next) break;
#pragma unroll
        for (int a = 0; a < 2; ++a)
#pragma unroll
            for (int b = 0; b < 2; ++b)
#pragma unroll
                for (int m = 0; m < 4; ++m)
#pragma unroll
                    for (int n = 0; n < 2; ++n) acc[a][b][m][n] = (f32x4){0.f, 0.f, 0.f, 0.f};
        cur = nxt; cA = nA; cB = nB; ++ui;
        if constexpr (ALIGN_EPI) { if (wr == 1) PG8_BAR; }
    }
    PG8_WAIT_V(0);
    if constexpr (!ALIGN_EPI) { if (wr == 0) PG8_BAR; }
    PG8_BAR;
#undef PG8_SA
#undef PG8_SB
#undef PG8_STAGE
#undef PG8_LDA
#undef PG8_LDB
#undef PG8_MMA
#undef PG8_WAIT_V
#undef PG8_WAIT_L
#undef PG8_BAR
#undef PG8_SCHED
}
}

struct Args {
    const float* x; const float* norm_g; const float* w_in; const float* qa_g; const float* w_uq; const float* kva_g; const float* w_ukv;
    const float* dlam; const float* subg; const float* conv_w; const float* w_out; const float* rel_bias; const float* final_g;
    float* out; unsigned char* ws;
    float lambda_init[2]; int pad[2];
};

typedef const __attribute__((address_space(4))) Args* ArgsP;
__device__ __forceinline__ ArgsP get_args() { ArgsP p = (ArgsP)__builtin_amdgcn_kernarg_segment_ptr(); asm volatile("" : "+s"(p)); return p; }

#define XB_TMO      128
#define XB_XCNT(j)  (256  + 64 * (j))
#define XB_XSUB(j)  (1280 + 64 * (j))
#define XB_XGEN(j)  (2304 + 64 * (j))
#define XB_TOP      3328
#define XB_TOPGEN   3392
#define XCD_BAR_WORDS 3456
#define XB_SPIN_CAP (1u << 18)
constexpr int LDS_XB = 148464;
__device__ __forceinline__ unsigned xb_ld(unsigned* p)              { return __hip_atomic_load(p, __ATOMIC_RELAXED, __HIP_MEMORY_SCOPE_AGENT); }
__device__ __forceinline__ unsigned xb_add(unsigned* p, unsigned v) { return __hip_atomic_fetch_add(p, v, __ATOMIC_RELAXED, __HIP_MEMORY_SCOPE_AGENT); }
__device__ __forceinline__ unsigned xb_xcc_id() { return (unsigned)__builtin_amdgcn_s_getreg((3 << 11) | 20) & 0xFu; }
#define XB_SPIN(cond, bar) do { unsigned _sp = 0; while (cond) { __builtin_amdgcn_s_sleep(1); \
    if ((++_sp & 255u) == 0u) { if (xb_ld(&(bar)[XB_TMO])) break; if (_sp > XB_SPIN_CAP) { atomicAdd(&(bar)[XB_TMO], 1u); break; } } } } while (0)
__device__ __forceinline__ void xcd_barrier_complete(unsigned* bar, unsigned x, unsigned& nloc, unsigned& nx) {
    const unsigned G = gridDim.x * gridDim.y * gridDim.z;
    unsigned sum, cnt, mine, sp = 0u;
    for (;;) {
        sum = 0u; cnt = 0u; mine = 0u;
#pragma unroll
        for (unsigned j = 0; j < 16; ++j) { const unsigned c = xb_ld(&bar[XB_XCNT(j)]); sum += c; cnt += (c > 0u) ? 1u : 0u; mine = (j == x) ? c : mine; }
        if (sum == G) break;
        __builtin_amdgcn_s_sleep(1);
        if ((++sp & 255u) == 0u) { if (xb_ld(&bar[XB_TMO])) break; if (sp > XB_SPIN_CAP) { atomicAdd(&bar[XB_TMO], 1u); break; } }
    }
    nloc = mine > 0u ? mine : 1u; nx = cnt > 0u ? cnt : 1u;
}
__device__ __forceinline__ void xcd_barrier_post(LAS unsigned char* lds) {
    ArgsP A = get_args(); unsigned* bar = (unsigned*)A->ws;
    if (threadIdx.x == 0) { ((volatile LAS unsigned*)(lds + LDS_XB))[0] = 0u; ((volatile LAS unsigned*)(lds + LDS_XB))[1] = 0u;
        (void)xb_add(&bar[XB_XCNT(xb_xcc_id())], 1u); }
    __syncthreads();
}
__device__ __forceinline__ void xcd_barrier(LAS unsigned char* lds) {
    ArgsP A = get_args(); unsigned* bar = (unsigned*)A->ws;
    asm volatile("s_waitcnt vmcnt(0)" ::: "memory");
    __syncthreads();
    if (threadIdx.x == 0) {
        const unsigned x = xb_xcc_id();
        volatile LAS unsigned* st = (volatile LAS unsigned*)(lds + LDS_XB);
        __builtin_amdgcn_s_waitcnt(0);
        unsigned nloc = st[0], nx = st[1];
        if (nloc == 0u) { xcd_barrier_complete(bar, x, nloc, nx); st[0] = nloc; st[1] = nx; }
        const unsigned old = xb_add(&bar[XB_XSUB(x)], 1u);
        const unsigned gen = old / nloc;
        if (old + 1u == (gen + 1u) * nloc) {
            __builtin_amdgcn_fence(__ATOMIC_RELEASE, "agent");
            asm volatile("s_waitcnt vmcnt(0)" ::: "memory");
            const unsigned og = xb_add(&bar[XB_TOP], 1u);
            const unsigned tg = og / nx;
            if (og + 1u == (tg + 1u) * nx) xb_add(&bar[XB_TOPGEN], 1u);
            else XB_SPIN(xb_ld(&bar[XB_TOPGEN]) == tg, bar);
            __builtin_amdgcn_fence(__ATOMIC_ACQUIRE, "agent");
            xb_add(&bar[XB_XGEN(x)], 1u);
            asm volatile("s_waitcnt vmcnt(0)" ::: "memory");
        } else {
            XB_SPIN(xb_ld(&bar[XB_XGEN(x)]) == gen, bar);
            __builtin_amdgcn_fence(__ATOMIC_ACQUIRE, "agent");
            asm volatile("s_waitcnt vmcnt(0)" ::: "memory");
        }
    }
    __syncthreads();
}

constexpr float QS_MLA = 0.10206207261596575f * 1.4426950408889634f;
constexpr float QS_DIFF = 0.17677669529663687f * 1.4426950408889634f;
constexpr float QS_DSA = 0.125f * 1.4426950408889634f;
template <bool OUT_BF16>
__device__ __forceinline__ void rms_rows4(const float* xbase, size_t rstride, const float* g, bf16_t* obase, float* fbase, int lane) {
    f32x4 v[4][4]; float ss[4];
#pragma unroll
    for (int k = 0; k < 4; ++k) { const f32x4* xr = (const f32x4*)(xbase + k * rstride) + lane;
#pragma unroll
        for (int j = 0; j < 4; ++j) v[k][j] = xr[64 * j]; }
#pragma unroll
    for (int k = 0; k < 4; ++k) { float s = 0.f;
#pragma unroll
        for (int j = 0; j < 4; ++j) s += v[k][j].x * v[k][j].x + v[k][j].y * v[k][j].y + v[k][j].z * v[k][j].z + v[k][j].w * v[k][j].w;
        ss[k] = s; }
#pragma unroll
    for (int o = 1; o < 64; o <<= 1) {
#pragma unroll
        for (int k = 0; k < 4; ++k) ss[k] += __shfl_xor(ss[k], o); }
    f32x4 gv[4];
#pragma unroll
    for (int j = 0; j < 4; ++j) gv[j] = ((const f32x4*)g)[lane + 64 * j];
#pragma unroll
    for (int k = 0; k < 4; ++k) { const float r = rsqrtf(ss[k] * (1.f / D) + EPS);
#pragma unroll
        for (int j = 0; j < 4; ++j) {
            const f32x4 o = (f32x4){v[k][j].x * r * gv[j].x, v[k][j].y * r * gv[j].y, v[k][j].z * r * gv[j].z, v[k][j].w * r * gv[j].w};
            if (OUT_BF16) { u32x2 w; w.x = pg8::cvt_pk_bf16(o.x, o.y); w.y = pg8::cvt_pk_bf16(o.z, o.w); ((u32x2*)(obase + k * rstride))[lane + 64 * j] = w; }
            else ((f32x4*)(fbase + k * rstride))[lane + 64 * j] = o;
        } }
}
template <bool OUT_BF16>
__device__ __forceinline__ void rms_rows4b(const bf16_t* xbase, size_t rstride, const float* g, bf16_t* obase, float* fbase, int lane) {
    u16x8 v[4][2]; float ss[4];
#pragma unroll
    for (int k = 0; k < 4; ++k) { const u16x8* xr = (const u16x8*)(xbase + k * rstride) + lane;
#pragma unroll
        for (int j = 0; j < 2; ++j) v[k][j] = xr[64 * j]; }
#pragma unroll
    for (int k = 0; k < 4; ++k) { float s = 0.f;
#pragma unroll
        for (int j = 0; j < 2; ++j)
#pragma unroll
            for (int e = 0; e < 8; ++e) { const float f = bf2f(v[k][j][e]); s += f * f; }
        ss[k] = s; }
#pragma unroll
    for (int o = 1; o < 64; o <<= 1) {
#pragma unroll
        for (int k = 0; k < 4; ++k) ss[k] += __shfl_xor(ss[k], o); }
    f32x4 gv[2][2];
#pragma unroll
    for (int j = 0; j < 2; ++j) { gv[j][0] = ((const f32x4*)g)[2 * lane + 128 * j]; gv[j][1] = ((const f32x4*)g)[2 * lane + 1 + 128 * j]; }
#pragma unroll
    for (int k = 0; k < 4; ++k) { const float r = rsqrtf(ss[k] * (1.f / D) + EPS);
#pragma unroll
        for (int j = 0; j < 2; ++j) {
            f32x4 o0, o1;
#pragma unroll
            for (int e = 0; e < 4; ++e) { o0[e] = bf2f(v[k][j][e]) * r * gv[j][0][e]; o1[e] = bf2f(v[k][j][4 + e]) * r * gv[j][1][e]; }
            if (OUT_BF16) { u32x4 w; w.x = pg8::cvt_pk_bf16(o0[0], o0[1]); w.y = pg8::cvt_pk_bf16(o0[2], o0[3]); w.z = pg8::cvt_pk_bf16(o1[0], o1[1]); w.w = pg8::cvt_pk_bf16(o1[2], o1[3]);
                ((u32x4*)(obase + k * rstride))[lane + 64 * j] = w; }
            else { ((f32x4*)(fbase + k * rstride))[2 * lane + 128 * j] = o0; ((f32x4*)(fbase + k * rstride))[2 * lane + 1 + 128 * j] = o1; }
        } }
}
__device__ __forceinline__ void convert_tile(LAS float* scr, const float* W, bf16_t* Wt, int K, int Nsrc, int remap, float uscale, int k0, int n0, int tid) {
    __syncthreads();
#pragma unroll
    for (int i = 0; i < 8; ++i) { const int e = tid + 512 * i, kk = e >> 6, nn = e & 63, n = n0 + nn;
        const int sc = remap ? orig_col(n) : n;
        float s = uscale;
        if (remap) { if (n >= CB_Q && n < CB_Q + 256) s = QS_DIFF; if (n >= CC_Q && n < CC_Q + 256) s = QS_DSA; }
        scr[kk * 65 + nn] = (sc >= 0) ? W[(size_t)(k0 + kk) * Nsrc + sc] * s : 0.f; }
    __syncthreads();
    { const int nn = tid >> 3, kc = (tid & 7) * 8;
        u32x4 w; w.x = pg8::cvt_pk_bf16(scr[(kc + 0) * 65 + nn], scr[(kc + 1) * 65 + nn]); w.y = pg8::cvt_pk_bf16(scr[(kc + 2) * 65 + nn], scr[(kc + 3) * 65 + nn]);
        w.z = pg8::cvt_pk_bf16(scr[(kc + 4) * 65 + nn], scr[(kc + 5) * 65 + nn]); w.w = pg8::cvt_pk_bf16(scr[(kc + 6) * 65 + nn], scr[(kc + 7) * 65 + nn]);
        *(u32x4*)(Wt + (size_t)(n0 + nn) * K + k0 + kc) = w; }
}
namespace fa {
typedef short ps16x2 __attribute__((ext_vector_type(2)));
typedef unsigned short pu16x2 __attribute__((ext_vector_type(2)));
__device__ __forceinline__ unsigned ppk_lt(unsigned v, unsigned c) { const ps16x2 d = __builtin_elementwise_sub_sat(__builtin_bit_cast(ps16x2, v), __builtin_bit_cast(ps16x2, c)); return __builtin_bit_cast(unsigned, __builtin_bit_cast(pu16x2, d) >> 15); }
__device__ __forceinline__ unsigned ppk_add(unsigned a, unsigned b) { return __builtin_bit_cast(unsigned, __builtin_bit_cast(pu16x2, a) + __builtin_bit_cast(pu16x2, b)); }
typedef float f32x16 __attribute__((ext_vector_type(16)));
typedef short s16x4 __attribute__((ext_vector_type(4)));
typedef short v4i16_t __attribute__((ext_vector_type(4)));
constexpr int KCS = 1040;
constexpr int KBUF = 12 * KCS + 64;
constexpr int L_K0 = 0, L_V0 = 4 * KBUF, L_WSF = L_V0 + 4 * 8192, L_BIAS = L_WSF + 8 * 256, L_END = L_BIAS + 12 * 320 * 4, L_FLAG = L_END;
constexpr float THR = 6.0f;
constexpr float LOG2E = 1.4426950408889634f;
__device__ __forceinline__ int crow(int r, int hi) { return (r & 3) + 8 * (r >> 2) + 4 * hi; }
__device__ __forceinline__ unsigned cvtpk(float lo, float hi) { typedef float f2 __attribute__((ext_vector_type(2))); typedef __bf16 b2 __attribute__((ext_vector_type(2)));
    f2 v = {lo, hi}; b2 r = __builtin_convertvector(v, b2); return __builtin_bit_cast(unsigned, r); }
__device__ __forceinline__ s16x4 vtr(const LAS unsigned char* p) { return __builtin_bit_cast(s16x4, __builtin_amdgcn_ds_read_tr16_b64_v4i16((LAS v4i16_t*)p)); }
__device__ __forceinline__ float max3f(float a, float b, float c) { float r; asm("v_max3_f32 %0, %1, %2, %3" : "=v"(r) : "v"(a), "v"(b), "v"(c)); return r; }
__device__ __forceinline__ float max2f(float a, float b) { float r; asm("v_max_f32_e32 %0, %1, %2" : "=v"(r) : "v"(a), "v"(b)); return r; }
#define FA_ROWMAX(rm, S0, S1) do { asm volatile("s_nop 15\n\ts_nop 7" : "+v"(S0), "+v"(S1)); \
        float a_ = max3f(S0[0], S0[1], S1[0]), b_ = max3f(S0[2], S0[3], S1[1]); a_ = max3f(a_, S1[2], S1[3]); \
        _Pragma("unroll") for (int r = 4; r < 16; r += 4) { a_ = max3f(a_, S0[r], S0[r + 1]); b_ = max3f(b_, S0[r + 2], S0[r + 3]); a_ = max3f(a_, S1[r], S1[r + 1]); b_ = max3f(b_, S1[r + 2], S1[r + 3]); } \
        rm = max2f(a_, b_); } while (0)
__device__ __forceinline__ float xhalf_max(float v) { auto rr = __builtin_amdgcn_permlane32_swap(__float_as_uint(v), __float_as_uint(v), false, false); return fmaxf(__uint_as_float(rr[0]), __uint_as_float(rr[1])); }
__device__ __forceinline__ float xhalf_sum(float v) { auto rr = __builtin_amdgcn_permlane32_swap(__float_as_uint(v), __float_as_uint(v), false, false); return __uint_as_float(rr[0]) + __uint_as_float(rr[1]); }

__device__ __forceinline__ void build_bias(LAS unsigned char* lds, const float* rel_bias) {
    LAS float* bt = (LAS float*)(lds + L_BIAS);
    for (int e = opaque_tid(); e < 12 * 320; e += NTHR) { const int col = e / 320, i = e % 320;
        bt[e] = (rel_bias[rel_bucket(i - 256) * 12 + col] - rel_bias[15 * 12 + col]) * LOG2E; }
}

template <int TYPE>
__device__ __forceinline__ void attn_unit(LAS unsigned char* lds, int b, int h, int qb, int layer) {
    ArgsP A = get_args();
    unsigned char* ws = A->ws;
    const bf16_t* P = (const bf16_t*)(ws + WS_P);
    const int tid = opaque_tid(), lane = tid & 63, r32 = lane & 31, hi = lane >> 5, wid = __builtin_amdgcn_readfirstlane(tid >> 6);
    constexpr int DK = (TYPE == 0) ? 96 : 64, NCH = DK / 8, NPASS = (TYPE == 1) ? 2 : 1, DQ = (TYPE == 0) ? 96 : (TYPE == 1) ? 32 : 64, NQF = DQ / 16;
    const size_t row0 = (size_t)b * S;
    const bf16_t* Kg; const bf16_t* Vg; int kpitch, vpitch;
    if (TYPE == 0) { Kg = (const bf16_t*)(ws + WS_KA) + row0 * 384 + h * 96; kpitch = 384; Vg = (const bf16_t*)(ws + WS_VA) + row0 * 256 + h * 64; vpitch = 256; }
    else { Kg = P + row0 * PC + ((TYPE == 1) ? CB_K : CC_K) + h * 64; kpitch = PC; Vg = P + row0 * PC + ((TYPE == 1) ? CB_V : CC_V) + h * 64; vpitch = PC; }
    const int k0key = tid / NCH, k0ch = tid % NCH;
    const int k1key = (tid + 512) / NCH, k1ch = (tid + 512) % NCH;
    const bool has_k1 = (NCH == 12) && (tid < 256);
    const int vkey = tid >> 3, vc8 = tid & 7;
    const bf16_t* kg0 = Kg + (size_t)k0key * kpitch + k0ch * 8;
    const bf16_t* kg1 = Kg + (size_t)k1key * kpitch + k1ch * 8;
    const bf16_t* vg0 = Vg + (size_t)vkey * vpitch + vc8 * 8;
    const int kl0 = k0ch * KCS + k0key * 16, kl1 = k1ch * KCS + k1key * 16;
    const int vl0 = ((vc8 >> 2) * 4 + (vkey >> 4)) * 1024 + (vkey & 15) * 64 + (vc8 & 3) * 16;
    const int qw = qb * 256 + wid * 32;
    const size_t tq = row0 + qw + r32;
    const int NT = 4 * qb + 4, NTw = 4 * qb + (wid >> 1) + 1, TM = 4 * qb;
    LAS float* wsf = (LAS float*)(lds + L_WSF) + wid * 64;
    const LAS unsigned char* vfb = lds + L_V0 + ((lane >> 4) & 1) * 32 + (lane & 3) * 8 + (4 * hi + ((lane & 15) >> 2)) * 64;
    const unsigned* mrow = (const unsigned*)(ws + WS_MASK) + tq * 128;
    float* okl = (float*)(ws + WS_OKL) + ((size_t)opaque_bid() * 8 + wid) * 2048 + lane;
    f32x16 o0 = f32x16{}, o1 = f32x16{};
    float mhat = 0.f, lsum = 0.f;
    int fast = 1; asm volatile("" : "+s"(fast));
#pragma unroll 1
    for (;;) {
#pragma unroll 1
    for (int mp = 0; mp < NPASS; ++mp) {
    bf16x8 qf[NQF];
#pragma unroll
    for (int d0 = 0; d0 < NQF; ++d0) {
        const bf16_t* qp = (TYPE == 0) ? (const bf16_t*)(ws + WS_QA) + tq * 384 + h * 96 + 16 * d0 + 8 * hi
                                       : P + tq * PC + ((TYPE == 1) ? CB_Q + mp * 32 : CC_Q) + h * 64 + 16 * d0 + 8 * hi;
        qf[d0] = *(const bf16x8*)qp;
    }
    mhat = 0.f; lsum = 0.f; o0 = f32x16{}; o1 = f32x16{};
    const LAS unsigned char* kfb = lds + L_K0 + hi * KCS + r32 * 16 + ((TYPE == 1) ? mp * 4 * KCS : 0);
    const LAS unsigned char* btb = lds + L_BIAS + (256 + 4 * hi - r32 - qw) * 4 + ((TYPE == 1) ? 2 * h + mp : 8 + h) * 1280;
    u32x4 kr0, kr1, vr;
    const bf16_t* kp0 = kg0; const bf16_t* kp1 = kg1; const bf16_t* vp0 = vg0;
    const size_t kstep = (size_t)64 * kpitch, vstep = (size_t)64 * vpitch;
#define FA_BIAS(S0, S1, t) do { if (TYPE != 0) { if (64 * (t) > qw - 154) { const LAS float* bt = (const LAS float*)(btb + (t) * 256); \
            _Pragma("unroll") for (int r = 0; r < 16; ++r) { S0[r] += bt[(r & 3) + 8 * (r >> 2)]; S1[r] += bt[32 + (r & 3) + 8 * (r >> 2)]; } } } } while (0)
#define FA_RESCALE(S0, S1, t) do { if (fast) break; \
        float rm; FA_ROWMAX(rm, S0, S1); \
        rm = xhalf_max(rm); \
        const bool first = ((t) == 0); \
        if (__any(first || rm > THR)) { \
            const float dl = first ? fmaxf(rm, -64.f) : fmaxf(rm, 0.f);     \
            mhat += dl; \
            _Pragma("unroll") for (int r = 0; r < 16; ++r) { S0[r] -= dl; S1[r] -= dl; } \
            if (!first) { const float f = __builtin_amdgcn_exp2f(-dl); lsum *= f; \
                if (hi == 0) wsf[r32] = f; \
                _Pragma("unroll") for (int r = 0; r < 16; ++r) { const float fr_ = wsf[crow(r, hi)]; o0[r] *= fr_; o1[r] *= fr_; } \
                asm volatile("" ::: "memory"); } \
        } } while (0)
#define FA_EXP(S0, S1) do { float sacc = 0.f; \
        _Pragma("unroll") for (int r = 0; r < 16; ++r) { \
            S0[r] = __builtin_amdgcn_exp2f(S0[r]); S1[r] = __builtin_amdgcn_exp2f(S1[r]); \
            sacc += S0[r] + S1[r]; } \
        lsum += sacc; \
        _Pragma("unroll") for (int i = 0; i < 4; ++i) { pw[0][i] = cvtpk(S0[2 * i], S0[2 * i + 1]); pw[1][i] = cvtpk(S0[8 + 2 * i], S0[8 + 2 * i + 1]); \
                                                       pw[2][i] = cvtpk(S1[2 * i], S1[2 * i + 1]); pw[3][i] = cvtpk(S1[8 + 2 * i], S1[8 + 2 * i + 1]); } } while (0)
#define FA_PV() do { \
        _Pragma("unroll") for (int ks = 0; ks < 4; ++ks) { const bf16x8 vfrag = (bf16x8){vlo_[ks][0], vlo_[ks][1], vlo_[ks][2], vlo_[ks][3], vhi_[ks][0], vhi_[ks][1], vhi_[ks][2], vhi_[ks][3]}; \
            o0 = __builtin_amdgcn_mfma_f32_32x32x16_bf16(__builtin_bit_cast(bf16x8, pw[ks]), vfrag, o0, 0, 0, 0); } \
        _Pragma("unroll") for (int i = 0; i < 4; ++i) { vlo_[i] = vtr(vb_ + (4 + i) * 1024); vhi_[i] = vtr(vb_ + (4 + i) * 1024 + 512); } \
        _Pragma("unroll") for (int ks = 0; ks < 4; ++ks) { const bf16x8 vfrag = (bf16x8){vlo_[ks][0], vlo_[ks][1], vlo_[ks][2], vlo_[ks][3], vhi_[ks][0], vhi_[ks][1], vhi_[ks][2], vhi_[ks][3]}; \
            o1 = __builtin_amdgcn_mfma_f32_32x32x16_bf16(__builtin_bit_cast(bf16x8, pw[ks]), vfrag, o1, 0, 0, 0); } } while (0)
#define FA_KLOAD(ks_off) do { const LAS unsigned char* kb_ = kfb + (ks_off); \
        _Pragma("unroll") for (int d0 = 0; d0 < NQF; ++d0) { ka_[d0][0] = *(const LAS bf16x8*)(kb_ + d0 * 2 * KCS); ka_[d0][1] = *(const LAS bf16x8*)(kb_ + d0 * 2 * KCS + 512); } } while (0)
#define FA_QKMFMA(N0, N1, tt, MW0, MW1) do { \
        if (TYPE == 2) { const unsigned w0_ = MW0 >> (4 * hi), w1_ = MW1 >> (4 * hi); const unsigned nm_ = __float_as_uint(-mhat); unsigned neg_ = 0xF149F2CAu; asm volatile("" : "+v"(neg_)); \
            _Pragma("unroll") for (int r = 0; r < 16; ++r) { const int pos_ = (r & 3) + 8 * (r >> 2); \
                const unsigned k0m = (unsigned)((int)(w0_ << (31 - pos_)) >> 31), k1m = (unsigned)((int)(w1_ << (31 - pos_)) >> 31); \
                N0[r] = __uint_as_float(__builtin_amdgcn_bitop3_b32(k0m, nm_, neg_, 0xCA)); N1[r] = __uint_as_float(__builtin_amdgcn_bitop3_b32(k1m, nm_, neg_, 0xCA)); } }     \
        else if (fast) { N0 = __builtin_amdgcn_mfma_f32_32x32x16_bf16(ka_[0][0], qf[0], f32x16{}, 0, 0, 0); N1 = __builtin_amdgcn_mfma_f32_32x32x16_bf16(ka_[0][1], qf[0], f32x16{}, 0, 0, 0); } \
        else { const float nm_ = -mhat; N0 = (f32x16){nm_, nm_, nm_, nm_, nm_, nm_, nm_, nm_, nm_, nm_, nm_, nm_, nm_, nm_, nm_, nm_}; N1 = N0; \
            N0 = __builtin_amdgcn_mfma_f32_32x32x16_bf16(ka_[0][0], qf[0], N0, 0, 0, 0); N1 = __builtin_amdgcn_mfma_f32_32x32x16_bf16(ka_[0][1], qf[0], N1, 0, 0, 0); } \
        _Pragma("unroll") for (int d0 = (TYPE == 2) ? 0 : 1; d0 < NQF; ++d0) { \
            N0 = __builtin_amdgcn_mfma_f32_32x32x16_bf16(ka_[d0][0], qf[d0], N0, 0, 0, 0); \
            N1 = __builtin_amdgcn_mfma_f32_32x32x16_bf16(ka_[d0][1], qf[d0], N1, 0, 0, 0); } } while (0)
#define FA_VLOAD(vs_off) const LAS unsigned char* vb_ = vfb + (vs_off); \
        _Pragma("unroll") for (int i = 0; i < 4; ++i) { vlo_[i] = vtr(vb_ + i * 1024); vhi_[i] = vtr(vb_ + i * 1024 + 512); }
#define FA_MASKW(t)
#define FA_STEP_U(C0, C1, N0, N1, t, vs_off, nks_off, MW0, MW1) do { \
        bf16x8 ka_[NQF][2]; s16x4 vlo_[4], vhi_[4]; u32x4 pw[4]; \
        FA_KLOAD(nks_off); FA_VLOAD(vs_off); FA_MASKW(t); \
        FA_BIAS(C0, C1, t); FA_RESCALE(C0, C1, t); \
        FA_QKMFMA(N0, N1, (t) + 1, MW0, MW1); FA_EXP(C0, C1); FA_PV(); } while (0)
#define FA_STEP_C(C0, C1, N0, N1, t, vs_off, nks_off, MW0, MW1) do { \
        if ((t) + 1 < NTw) { bf16x8 ka_[NQF][2]; FA_KLOAD(nks_off); FA_QKMFMA(N0, N1, (t) + 1, MW0, MW1); } \
        if ((t) < NTw) { s16x4 vlo_[4], vhi_[4]; u32x4 pw[4]; FA_VLOAD(vs_off); FA_MASKW(t); \
            FA_BIAS(C0, C1, t); \
            if (!fast) { float rm; FA_ROWMAX(rm, C0, C1); \
              rm = xhalf_max(rm); \
              const bool first = ((t) == 0); \
              if (__any(first || rm > THR)) { \
                const float dl = first ? fmaxf(rm, -64.f) : fmaxf(rm, 0.f);     \
                mhat += dl; \
                _Pragma("unroll") for (int r = 0; r < 16; ++r) { C0[r] -= dl; C1[r] -= dl; N0[r] -= dl; N1[r] -= dl; } \
                if (!first) { const float f = __builtin_amdgcn_exp2f(-dl); lsum *= f; \
                    if (hi == 0) wsf[r32] = f; \
                    _Pragma("unroll") for (int r = 0; r < 16; ++r) { const float fr_ = wsf[crow(r, hi)]; o0[r] *= fr_; o1[r] *= fr_; } \
                    asm volatile("" ::: "memory"); } } } \
            FA_EXP(C0, C1); FA_PV(); } } while (0)
#define FA_LOADKV(tk, tv) do { if (FA_UNC || (tk) < NT) { kr0 = *(const u32x4*)kp0; if (has_k1) kr1 = *(const u32x4*)kp1; kp0 += kstep; kp1 += kstep; } \
        if (FA_UNC || (tv) < NT) { vr = *(const u32x4*)vp0; vp0 += vstep; } } while (0)
#define FA_COMMIT(tk, kslot, tv, vslot) do { if (FA_UNC || (tk) < NT) { *(LAS u32x4*)(lds + L_K0 + (kslot) + kl0) = kr0; if (has_k1) *(LAS u32x4*)(lds + L_K0 + (kslot) + kl1) = kr1; } \
        if (FA_UNC || (tv) < NT) *(LAS u32x4*)(lds + L_V0 + (vslot) + vl0) = vr; } while (0)
#define FA_UNC 0
    {
        FA_LOADKV(0, 0);
        const u32x4 ka0 = kr0, ka1 = kr1, va = vr;
        FA_LOADKV(1, 1);
        const u32x4 kb0 = kr0, kb1 = kr1, vb = vr;
        FA_LOADKV(2, NT);
        __syncthreads();
        *(LAS u32x4*)(lds + L_K0 + kl0) = ka0; if (has_k1) *(LAS u32x4*)(lds + L_K0 + kl1) = ka1; *(LAS u32x4*)(lds + L_V0 + vl0) = va;
        *(LAS u32x4*)(lds + L_K0 + KBUF + kl0) = kb0; if (has_k1) *(LAS u32x4*)(lds + L_K0 + KBUF + kl1) = kb1; *(LAS u32x4*)(lds + L_V0 + 8192 + vl0) = vb;
        FA_COMMIT(2, 2 * KBUF, NT, 0);
        if (fast && mp == 0 && tid == 0) *(volatile LAS unsigned*)(lds + L_FLAG) = 0u;
    }
    __syncthreads();
    f32x16 sA0, sA1, sB0, sB1;
    unsigned mwA0 = 0u, mwA1 = 0u, mwB0 = 0u, mwB1 = 0u;
#define FA_MLOAD(W0, W1, tt) do { if (TYPE == 2 && (FA_UNC || (tt) < NT)) { W0 = mrow[2 * (tt)]; W1 = mrow[2 * (tt) + 1]; } } while (0)
    FA_MLOAD(mwA0, mwA1, 0); FA_MLOAD(mwB0, mwB1, 1);
    { bf16x8 ka_[NQF][2]; FA_KLOAD(0); FA_QKMFMA(sA0, sA1, 0, mwA0, mwA1); }
    __syncthreads();
#pragma unroll
    for (int r = 0; r < 16; ++r) { sB0[r] = 0.f; sB1[r] = 0.f; }
#define FA_KS(tt) ((((tt)) & 3) * KBUF)
#define FA_VS(tt) ((((tt)) & 3) * 8192)
    int t = 0;
#undef FA_UNC
#define FA_UNC 1
    for (; t < TM; t += 2) {
        FA_LOADKV(t + 3, t + 2); FA_MLOAD(mwA0, mwA1, t + 2);
        FA_STEP_U(sA0, sA1, sB0, sB1, t, FA_VS(t), FA_KS(t + 1), mwB0, mwB1);
        FA_COMMIT(t + 3, FA_KS(t + 3), t + 2, FA_VS(t + 2));
        FA_LOADKV(t + 4, t + 3); FA_MLOAD(mwB0, mwB1, t + 3);
        FA_STEP_U(sB0, sB1, sA0, sA1, t + 1, FA_VS(t + 1), FA_KS(t + 2), mwA0, mwA1);
        FA_COMMIT(t + 4, FA_KS(t + 4), t + 3, FA_VS(t + 3));
        __syncthreads();
    }
#undef FA_UNC
#define FA_UNC 0
    for (; t < NT; t += 2) {
        FA_LOADKV(t + 3, t + 2); FA_MLOAD(mwA0, mwA1, t + 2);
        FA_STEP_C(sA0, sA1, sB0, sB1, t, FA_VS(t), FA_KS(t + 1), mwB0, mwB1);
        FA_COMMIT(t + 3, FA_KS(t + 3), t + 2, FA_VS(t + 2));
        FA_LOADKV(t + 4, t + 3); FA_MLOAD(mwB0, mwB1, t + 3);
        FA_STEP_C(sB0, sB1, sA0, sA1, t + 1, FA_VS(t + 1), FA_KS(t + 2), mwA0, mwA1);
        FA_COMMIT(t + 4, FA_KS(t + 4), t + 3, FA_VS(t + 3));
        __syncthreads();
    }
#undef FA_KS
#undef FA_UNC
#undef FA_MLOAD
#undef FA_VS
#undef FA_BIAS
#undef FA_RESCALE
#undef FA_EXP
#undef FA_PV
#undef FA_KLOAD
#undef FA_QKMFMA
#undef FA_VLOAD
#undef FA_MASKW
#undef FA_STEP_U
#undef FA_STEP_C
#undef FA_LOADKV
#undef FA_COMMIT
    {
        const float lt = xhalf_sum(lsum);
        if (fast) { if (!(lt >= 0x1p-90f && lt <= 0x1p90f)) *(volatile LAS unsigned*)(lds + L_FLAG) = 1u; }
        if (hi == 0) wsf[32 + r32] = __builtin_amdgcn_rcpf(lt);
#pragma unroll
        for (int r = 0; r < 16; ++r) { const float iv = wsf[32 + crow(r, hi)]; o0[r] *= iv; o1[r] *= iv; }
        asm volatile("" ::: "memory");
    }
    if (TYPE == 1 && mp == 0) {
#pragma unroll
        for (int r = 0; r < 16; ++r) { okl[r * 64] = o0[r]; okl[(16 + r) * 64] = o1[r]; }
    }
    }
    if (!fast) break;
    __syncthreads();
    if (__builtin_amdgcn_readfirstlane(*(volatile LAS unsigned*)(lds + L_FLAG)) == 0u) break;
    fast = 0;
    }
    const int gcol = (TYPE == 0) ? CA_G : (TYPE == 1) ? CB_G : CC_G;
    bf16_t* Y = (bf16_t*)(ws + WS_Y);
    float gs0[16], gs1[16];
    {
        bf16_t gr0[16], gr1[16];
#pragma unroll
        for (int r = 0; r < 16; ++r) { const bf16_t* gp = P + (row0 + qw + crow(r, hi)) * PC + gcol + h * 64; gr0[r] = gp[r32]; gr1[r] = gp[32 + r32]; }
#pragma unroll
        for (int r = 0; r < 16; ++r) { const float a0 = bf2f(gr0[r]), a1 = bf2f(gr1[r]);
            gs0[r] = a0 * __builtin_amdgcn_rcpf(1.f + __expf(-a0)); gs1[r] = a1 * __builtin_amdgcn_rcpf(1.f + __expf(-a1)); }
    }
    if (TYPE == 1) {
        const float* lamp = A->dlam + layer * 128;
        float s1 = 0.f, s2 = 0.f;
        for (int i = 0; i < 32; ++i) { s1 += lamp[i] * lamp[32 + i]; s2 += lamp[64 + i] * lamp[96 + i]; }
        const float lambda_init = A->lambda_init[layer];
        const float lam = __expf(s1) - __expf(s2) + lambda_init;
        const float g0 = A->subg[layer * 64 + r32], g1 = A->subg[layer * 64 + 32 + r32];
#pragma unroll
        for (int r = 0; r < 16; ++r) {
            const float v0 = okl[r * 64] - lam * o0[r];
            const float v1 = okl[(16 + r) * 64] - lam * o1[r];
            float ss = v0 * v0 + v1 * v1;
#pragma unroll
            for (int off = 1; off < 32; off <<= 1) ss += __shfl_xor(ss, off);
            const float rr = rsqrtf(ss * (1.f / 64.f) + EPS) * (1.f - lambda_init);
            bf16_t* yp = Y + (row0 + qw + crow(r, hi)) * D + 256 + h * 64;
            yp[r32] = f2bf(v0 * rr * g0 * gs0[r]);
            yp[32 + r32] = f2bf(v1 * rr * g1 * gs1[r]);
        }
    } else {
#pragma unroll
        for (int r = 0; r < 16; ++r) {
            bf16_t* yp = Y + (row0 + qw + crow(r, hi)) * D + TYPE * 256 + h * 64;
            yp[r32] = f2bf(o0[r] * gs0[r]);
            yp[32 + r32] = f2bf(o1[r] * gs1[r]);
        }
    }
}
__device__ __forceinline__ void attn_unit_diff(LAS unsigned char* lds, int b, int h, int qb, int layer) {
    ArgsP A = get_args();
    unsigned char* ws = A->ws;
    const bf16_t* P = (const bf16_t*)(ws + WS_P);
    const int tid = opaque_tid(), lane = tid & 63, r32 = lane & 31, hi = lane >> 5, wid = __builtin_amdgcn_readfirstlane(tid >> 6);
    const size_t row0 = (size_t)b * S;
    const int skey = tid >> 3, sch = tid & 7;
    const bf16_t* kg0 = P + (row0 + skey) * PC + CB_K + h * 64 + sch * 8;
    const bf16_t* vg0 = P + (row0 + skey) * PC + CB_V + h * 64 + sch * 8;
    const int kl0 = sch * KCS + skey * 16;
    const int vl0 = ((sch >> 2) * 4 + (skey >> 4)) * 1024 + (skey & 15) * 64 + (sch & 3) * 16;
    const int qw = qb * 256 + wid * 32;
    const size_t tq = row0 + qw + r32;
    const int NT = 4 * qb + 4, NTw = 4 * qb + (wid >> 1) + 1, TM = 4 * qb;
    LAS float* wsf = (LAS float*)(lds + L_WSF) + wid * 64;
    const LAS unsigned char* vfb = lds + L_V0 + ((lane >> 4) & 1) * 32 + (lane & 3) * 8 + (4 * hi + ((lane & 15) >> 2)) * 64;
    const LAS unsigned char* kfA = lds + L_K0 + hi * KCS + r32 * 16;
    const LAS unsigned char* kfB = kfA + 4 * KCS;
    const LAS unsigned char* btA = lds + L_BIAS + (256 + 4 * hi - r32 - qw) * 4 + (2 * h) * 1280;
    const LAS unsigned char* btB = btA + 1280;
    bf16x8 qA[2], qB[2];
#pragma unroll
    for (int d0 = 0; d0 < 2; ++d0) { qA[d0] = *(const bf16x8*)(P + tq * PC + CB_Q + h * 64 + 16 * d0 + 8 * hi); qB[d0] = *(const bf16x8*)(P + tq * PC + CB_Q + 32 + h * 64 + 16 * d0 + 8 * hi); }
    f32x16 oA0, oA1, oB0, oB1;
    float mA, mB, lA, lB;
    const size_t tstep = (size_t)64 * PC;
    int fast = 1; asm volatile("" : "+s"(fast));
#define DF_KS(tt) ((((tt)) & 3) * KBUF)
#define DF_VS(tt) ((((tt)) & 3) * 8192)
#define DF_QK(N0, N1, KF, ks_off, QF, MH) do { const LAS unsigned char* kb_ = (KF) + (ks_off); \
        const bf16x8 k00 = *(const LAS bf16x8*)kb_, k01 = *(const LAS bf16x8*)(kb_ + 512), k10 = *(const LAS bf16x8*)(kb_ + 2 * KCS), k11 = *(const LAS bf16x8*)(kb_ + 2 * KCS + 512); \
        if (fast) { N0 = __builtin_amdgcn_mfma_f32_32x32x16_bf16(k00, QF[0], f32x16{}, 0, 0, 0); N1 = __builtin_amdgcn_mfma_f32_32x32x16_bf16(k01, QF[0], f32x16{}, 0, 0, 0); } \
        else { const float nm_ = -(MH); N0 = (f32x16){nm_, nm_, nm_, nm_, nm_, nm_, nm_, nm_, nm_, nm_, nm_, nm_, nm_, nm_, nm_, nm_}; N1 = N0; \
            N0 = __builtin_amdgcn_mfma_f32_32x32x16_bf16(k00, QF[0], N0, 0, 0, 0); N1 = __builtin_amdgcn_mfma_f32_32x32x16_bf16(k01, QF[0], N1, 0, 0, 0); } \
        N0 = __builtin_amdgcn_mfma_f32_32x32x16_bf16(k10, QF[1], N0, 0, 0, 0); N1 = __builtin_amdgcn_mfma_f32_32x32x16_bf16(k11, QF[1], N1, 0, 0, 0); } while (0)
#define DF_SOFTMAX(S0, S1, O0, O1, MH, LS, BT, WOFF, t, PW) do { \
        if (64 * (t) > qw - 154) { const LAS float* bt = (const LAS float*)((BT) + (t) * 256); \
            _Pragma("unroll") for (int r = 0; r < 16; ++r) { S0[r] += bt[(r & 3) + 8 * (r >> 2)]; S1[r] += bt[32 + (r & 3) + 8 * (r >> 2)]; } } \
        if (!fast) { float rm; FA_ROWMAX(rm, S0, S1); rm = xhalf_max(rm); const bool first = ((t) == 0); \
            if (__any(first || rm > THR)) { const float dl = first ? fmaxf(rm, -64.f) : fmaxf(rm, 0.f); MH += dl; \
                _Pragma("unroll") for (int r = 0; r < 16; ++r) { S0[r] -= dl; S1[r] -= dl; } \
                if (!first) { const float f = __builtin_amdgcn_exp2f(-dl); LS *= f; if (hi == 0) wsf[(WOFF) + r32] = f; \
                    _Pragma("unroll") for (int r = 0; r < 16; ++r) { const float fr_ = wsf[(WOFF) + crow(r, hi)]; O0[r] *= fr_; O1[r] *= fr_; } \
                    asm volatile("" ::: "memory"); } } } \
        { float sacc = 0.f; \
          _Pragma("unroll") for (int r = 0; r < 16; ++r) { S0[r] = __builtin_amdgcn_exp2f(S0[r]); S1[r] = __builtin_amdgcn_exp2f(S1[r]); sacc += S0[r] + S1[r]; } \
          LS += sacc; } \
        _Pragma("unroll") for (int i = 0; i < 4; ++i) { PW[0][i] = cvtpk(S0[2 * i], S0[2 * i + 1]); PW[1][i] = cvtpk(S0[8 + 2 * i], S0[8 + 2 * i + 1]); \
                                                       PW[2][i] = cvtpk(S1[2 * i], S1[2 * i + 1]); PW[3][i] = cvtpk(S1[8 + 2 * i], S1[8 + 2 * i + 1]); } } while (0)
#define DF_VLOAD(vs_off, G0) do { const LAS unsigned char* vb_ = vfb + (vs_off); \
        _Pragma("unroll") for (int i = 0; i < 4; ++i) { vlo_[i] = vtr(vb_ + ((G0) + i) * 1024); vhi_[i] = vtr(vb_ + ((G0) + i) * 1024 + 512); } } while (0)
#define DF_PV(O0, O1, PW, vs_off) do { \
        DF_VLOAD(vs_off, 0); \
        _Pragma("unroll") for (int ks = 0; ks < 4; ++ks) { const bf16x8 vf = (bf16x8){vlo_[ks][0], vlo_[ks][1], vlo_[ks][2], vlo_[ks][3], vhi_[ks][0], vhi_[ks][1], vhi_[ks][2], vhi_[ks][3]}; \
            O0 = __builtin_amdgcn_mfma_f32_32x32x16_bf16(__builtin_bit_cast(bf16x8, PW[ks]), vf, O0, 0, 0, 0); } \
        DF_VLOAD(vs_off, 4); \
        _Pragma("unroll") for (int ks = 0; ks < 4; ++ks) { const bf16x8 vf = (bf16x8){vlo_[ks][0], vlo_[ks][1], vlo_[ks][2], vlo_[ks][3], vhi_[ks][0], vhi_[ks][1], vhi_[ks][2], vhi_[ks][3]}; \
            O1 = __builtin_amdgcn_mfma_f32_32x32x16_bf16(__builtin_bit_cast(bf16x8, PW[ks]), vf, O1, 0, 0, 0); } } while (0)
#define DF_STEP(COND, t) do { \
        if (!(COND) || (t) + 2 < NT) { kr = *(const u32x4*)kp; kp += tstep; } \
        if (!(COND) || (t) + 1 < NT) { vr = *(const u32x4*)vp; vp += tstep; } \
        if (!(COND) || (t) < NTw) { s16x4 vlo_[4], vhi_[4]; u32x4 pw[4]; \
            DF_QK(sB0, sB1, kfB, DF_KS(t), qB, mB); \
            DF_SOFTMAX(sA0, sA1, oA0, oA1, mA, lA, btA, 0, t, pw); \
            DF_PV(oA0, oA1, pw, DF_VS(t)); \
            DF_SOFTMAX(sB0, sB1, oB0, oB1, mB, lB, btB, 32, t, pw); \
            if (!(COND) || (t) + 1 < NTw) DF_QK(sA0, sA1, kfA, DF_KS((t) + 1), qA, mA); \
            DF_PV(oB0, oB1, pw, DF_VS(t)); } \
        if (!(COND) || (t) + 2 < NT) *(LAS u32x4*)(lds + L_K0 + DF_KS((t) + 2) + kl0) = kr; \
        if (!(COND) || (t) + 1 < NT) *(LAS u32x4*)(lds + L_V0 + DF_VS((t) + 1) + vl0) = vr; \
        __syncthreads(); } while (0)
#pragma unroll 1
    for (;;) {
        mA = 0.f; mB = 0.f; lA = 0.f; lB = 0.f; oA0 = f32x16{}; oA1 = f32x16{}; oB0 = f32x16{}; oB1 = f32x16{};
        const bf16_t* kp = kg0; const bf16_t* vp = vg0;
        u32x4 kr, vr;
        {
            const u32x4 ka = *(const u32x4*)kp; kp += tstep; const u32x4 va = *(const u32x4*)vp; vp += tstep; const u32x4 kb = *(const u32x4*)kp; kp += tstep;
            __syncthreads();
            *(LAS u32x4*)(lds + L_K0 + kl0) = ka; *(LAS u32x4*)(lds + L_V0 + vl0) = va; *(LAS u32x4*)(lds + L_K0 + KBUF + kl0) = kb;
            if (fast && tid == 0) *(volatile LAS unsigned*)(lds + L_FLAG) = 0u;
        }
        __syncthreads();
        f32x16 sA0, sA1, sB0, sB1;
        DF_QK(sA0, sA1, kfA, 0, qA, mA);
#pragma unroll
        for (int r = 0; r < 16; ++r) { sB0[r] = 0.f; sB1[r] = 0.f; }
        int t = 0;
        _Pragma("unroll 1") for (; t < TM; ++t) { DF_STEP(false, t); }
        _Pragma("unroll 1") for (; t < NT; ++t) { DF_STEP(true, t); }
        {
            const float ltA = xhalf_sum(lA), ltB = xhalf_sum(lB);
            if (fast) { if (!(ltA >= 0x1p-90f && ltA <= 0x1p90f && ltB >= 0x1p-90f && ltB <= 0x1p90f)) *(volatile LAS unsigned*)(lds + L_FLAG) = 1u; }
            if (hi == 0) { wsf[r32] = __builtin_amdgcn_rcpf(ltA); wsf[32 + r32] = __builtin_amdgcn_rcpf(ltB); }
#pragma unroll
            for (int r = 0; r < 16; ++r) { const float ia = wsf[crow(r, hi)], ib = wsf[32 + crow(r, hi)]; oA0[r] *= ia; oA1[r] *= ia; oB0[r] *= ib; oB1[r] *= ib; }
            asm volatile("" ::: "memory");
        }
        if (!fast) break;
        __syncthreads();
        if (__builtin_amdgcn_readfirstlane(*(volatile LAS unsigned*)(lds + L_FLAG)) == 0u) break;
        fast = 0;
    }
#undef DF_STEP
#undef DF_PV
#undef DF_VLOAD
#undef DF_SOFTMAX
#undef DF_QK
#undef DF_KS
#undef DF_VS
    bf16_t* Y = (bf16_t*)(ws + WS_Y);
    float gs0[16], gs1[16];
    {
        bf16_t gr0[16], gr1[16];
#pragma unroll
        for (int r = 0; r < 16; ++r) { const bf16_t* gp = P + (row0 + qw + crow(r, hi)) * PC + CB_G + h * 64; gr0[r] = gp[r32]; gr1[r] = gp[32 + r32]; }
#pragma unroll
        for (int r = 0; r < 16; ++r) { const float a0 = bf2f(gr0[r]), a1 = bf2f(gr1[r]);
            gs0[r] = a0 * __builtin_amdgcn_rcpf(1.f + __expf(-a0)); gs1[r] = a1 * __builtin_amdgcn_rcpf(1.f + __expf(-a1)); }
    }
    {
        const float* lamp = A->dlam + layer * 128;
        float s1 = 0.f, s2 = 0.f;
        for (int i = 0; i < 32; ++i) { s1 += lamp[i] * lamp[32 + i]; s2 += lamp[64 + i] * lamp[96 + i]; }
        const float lambda_init = A->lambda_init[layer];
        const float lam = __expf(s1) - __expf(s2) + lambda_init;
        const float g0 = A->subg[layer * 64 + r32], g1 = A->subg[layer * 64 + 32 + r32];
#pragma unroll
        for (int r = 0; r < 16; ++r) {
            const float v0 = oA0[r] - lam * oB0[r];
            const float v1 = oA1[r] - lam * oB1[r];
            float ss = v0 * v0 + v1 * v1;
#pragma unroll
            for (int off = 1; off < 32; off <<= 1) ss += __shfl_xor(ss, off);
            const float rr = rsqrtf(ss * (1.f / 64.f) + EPS) * (1.f - lambda_init);
            bf16_t* yp = Y + (row0 + qw + crow(r, hi)) * D + 256 + h * 64;
            yp[r32] = f2bf(v0 * rr * g0 * gs0[r]);
            yp[32 + r32] = f2bf(v1 * rr * g1 * gs1[r]);
        }
    }
}
}

namespace sel {
__device__ __forceinline__ float relu_s(float x) { const int i = __builtin_bit_cast(int, x); return __builtin_bit_cast(float, i > 0 ? i : 0); }
}

namespace sel2 {
typedef float f32x16 __attribute__((ext_vector_type(16)));
typedef short s16x2 __attribute__((ext_vector_type(2)));
typedef unsigned short u16x2 __attribute__((ext_vector_type(2)));
__device__ __forceinline__ unsigned pk_lt(unsigned v, unsigned c) {
    const s16x2 d = __builtin_elementwise_sub_sat(__builtin_bit_cast(s16x2, v), __builtin_bit_cast(s16x2, c));
    return __builtin_bit_cast(unsigned, __builtin_bit_cast(u16x2, d) >> 15);
}
__device__ __forceinline__ unsigned pk_add(unsigned a, unsigned b) { return __builtin_bit_cast(unsigned, __builtin_bit_cast(u16x2, a) + __builtin_bit_cast(u16x2, b)); }
__device__ __forceinline__ unsigned half_sum(unsigned x) {
    x = pk_add(x, (unsigned)__builtin_amdgcn_update_dpp(0, (int)x, 0xB1, 0xf, 0xf, false));
    x = pk_add(x, (unsigned)__builtin_amdgcn_update_dpp(0, (int)x, 0x4E, 0xf, 0xf, false));
    x = pk_add(x, (unsigned)__builtin_amdgcn_update_dpp(0, (int)x, 0x141, 0xf, 0xf, false));
    x = pk_add(x, (unsigned)__builtin_amdgcn_update_dpp(0, (int)x, 0x140, 0xf, 0xf, false));
    x = pk_add(x, (unsigned)__builtin_amdgcn_ds_swizzle((int)x, 0x401F));
    return x;
}
__device__ __forceinline__ float mul_s(float a, float b) { float d; asm("v_mul_f32_e32 %0, %1, %2" : "=v"(d) : "v"(a), "v"(b)); return d; }
__device__ __forceinline__ float fma_s(float a, float b, float c) { float d; asm("v_fma_f32 %0, %1, %2, %3" : "=v"(d) : "v"(a), "v"(b), "v"(c)); return d; }
__device__ __forceinline__ void select_unit(LAS unsigned char* lds, int b, int c, int half) {
    ArgsP A = get_args();
    unsigned char* ws = A->ws;
    const bf16_t* P = (const bf16_t*)(ws + WS_P);
    unsigned* MASK = (unsigned*)(ws + WS_MASK);
    const int tid = opaque_tid(), lane = tid & 63, r32 = lane & 31, hi = lane >> 5; const int wid = __builtin_amdgcn_readfirstlane(tid >> 6);
    const int ni = c + 1, nb = 2 * ni;
    const size_t tq0 = (size_t)b * S + 64 * c + 32 * half + 4 * wid;
    if (c <= 3) {
        for (int e = lane; e < 4 * nb; e += 64) MASK[(tq0 + e / nb) * 128 + e % nb] = 0xffffffffu;
        return;
    }
    int nkeys_v = 64 * ni; asm volatile("" : "+v"(nkeys_v));
    unsigned vals[64];
    LAS unsigned* ldsv = (LAS unsigned*)lds + wid * 4096 + lane;
#define SVAL(blk) (((blk) < 64) ? vals[(blk) & 63] : ldsv[(((blk) - 64) & 63) * 64])
    {
        const int ql = 2 * ((r32 >> 2) & 1) + (r32 >> 4), hh = ((r32 >> 3) & 1) * 4 + (r32 & 3);
        const bf16x8 af0 = *(const bf16x8*)(P + (tq0 + ql) * PC + CC_QI + hh * 32 + 8 * hi), af1 = *(const bf16x8*)(P + (tq0 + ql) * PC + CC_QI + hh * 32 + 16 + 8 * hi);
        const float idx_scale = 0.35355339059327373f * 0.17677669529663687f * 0.125f;
        float wv[16];
#pragma unroll
        for (int qh = 0; qh < 2; ++qh) { const u16x8 w8 = *(const u16x8*)(P + (tq0 + 2 * hi + qh) * PC + CC_WI);
#pragma unroll
            for (int e = 0; e < 8; ++e) wv[8 * qh + e] = bf2f(w8[e]) * idx_scale; }
        const bf16_t* kgl = P + ((size_t)b * S) * PC + CC_KI;
        LAS unsigned char* kch = lds + 131072;
        const int sk0 = tid >> 2, sq = tid & 3;
        const bf16_t* sg = kgl + (size_t)sk0 * PC + sq * 8;
        const int sl0 = sk0 * 64 + ((sq ^ ((sk0 >> 2) & 3)) * 16), sl1 = sl0 + 128 * 64;
        const int sw = (r32 >> 2) & 3;
        const LAS unsigned char* rd0 = kch + r32 * 64 + ((hi ^ sw) * 16);
        const LAS unsigned char* rd1 = kch + r32 * 64 + (((2 + hi) ^ sw) * 16);
        bf16x8 afc[2][2] = {{af0, af1}, {af0, af1}};
        u32x4 st0 = *(const u32x4*)sg, st1 = *(const u32x4*)(sg + (size_t)128 * PC);
        const int ngc = 2 * ((nb + 15) >> 4);
#define SEL_BAR() do { asm volatile("s_waitcnt lgkmcnt(0)" ::: "memory"); __builtin_amdgcn_s_barrier(); asm volatile("" ::: "memory"); } while (0)
#pragma unroll
        for (int g = 0; g < 16; ++g) if (g < ngc) {
            SEL_BAR();
            *(LAS u32x4*)(kch + sl0) = st0; *(LAS u32x4*)(kch + sl1) = st1;
            SEL_BAR();
            if (g + 1 < ngc) { st0 = *(const u32x4*)(sg + (size_t)(256 * (g + 1)) * PC); st1 = *(const u32x4*)(sg + (size_t)(256 * (g + 1) + 128) * PC); }
            bf16x8 pb[2][2];
            pb[0][0] = *(const LAS bf16x8*)rd0; pb[0][1] = *(const LAS bf16x8*)rd1;
#pragma unroll
            for (int jb = 0; jb < 8; ++jb) { const int blk = 8 * g + jb;
                if (jb + 1 < 8) { pb[(jb + 1) & 1][0] = *(const LAS bf16x8*)(rd0 + (jb + 1) * 2048); pb[(jb + 1) & 1][1] = *(const LAS bf16x8*)(rd1 + (jb + 1) * 2048); }
                f32x16 acc = f32x16{};
                acc = __builtin_amdgcn_mfma_f32_32x32x16_bf16(afc[blk & 1][0], pb[jb & 1][0], acc, 0, 0, 0);
                acc = __builtin_amdgcn_mfma_f32_32x32x16_bf16(afc[blk & 1][1], pb[jb & 1][1], acc, 0, 0, 0);
                float pr_[16];
#pragma unroll
                for (int r = 0; r < 16; ++r) pr_[r] = sel::relu_s(acc[r]);
                float v0 = mul_s(wv[0], pr_[0]), v1 = mul_s(wv[8], pr_[8]);
#pragma unroll
                for (int e = 1; e < 8; ++e) { v0 = fma_s(wv[e], pr_[e], v0); v1 = fma_s(wv[8 + e], pr_[8 + e], v1); }
                unsigned sv_ = __builtin_bit_cast(unsigned, __builtin_amdgcn_cvt_pknorm_i16(v0, v1));
                sv_ = (32 * blk + r32 < nkeys_v) ? sv_ : 0x80008000u;
                asm volatile("" : "+v"(afc[blk & 1][0]) : "v"(sv_));
                if (blk < 64) vals[blk & 63] = sv_; else ldsv[((blk - 64) & 63) * 64] = sv_;
            }
        }
        SEL_BAR();
#undef SEL_BAR
    }
    const int ng16 = (nb + 15) >> 4;
    const unsigned total = (unsigned)ng16 * 512u;
#define SEL2_COUNT_LT(res, c2) do { unsigned a0_ = 0u, a1_ = 0u, a2_ = 0u, a3_ = 0u; \
        _Pragma("unroll") for (int g = 0; g < 8; ++g) if (g < ng16) { \
            unsigned sv_[16]; _Pragma("unroll") for (int j = 0; j < 16; ++j) sv_[j] = SVAL(16 * g + j); \
            __builtin_amdgcn_sched_barrier(0); \
            s16x2 dd_[16]; _Pragma("unroll") for (int j = 0; j < 16; ++j) dd_[j] = __builtin_elementwise_sub_sat(__builtin_bit_cast(s16x2, sv_[j]), __builtin_bit_cast(s16x2, (unsigned)(c2))); \
            __builtin_amdgcn_sched_barrier(0); \
            u16x2 ss_[16]; _Pragma("unroll") for (int j = 0; j < 16; ++j) ss_[j] = __builtin_bit_cast(u16x2, dd_[j]) >> 15; \
            __builtin_amdgcn_sched_barrier(0); \
            _Pragma("unroll") for (int j = 0; j < 8; ++j) ss_[j] += ss_[j + 8]; \
            __builtin_amdgcn_sched_barrier(0); \
            _Pragma("unroll") for (int j = 0; j < 4; ++j) ss_[j] += ss_[j + 4]; \
            __builtin_amdgcn_sched_barrier(0); \
            a0_ = pk_add(a0_, __builtin_bit_cast(unsigned, ss_[0])); a1_ = pk_add(a1_, __builtin_bit_cast(unsigned, ss_[1])); a2_ = pk_add(a2_, __builtin_bit_cast(unsigned, ss_[2])); a3_ = pk_add(a3_, __builtin_bit_cast(unsigned, ss_[3])); \
            __builtin_amdgcn_sched_barrier(0); } \
        res = half_sum(pk_add(pk_add(a0_, a1_), pk_add(a2_, a3_))); } while (0)
    unsigned Tu2 = 0u;
    unsigned cge_lo = total, cge_hi = total;
#pragma unroll 1
    for (int bit = 15; bit >= 0; --bit) {
        const unsigned cand2 = Tu2 | ((1u << bit) * 0x10001u);
        unsigned clt; SEL2_COUNT_LT(clt, cand2 ^ 0x80008000u);
        const unsigned g_lo = total - (clt & 0xffffu), g_hi = total - (clt >> 16);
        if (g_lo >= 256u) { Tu2 = (Tu2 & 0xffff0000u) | (cand2 & 0x0000ffffu); cge_lo = g_lo; }
        if (g_hi >= 256u) { Tu2 = (Tu2 & 0x0000ffffu) | (cand2 & 0xffff0000u); cge_hi = g_hi; }
        if (__all((cge_lo == 256u) && (cge_hi == 256u))) break;
    }
    const unsigned Ts2 = Tu2 ^ 0x80008000u;
    const bool anytie = __any((cge_lo != 256u) || (cge_hi != 256u));
    LAS unsigned* m0 = (LAS unsigned*)(lds + 131072) + wid * 512; LAS unsigned* m1 = m0 + 128; LAS unsigned* m2 = m0 + 256; LAS unsigned* m3 = m0 + 384;
    if (!anytie) {
#pragma unroll
        for (int g = 0; g < 8; ++g) if (g < ng16)
#pragma unroll
        for (int jb = 0; jb < 16; ++jb) { const int blk = 16 * g + jb;
            const unsigned d = __builtin_bit_cast(unsigned, __builtin_elementwise_sub_sat(__builtin_bit_cast(s16x2, SVAL(blk)), __builtin_bit_cast(s16x2, Ts2)));
            const unsigned long long bl = __ballot((d & 0x8000u) == 0u), bh = __ballot((int)d >= 0);
            if (lane == 0) { m0[blk] = (unsigned)bl; m2[blk] = (unsigned)(bl >> 32); m1[blk] = (unsigned)bh; m3[blk] = (unsigned)(bh >> 32); }
        }
    } else {
        const s16x2 tp1 = __builtin_elementwise_add_sat(__builtin_bit_cast(s16x2, Ts2), (s16x2){1, 1});
        unsigned clt_u; SEL2_COUNT_LT(clt_u, __builtin_bit_cast(unsigned, tp1));
        const int cgt_lo = ((Ts2 & 0xffffu) == 0x7fffu) ? 0 : (int)(total - (clt_u & 0xffffu)), cgt_hi = ((Ts2 >> 16) == 0x7fffu) ? 0 : (int)(total - (clt_u >> 16));
        const int need_lo = 256 - cgt_lo, need_hi = 256 - cgt_hi;
        int taken_lo = 0, taken_hi = 0;
#pragma unroll
        for (int g = 0; g < 8; ++g) if (g < ng16)
#pragma unroll
        for (int jb = 0; jb < 16; ++jb) { const int blk = 16 * g + jb;
            const unsigned d = __builtin_bit_cast(unsigned, __builtin_elementwise_sub_sat(__builtin_bit_cast(s16x2, SVAL(blk)), __builtin_bit_cast(s16x2, Ts2)));
            const bool eq_lo = ((d & 0xffffu) == 0u), eq_hi = ((d >> 16) == 0u);
            const bool gt_lo = !eq_lo && ((d & 0x8000u) == 0u), gt_hi = !eq_hi && ((int)d >= 0);
            const unsigned long long el = __ballot(eq_lo), eh = __ballot(eq_hi);
            const int cl0 = __popc((unsigned)el), cl1 = __popc((unsigned)(el >> 32)), ch0 = __popc((unsigned)eh), ch1 = __popc((unsigned)(eh >> 32));
            const int pre_lo = (int)__builtin_amdgcn_mbcnt_hi((unsigned)(el >> 32), __builtin_amdgcn_mbcnt_lo((unsigned)el, 0u)) - (hi ? cl0 : 0);
            const int pre_hi = (int)__builtin_amdgcn_mbcnt_hi((unsigned)(eh >> 32), __builtin_amdgcn_mbcnt_lo((unsigned)eh, 0u)) - (hi ? ch0 : 0);
            const bool s_lo = gt_lo || (eq_lo && (taken_lo + pre_lo) < need_lo), s_hi = gt_hi || (eq_hi && (taken_hi + pre_hi) < need_hi);
            taken_lo += hi ? cl1 : cl0; taken_hi += hi ? ch1 : ch0;
            const unsigned long long bl = __ballot(s_lo), bh = __ballot(s_hi);
            if (lane == 0) { m0[blk] = (unsigned)bl; m2[blk] = (unsigned)(bl >> 32); m1[blk] = (unsigned)bh; m3[blk] = (unsigned)(bh >> 32); }
        }
    }
    asm volatile("s_waitcnt lgkmcnt(0)" ::: "memory");
#pragma unroll
    for (int q = 0; q < 4; ++q)
#pragma unroll
        for (int hf = 0; hf < 2; ++hf) { const int bw = lane + 64 * hf; if (bw < nb) MASK[(tq0 + q) * 128 + bw] = m0[q * 128 + bw]; }
#undef SEL2_COUNT_LT
#undef SVAL
}
}

namespace mp {
constexpr int AQ_STRIDE = 528, AKV_STRIDE = 272, L_AQ = 0, L_AKV = 128 * AQ_STRIDE;
constexpr int L_RK = L_AKV + 128 * AKV_STRIDE;
constexpr int ST_STRIDE = 208, L_ST = L_RK + 128 * 64;
__device__ __forceinline__ void stage4(LAS unsigned char* p, const f32x4 v) { u32x2 w; w.x = pg8::cvt_pk_bf16(v[0], v[1]); w.y = pg8::cvt_pk_bf16(v[2], v[3]); *(LAS u32x2*)p = w; }
__device__ __forceinline__ void store4(bf16_t* p, const f32x4 v) { uint2 w; w.x = pg8::cvt_pk_bf16(v[0], v[1]); w.y = pg8::cvt_pk_bf16(v[2], v[3]); *(uint2*)p = w; }
template <int CTRL> __device__ __forceinline__ float dppf(float v) { return __builtin_bit_cast(float, __builtin_amdgcn_update_dpp(0, __builtin_bit_cast(int, v), CTRL, 0xf, 0xf, false)); }
__device__ __forceinline__ float wave_sum64(float v) {
    v += dppf<0xB1>(v); v += dppf<0x4E>(v); v += dppf<0x141>(v); v += dppf<0x140>(v);
    v += __builtin_bit_cast(float, __builtin_amdgcn_ds_swizzle(__builtin_bit_cast(int, v), 0x401F));
    return fa::xhalf_sum(v);
}
__device__ __forceinline__ void mla_prep_unit(LAS unsigned char* lds, int tile, int l) {
    ArgsP A = get_args();
    unsigned char* ws = A->ws;
    const bf16_t* P = (const bf16_t*)(ws + WS_P);
    const float* ROPE = (const float*)(ws + WS_ROPE);
    bf16_t* QA = (bf16_t*)(ws + WS_QA); bf16_t* KA = (bf16_t*)(ws + WS_KA); bf16_t* VA = (bf16_t*)(ws + WS_VA);
    const int tid = opaque_tid(), lane = tid & 63, fr = lane & 15, fq = lane >> 4, wid = __builtin_amdgcn_readfirstlane(tid >> 6);
    const size_t t0 = (size_t)tile * 128;
    const int h = wid >> 1, half = wid & 1;
    bf16x8 wq[8][3];
    {
        const bf16_t* W = (const bf16_t*)(ws + WS_WTUQ) + (size_t)l * 384 * 256 + (size_t)(48 * wid + fr) * 256 + 8 * fq;
#pragma unroll
        for (int ks = 0; ks < 8; ++ks)
#pragma unroll
            for (int nf = 0; nf < 3; ++nf) wq[ks][nf] = *(const bf16x8*)(W + (size_t)(16 * nf) * 256 + 32 * ks);
    }
    __syncthreads();
    {
        const float* qg = A->qa_g + l * 256; const float* kg = A->kva_g + l * 128;
        float gq[4], gk[4];
#pragma unroll
        for (int j = 0; j < 4; ++j) { gq[j] = qg[4 * lane + j]; gk[j] = kg[(4 * lane + j) & 127]; }
#pragma unroll 1
        for (int bt = 0; bt < 4; ++bt) {
            uint2 cq[4], ck[4]; bf16_t kr1[4], kr2[4]; float rcs[4], rsn[4];
#pragma unroll
            for (int i = 0; i < 4; ++i) {
                const int row = 16 * wid + 4 * bt + i; const size_t t = t0 + row;
                const bf16_t* p = P + t * PC;
                cq[i] = *(const uint2*)(p + CA_CQ + 4 * lane);
                ck[i] = *(const uint2*)(p + CA_CKV + 4 * (lane & 31));
                if (lane < 16) { const int pos = (int)(t % S); kr1[i] = p[CA_KR + lane]; kr2[i] = p[CA_KR + 16 + lane]; rcs[i] = ROPE[pos * 16 + lane]; rsn[i] = ROPE[S * 16 + pos * 16 + lane]; }
            }
#pragma unroll
            for (int i = 0; i < 4; ++i) {
                const int row = 16 * wid + 4 * bt + i; const size_t t = t0 + row;
                float a[4] = {bf2f((bf16_t)(cq[i].x & 0xffff)), bf2f((bf16_t)(cq[i].x >> 16)), bf2f((bf16_t)(cq[i].y & 0xffff)), bf2f((bf16_t)(cq[i].y >> 16))};
                float c[4] = {bf2f((bf16_t)(ck[i].x & 0xffff)), bf2f((bf16_t)(ck[i].x >> 16)), bf2f((bf16_t)(ck[i].y & 0xffff)), bf2f((bf16_t)(ck[i].y >> 16))};
                float sa = a[0] * a[0] + a[1] * a[1] + a[2] * a[2] + a[3] * a[3];
                float sb = (lane < 32) ? (c[0] * c[0] + c[1] * c[1] + c[2] * c[2] + c[3] * c[3]) : 0.f;
                sa = wave_sum64(sa); sb = wave_sum64(sb);
                const float ra = rsqrtf(sa * (1.f / 256.f) + EPS), rb = rsqrtf(sb * (1.f / 128.f) + EPS);
                u32x2 w; w.x = pg8::cvt_pk_bf16(a[0] * ra * gq[0], a[1] * ra * gq[1]); w.y = pg8::cvt_pk_bf16(a[2] * ra * gq[2], a[3] * ra * gq[3]);
                *(LAS u32x2*)(lds + L_AQ + row * AQ_STRIDE + 8 * lane) = w;
                if (lane < 32) { u32x2 v; v.x = pg8::cvt_pk_bf16(c[0] * rb * gk[0], c[1] * rb * gk[1]); v.y = pg8::cvt_pk_bf16(c[2] * rb * gk[2], c[3] * rb * gk[3]);
                    *(LAS u32x2*)(lds + L_AKV + row * AKV_STRIDE + 8 * lane) = v; }
                if (lane < 16) {
                    const float k1 = bf2f(kr1[i]), k2 = bf2f(kr2[i]);
                    const bf16_t o1 = f2bf(k1 * rcs[i] - k2 * rsn[i]), o2 = f2bf(k2 * rcs[i] + k1 * rsn[i]);
                    LAS bf16_t* rk = (LAS bf16_t*)(lds + L_RK + row * 64); rk[lane] = o1; rk[16 + lane] = o2;
                }
            }
        }
    }
    __syncthreads();
    f32x4 acc[8][3];
#pragma unroll
    for (int mi = 0; mi < 8; ++mi)
#pragma unroll
        for (int nf = 0; nf < 3; ++nf) acc[mi][nf] = (f32x4){0.f, 0.f, 0.f, 0.f};
#pragma unroll
    for (int ks = 0; ks < 8; ++ks) {
#pragma unroll
        for (int mi = 0; mi < 8; ++mi) {
            const bf16x8 xf = *(const LAS bf16x8*)(lds + L_AQ + (16 * mi + fr) * AQ_STRIDE + 64 * ks + 16 * fq);
#pragma unroll
            for (int nf = 0; nf < 3; ++nf) acc[mi][nf] = __builtin_amdgcn_mfma_f32_16x16x32_bf16(wq[ks][nf], xf, acc[mi][nf], 0, 0, 0);
        }
    }
    __builtin_amdgcn_sched_barrier(0);
    bf16x8 wkv[4][4];
    {
        const bf16_t* W = (const bf16_t*)(ws + WS_WTUKV) + (size_t)l * 512 * 128 + (size_t)(64 * wid + fr) * 128 + 8 * fq;
#pragma unroll
        for (int ks = 0; ks < 4; ++ks)
#pragma unroll
            for (int nf = 0; nf < 4; ++nf) wkv[ks][nf] = *(const bf16x8*)(W + (size_t)(16 * nf) * 128 + 32 * ks);
    }
    LAS unsigned char* stg = lds + L_ST + wid * (16 * ST_STRIDE);
#pragma unroll
    for (int mb = 0; mb < 2; ++mb) {
        f32x4 cs[4], sn[4];
        if (half == 1) {
#pragma unroll
            for (int i = 0; i < 4; ++i) { const int pos = (int)((t0 + 16 * (4 * mb + i) + fr) % S);
                cs[i] = *(const f32x4*)(ROPE + pos * 16 + 4 * fq); sn[i] = *(const f32x4*)(ROPE + S * 16 + pos * 16 + 4 * fq); }
        }
#pragma unroll
        for (int i = 0; i < 4; ++i) { const int mi = 4 * mb + i;
            LAS unsigned char* sp = stg + fr * ST_STRIDE + 8 * fq;
            if (half == 0) { stage4(sp, acc[mi][0]); stage4(sp + 32, acc[mi][1]); stage4(sp + 64, acc[mi][2]); }
            else { const f32x4 x1 = acc[mi][1], x2 = acc[mi][2];
                stage4(sp, acc[mi][0]); stage4(sp + 32, x1 * cs[i] - x2 * sn[i]); stage4(sp + 64, x2 * cs[i] + x1 * sn[i]); }
            asm volatile("" ::: "memory");
#pragma unroll
            for (int j = 0; j < 2; ++j) { const int pc = lane + 64 * j; const int row = pc / 6, c = pc % 6;
                if (pc < 96) { const u32x4 v = *(const LAS u32x4*)(stg + row * ST_STRIDE + c * 16);
                    *(u32x4*)(QA + (t0 + 16 * mi + row) * 384 + h * 96 + 48 * half + c * 8) = v; } }
            asm volatile("" ::: "memory");
        }
    }
    {
        f32x4 ac2[8][4];
#pragma unroll
        for (int mi = 0; mi < 8; ++mi)
#pragma unroll
            for (int nf = 0; nf < 4; ++nf) ac2[mi][nf] = (f32x4){0.f, 0.f, 0.f, 0.f};
#pragma unroll
        for (int ks = 0; ks < 4; ++ks) {
#pragma unroll
            for (int mi = 0; mi < 8; ++mi) {
                const bf16x8 xf = *(const LAS bf16x8*)(lds + L_AKV + (16 * mi + fr) * AKV_STRIDE + 64 * ks + 16 * fq);
#pragma unroll
                for (int nf = 0; nf < 4; ++nf) ac2[mi][nf] = __builtin_amdgcn_mfma_f32_16x16x32_bf16(wkv[ks][nf], xf, ac2[mi][nf], 0, 0, 0);
            }
        }
#pragma unroll
        for (int mi = 0; mi < 8; ++mi) {
            LAS unsigned char* sp = stg + fr * ST_STRIDE + 8 * fq;
#pragma unroll
            for (int nf = 0; nf < 4; ++nf) stage4(sp + 32 * nf, ac2[mi][nf]);
            asm volatile("" ::: "memory");
            if (half == 0) {
#pragma unroll
                for (int j = 0; j < 3; ++j) { const int pc = lane + 64 * j; const int row = pc / 12, c = pc % 12;
                    const u32x4 v = (c < 8) ? *(const LAS u32x4*)(stg + row * ST_STRIDE + c * 16) : *(const LAS u32x4*)(lds + L_RK + (16 * mi + row) * 64 + (c - 8) * 16);
                    *(u32x4*)(KA + (t0 + 16 * mi + row) * 384 + h * 96 + c * 8) = v; }
            } else {
#pragma unroll
                for (int j = 0; j < 2; ++j) { const int pc = lane + 64 * j; const int row = pc >> 3, c = pc & 7;
                    const u32x4 v = *(const LAS u32x4*)(stg + row * ST_STRIDE + c * 16);
                    *(u32x4*)(VA + (t0 + 16 * mi + row) * 256 + h * 64 + c * 8) = v; }
            }
            asm volatile("" ::: "memory");
        }
    }
}
}

__device__ __forceinline__ void conv_tokens(int t, int cg, const bf16_t* P, const float* cw, bf16_t* Y) {
    const int pos = t % S, ch = cg * 8;
    const bf16_t* p = P + (size_t)t * PC;
    const u16x8 zero = (u16x8){0, 0, 0, 0, 0, 0, 0, 0};
    const u16x8 c2 = *(const u16x8*)(p + CD_C + ch), h2 = *(const u16x8*)(p + CD_H + ch);
    const u16x8 c1 = (pos >= 1) ? *(const u16x8*)(p - PC + CD_C + ch) : zero, h1 = (pos >= 1) ? *(const u16x8*)(p - PC + CD_H + ch) : zero;
    const u16x8 c0 = (pos >= 2) ? *(const u16x8*)(p - 2 * PC + CD_C + ch) : zero, h0 = (pos >= 2) ? *(const u16x8*)(p - 2 * PC + CD_H + ch) : zero;
    const u16x8 bb = *(const u16x8*)(p + CD_B + ch), gg = *(const u16x8*)(p + CD_G + ch);
    u16x8 out;
#pragma unroll
    for (int e = 0; e < 8; ++e) {
        const float y = cw[ch + e] * (bf2f(c0[e]) * bf2f(h0[e])) + cw[256 + ch + e] * (bf2f(c1[e]) * bf2f(h1[e])) + cw[512 + ch + e] * (bf2f(c2[e]) * bf2f(h2[e]));
        const float g = bf2f(gg[e]);
        out[e] = f2bf(bf2f(bb[e]) * y * (g * __builtin_amdgcn_rcpf(1.f + __expf(-g))));
    }
    *(u16x8*)(Y + (size_t)t * D + 768 + ch) = out;
}

#define PH_PRE const int tid = opaque_tid(), lane = tid & 63, wave = __builtin_amdgcn_readfirstlane(tid >> 6); const int G = opaque_grid(), bid = opaque_bid(); \
    ArgsP A = get_args(); unsigned char* ws = A->ws; (void)lane; (void)wave; (void)G; (void)bid; (void)ws;
__device__ __forceinline__ void ph_prologue(LAS unsigned char* lds) {
    PH_PRE
    const long gtid = (long)bid * NTHR + tid, gthreads = (long)G * NTHR;
    {
        LAS float* scr = (LAS float*)lds;
        constexpr int T_IN = 16 * 64, T_OUT = 16 * 16, T_UQ = 4 * 6, T_UKV = 2 * 8, T_L = T_IN + T_OUT + T_UQ + T_UKV;
        for (int it = bid; it < NL * T_L; it += G) {
            const int l = it / T_L; int r = it % T_L;
            if (r < T_IN) { convert_tile(scr, A->w_in + (size_t)l * 1024 * INC, (bf16_t*)(ws + WS_WTIN) + (size_t)l * PC * 1024, 1024, INC, 1, 1.f, (r >> 6) * 64, (r & 63) * 64, tid); continue; } r -= T_IN;
            if (r < T_OUT) { convert_tile(scr, A->w_out + (size_t)l * 1024 * 1024, (bf16_t*)(ws + WS_WTOUT) + (size_t)l * 1024 * 1024, 1024, 1024, 0, 1.f, (r >> 4) * 64, (r & 15) * 64, tid); continue; } r -= T_OUT;
            if (r < T_UQ) { convert_tile(scr, A->w_uq + (size_t)l * 256 * 384, (bf16_t*)(ws + WS_WTUQ) + (size_t)l * 384 * 256, 256, 384, 0, QS_MLA, (r / 6) * 64, (r % 6) * 64, tid); continue; } r -= T_UQ;
            convert_tile(scr, A->w_ukv + (size_t)l * 128 * 512, (bf16_t*)(ws + WS_WTUKV) + (size_t)l * 512 * 128, 128, 512, 0, 1.f, (r >> 3) * 64, (r & 7) * 64, tid);
        }
        __syncthreads();
    }
    float* ROPE = (float*)(ws + WS_ROPE);
    for (long i = gtid; i < S * 16; i += gthreads) {
        const int s = (int)(i >> 4), f = (int)(i & 15);
        const float inv = powf(10000.0f, -(float)f / 16.0f);
        const float ang = (float)s * inv;
        float sn, c; sincosf(ang, &sn, &c);
        ROPE[i] = c; ROPE[S * 16 + i] = sn;
    }
}
__device__ __forceinline__ void ph_rms(int l) {
    PH_PRE
    bf16_t* HN = (bf16_t*)(ws + WS_HN);
    const int NGW = G * NWAVE;
    if (l == 0) { for (int r = bid * NWAVE + wave; r < T; r += 4 * NGW) rms_rows4<true>(A->x + (size_t)r * D, (size_t)NGW * D, A->norm_g + l * D, HN + (size_t)r * D, nullptr, lane); }
    else { const bf16_t* XR = (const bf16_t*)(ws + WS_XR);
        for (int r = bid * NWAVE + wave; r < T; r += 4 * NGW) rms_rows4b<true>(XR + (size_t)r * D, (size_t)NGW * D, A->norm_g + l * D, HN + (size_t)r * D, nullptr, lane); }
}
__device__ __forceinline__ void ph_gemm_in(LAS unsigned char* lds, int l) {
    PH_PRE
    pg8::Gemm g{(const bf16_t*)(ws + WS_HN), (const bf16_t*)(ws + WS_WTIN) + (size_t)l * PC * 1024, T, PC, 1024}; pg8::StaticOrder So; So.init(T, PC, G, bid);
    pg8::EpiBf16 E{(bf16_t*)(ws + WS_P), PC};
    pg8::gemm_phase<pg8::EpiBf16, pg8::StaticOrder, true, true>(lds, g, So, E);
}
__device__ __forceinline__ void ph_mid(LAS unsigned char* lds, int l) {
    const int G = opaque_grid(), bid = opaque_bid();
    for (int u = bid; u < T / 128; u += G) mp::mla_prep_unit(lds, u, l);
    __syncthreads();
    {
        const int vcu = (bid & 7) * (G >> 3) + (bid >> 3);
        const int b = vcu >> 5, j = vcu & 31;
        for (int m = 0; m < 4; ++m) { const int c = ((m & 1) ? (15 - (j >> 1)) : (j >> 1)) + 16 * m; sel2::select_unit(lds, b, c, j & 1); }
    }
}
__device__ __forceinline__ void ph_attn(LAS unsigned char* lds, int l) {
    const int G = opaque_grid(), bid = opaque_bid();
    {
        const int vcu = (bid & 7) * (G >> 3) + (bid >> 3);
        const int b = vcu >> 5, h = (vcu >> 3) & 3, s = vcu & 7;
        { ArgsP A = get_args(); fa::build_bias(lds, A->rel_bias); }
#define ATTN_UNIT(TY) do { _Pragma("unroll 1") for (int u_ = 0; u_ < 2; ++u_) { int b_ = b, h_ = h, q_ = u_ ? s : 15 - s, l_ = l; asm volatile("" : "+s"(b_), "+s"(h_), "+s"(q_), "+s"(l_)); \
            fa::attn_unit<TY>(lds, b_, h_, q_, l_); } } while (0)
        ATTN_UNIT(0);
        { _Pragma("unroll 1") for (int u_ = 0; u_ < 2; ++u_) { int b_ = b, h_ = h, q_ = u_ ? s : 15 - s, l_ = l; asm volatile("" : "+s"(b_), "+s"(h_), "+s"(q_), "+s"(l_)); fa::attn_unit_diff(lds, b_, h_, q_, l_); } }
        ATTN_UNIT(2);
#undef ATTN_UNIT
        __syncthreads();
    }
    {
        PH_PRE
        for (int t = bid * 16 + (tid >> 5); t < T; t += 16 * G) conv_tokens(t, tid & 31, (const bf16_t*)(ws + WS_P), A->conv_w + l * 768, (bf16_t*)(ws + WS_Y));
    }
}
__device__ __forceinline__ void ph_gemm_out(LAS unsigned char* lds, int l) {
    PH_PRE
    pg8::Gemm g{(const bf16_t*)(ws + WS_Y), (const bf16_t*)(ws + WS_WTOUT) + (size_t)l * 1024 * 1024, T, 1024, 1024}; pg8::StaticOrder So; So.init(T, 1024, G, bid);
    bf16_t* XR = (bf16_t*)(ws + WS_XR);
    if (l == 0) { pg8::EpiResBf16<false> E{A->x, XR, 1024}; pg8::gemm_phase<pg8::EpiResBf16<false>, pg8::StaticOrder, true, true>(lds, g, So, E); }
    else { pg8::EpiResBf16<true> E{XR, XR, 1024}; pg8::gemm_phase<pg8::EpiResBf16<true>, pg8::StaticOrder, true, true>(lds, g, So, E); }
}
__device__ __forceinline__ void ph_final() {
    PH_PRE
    const int NGW = G * NWAVE;
    const bf16_t* XR = (const bf16_t*)(ws + WS_XR);
    for (int r = bid * NWAVE + wave; r < T; r += 4 * NGW) rms_rows4b<false>(XR + (size_t)r * D, (size_t)NGW * D, A->final_g, nullptr, A->out + (size_t)r * D, lane);
}

#define GRID_SYNC() xcd_barrier(lds)
__global__ void __launch_bounds__(NTHR, 2) mk_fwd(Args Akernarg) {
    extern __shared__ __attribute__((aligned(16))) unsigned char lds_raw[];
    LAS unsigned char* lds = (LAS unsigned char*)lds_raw;
    xcd_barrier_post(lds);
    ph_prologue(lds);
    for (int l = 0; l < NL; ++l) {
        ph_rms(l);
        GRID_SYNC();
        ph_gemm_in(lds, l);
        GRID_SYNC();
        ph_mid(lds, l);
        GRID_SYNC();
        ph_attn(lds, l);
        GRID_SYNC();
        ph_gemm_out(lds, l);
        GRID_SYNC();
    }
    ph_final();
}

extern "C" void kernel_launch(void* const* d_in, const int* in_sizes, int n_in, void* d_out, int out_size, void* d_ws, size_t ws_size, hipStream_t stream) {
    static int grid = 0;
    if (grid == 0) {
        if (ws_size < WS_END) { fprintf(stderr, "kernel_launch: workspace too small (%zu < %zu)\n", ws_size, (size_t)WS_END); grid = -1; return; }
        int dev = 0, cus = 0, per_cu = 0;
        hipGetDevice(&dev);
        hipDeviceGetAttribute(&cus, hipDeviceAttributeMultiprocessorCount, dev);
        hipFuncSetAttribute((const void*)mk_fwd, hipFuncAttributeMaxDynamicSharedMemorySize, LDS_BYTES);
        hipOccupancyMaxActiveBlocksPerMultiprocessor(&per_cu, (const void*)mk_fwd, NTHR, LDS_BYTES);
        if (per_cu < 1) fprintf(stderr, "kernel_launch: note: the occupancy query reports %d workgroups per CU; 145 KiB of LDS per workgroup admits exactly one\n", per_cu);
        (void)hipGetLastError();
        if (cus != 256) { fprintf(stderr, "kernel_launch: built for a 256-CU device (one workgroup per CU, 32 per batch); found %d CUs; nothing launched\n", cus); grid = -1; return; }
        grid = cus;
    }
    if (grid < 0) return;
    Args a{};
    a.x = (const float*)d_in[0]; a.norm_g = (const float*)d_in[1]; a.w_in = (const float*)d_in[2]; a.qa_g = (const float*)d_in[3];
    a.w_uq = (const float*)d_in[4]; a.kva_g = (const float*)d_in[5]; a.w_ukv = (const float*)d_in[6]; a.dlam = (const float*)d_in[7];
    a.subg = (const float*)d_in[8]; a.conv_w = (const float*)d_in[9]; a.w_out = (const float*)d_in[10]; a.rel_bias = (const float*)d_in[11];
    a.final_g = (const float*)d_in[12];
    a.out = (float*)d_out; a.ws = (unsigned char*)d_ws;
    a.lambda_init[0] = 0.8f - 0.6f * expf(-0.3f * 0.f); a.lambda_init[1] = 0.8f - 0.6f * expf(-0.3f * 1.f);
    if (hipMemsetAsync(d_ws, 0, 65536, stream) != hipSuccess) { fprintf(stderr, "kernel_launch: memset of the barrier words failed\n"); return; }
    hipLaunchKernelGGL(mk_fwd, dim3(grid), dim3(NTHR), LDS_BYTES, stream, a);
    const hipError_t e = hipPeekAtLastError();
    if (e != hipSuccess) fprintf(stderr, "launch failed: %s (grid %d)\n", hipGetErrorString(e), grid);
}
```

```cpp
#include <hip/hip_runtime.h>
#include <hip/hip_bf16.h>
#include <cstdint>
#include <cstdio>

#define LAS __attribute__((address_space(3)))
typedef unsigned short bf16_t;
typedef short bf16x8 __attribute__((ext_vector_type(8)));
typedef unsigned short u16x8 __attribute__((ext_vector_type(8)));
typedef float f32x4 __attribute__((ext_vector_type(4)));
typedef unsigned u32x4 __attribute__((ext_vector_type(4)));
typedef unsigned u32x2 __attribute__((ext_vector_type(2)));

constexpr int NB = 8, S = 4096, T = NB * S, D = 1024, NL = 2;
constexpr int PC = 4096;
constexpr int INC = 4040;
constexpr int CA_CQ = 0, CA_CKV = 256, CA_KR = 384, CA_G = 448;
constexpr int CB_Q = 704, CB_K = 960, CB_V = 1216, CB_G = 1472;
constexpr int CC_Q = 1728, CC_K = 1984, CC_V = 2240, CC_QI = 2496, CC_KI = 2752, CC_WI = 2784, CC_G = 2816;
constexpr int CD_B = 3072, CD_C = 3328, CD_H = 3584, CD_G = 3840;
constexpr float EPS = 1e-6f;
constexpr int NTHR = 512, NWAVE = 8;

constexpr size_t MiB = 1u << 20;
constexpr size_t WS_WTIN = 1 * MiB;
constexpr size_t WS_WTOUT = 17 * MiB;
constexpr size_t WS_WTUQ = 21 * MiB;
constexpr size_t WS_WTUKV = 22 * MiB;
constexpr size_t WS_ROPE = 23 * MiB;
constexpr size_t WS_HN = 24 * MiB;
constexpr size_t WS_Y = WS_HN;
constexpr size_t WS_Q384 = WS_HN;
constexpr size_t WS_KV512 = WS_HN + 24 * MiB;
constexpr size_t WS_P = 88 * MiB;
constexpr size_t WS_QA = 344 * MiB;
constexpr size_t WS_KA = 368 * MiB;
constexpr size_t WS_VA = 392 * MiB;
constexpr size_t WS_CQN = WS_VA;
constexpr size_t WS_MASK = 408 * MiB;
constexpr size_t WS_CKVN = WS_MASK;
constexpr size_t WS_OKL = 424 * MiB;
constexpr size_t WS_XR = 440 * MiB;
constexpr size_t WS_END = 504 * MiB;

constexpr int LDS_BYTES = 148480;

__device__ __forceinline__ bf16_t f2bf(float f) {
    unsigned u = __builtin_bit_cast(unsigned, f);
    return (bf16_t)((u + 0x7fffu + ((u >> 16) & 1u)) >> 16);
}
__device__ __forceinline__ float bf2f(bf16_t h) { return __builtin_bit_cast(float, (unsigned)h << 16); }
__device__ __forceinline__ float silu(float x) { return x / (1.f + __expf(-x)); }
__device__ __forceinline__ int orig_col(int pc) {
    if (pc < 416) return pc;
    if (pc < 448) return -1;
    if (pc < 2792) return pc - 32;
    if (pc < 2816) return -1;
    return pc - 56;
}
__device__ __forceinline__ int rel_bucket(int rel) {
    const int ret = rel > 0 ? 16 : 0;
    const int n = rel < 0 ? -rel : rel;
    if (n < 8) return ret + n;
    int large = 2 + (31 - __clz(n * n));
    if (large > 15) large = 15;
    return ret + large;
}

__device__ __forceinline__ int opaque_tid() { int t = threadIdx.x; asm volatile("" : "+v"(t)); return t; }
__device__ __forceinline__ int opaque_bid() { int b = blockIdx.x; asm volatile("" : "+s"(b)); return b; }
__device__ __forceinline__ int opaque_grid() { int g = gridDim.x; asm volatile("" : "+s"(g)); return g; }
namespace pg8 {
constexpr int BM = 256, BK = 64, HALF = 128, HTB = HALF * BK * 2, STAGE_BYTES = 8 * HTB, NXCD = 8, WGM = 8;
__host__ __device__ __forceinline__ int lds_byte(int r, int c) { const int st = (r >> 4) * 2 + (c >> 5), rr = r & 15, cc = c & 31, ob = rr * 64 + cc * 2; return st * 1024 + (ob ^ (((ob >> 9) & 1) << 5)); }
__host__ __device__ __forceinline__ void stage_rc(int b, int& R, int& C) { const int st = b / 1024, sb = b % 1024, swz = sb ^ (((sb >> 9) & 1) << 5); R = (st >> 1) * 16 + swz / 64; C = (st & 1) * 32 + (swz % 64) / 2; }
__host__ __device__ __forceinline__ int perm32(int rho) { const int n = rho >> 4, i = rho & 15; return 8 * (i >> 2) + 4 * n + (i & 3); }
struct Unit { int pm, pn; };
struct Gemm { const bf16_t* A; const bf16_t* Bt; int M, N, K; };
struct StaticOrder {
    int nM, nN, nwg, G, c;
    __host__ __device__ void init(int M, int N, int G_, int c_) { nM = M / BM; nN = N / BM; nwg = nM * nN; G = G_; c = c_; }
    __host__ __device__ bool next(int i, Unit& u) const {
        const long L = (long)i * G + c; if (L >= nwg) return false;
        int wgid = (int)L; { const int q = nwg / NXCD, r = nwg % NXCD, xcd = wgid % NXCD, off = wgid / NXCD; wgid = (xcd < r ? xcd * (q + 1) : r * (q + 1) + (xcd - r) * q) + off; }
        const int nig = WGM * nN, gid = wgid / nig, fm = gid * WGM, gsz = (nM - fm) < WGM ? (nM - fm) : WGM;
        u.pm = fm + ((wgid % nig) % gsz); u.pn = (wgid % nig) / gsz; return true;
    }
    __device__ __forceinline__ void a_ready(const Unit&) const {}
    __device__ __forceinline__ void done(const Unit&) const {}
};
__device__ __forceinline__ unsigned cvt_pk_bf16(float lo, float hi) { unsigned r; asm volatile("v_cvt_pk_bf16_f32 %0, %1, %2" : "=v"(r) : "v"(lo), "v"(hi)); return r; }
struct EpiBf16 {
    static constexpr bool PERM = true, AFTER_DRAIN = false;
    bf16_t* O; int ldc;
    __device__ __forceinline__ void operator()(const f32x4 (&acc)[2][2][4][2], const Unit& u, int wr, int wc, int fr, int fq) const {
        const int row0 = u.pm * BM + wr * 64 + fr; const int col0 = u.pn * BM + wc * 32 + 8 * fq;
#pragma unroll
        for (int ai = 0; ai < 2; ++ai)
#pragma unroll
            for (int m = 0; m < 4; ++m) { bf16_t* rowp = O + (size_t)(row0 + ai * HALF + m * 16) * ldc + col0;
#pragma unroll
                for (int bj = 0; bj < 2; ++bj) { const f32x4 v0 = acc[ai][bj][m][0], v1 = acc[ai][bj][m][1];
                    u32x4 w; w.x = cvt_pk_bf16(v0[0], v0[1]); w.y = cvt_pk_bf16(v0[2], v0[3]); w.z = cvt_pk_bf16(v1[0], v1[1]); w.w = cvt_pk_bf16(v1[2], v1[3]);
                    *(u32x4*)(rowp + bj * HALF) = w; } }
    }
};
struct EpiResF32 {
    static constexpr bool PERM = false, AFTER_DRAIN = false;
    const float* base; float* out; int ldc;
    __device__ __forceinline__ void operator()(const f32x4 (&acc)[2][2][4][2], const Unit& u, int wr, int wc, int fr, int fq) const {
        const int col0 = u.pn * BM + wc * 32 + 4 * fq;
#pragma unroll
        for (int ai = 0; ai < 2; ++ai)
#pragma unroll
            for (int m = 0; m < 4; ++m) { const size_t off = (size_t)(u.pm * BM + ai * HALF + wr * 64 + m * 16 + fr) * ldc + col0;
#pragma unroll
                for (int bj = 0; bj < 2; ++bj)
#pragma unroll
                    for (int n = 0; n < 2; ++n) { const f32x4 bs = *(const f32x4*)(base + off + bj * HALF + n * 16); *(f32x4*)(out + off + bj * HALF + n * 16) = bs + acc[ai][bj][m][n]; } }
    }
};
template <bool BASE_BF16>
struct EpiResBf16 {
    static constexpr bool PERM = true, AFTER_DRAIN = false;
    const void* base; bf16_t* out; int ldc;
    __device__ __forceinline__ void operator()(const f32x4 (&acc)[2][2][4][2], const Unit& u, int wr, int wc, int fr, int fq) const {
        const int row0 = u.pm * BM + wr * 64 + fr; const int col0 = u.pn * BM + wc * 32 + 8 * fq;
#pragma unroll
        for (int ai = 0; ai < 2; ++ai)
#pragma unroll
            for (int m = 0; m < 4; ++m) { const size_t ro = (size_t)(row0 + ai * HALF + m * 16) * ldc + col0;
#pragma unroll
                for (int bj = 0; bj < 2; ++bj) { const f32x4 v0 = acc[ai][bj][m][0], v1 = acc[ai][bj][m][1]; const size_t off = ro + bj * HALF;
                    f32x4 b0, b1;
                    if (BASE_BF16) { const u16x8 bb = *(const u16x8*)((const bf16_t*)base + off);
                        b0 = (f32x4){bf2f(bb[0]), bf2f(bb[1]), bf2f(bb[2]), bf2f(bb[3])}; b1 = (f32x4){bf2f(bb[4]), bf2f(bb[5]), bf2f(bb[6]), bf2f(bb[7])}; }
                    else { b0 = *(const f32x4*)((const float*)base + off); b1 = *(const f32x4*)((const float*)base + off + 4); }
                    const f32x4 s0 = b0 + v0, s1 = b1 + v1;
                    u32x4 w; w.x = cvt_pk_bf16(s0[0], s0[1]); w.y = cvt_pk_bf16(s0[2], s0[3]); w.z = cvt_pk_bf16(s1[0], s1[1]); w.w = cvt_pk_bf16(s1[2], s1[3]);
                    *(u32x4*)(out + off) = w; } }
    }
};
template <class Epi, class Sched, bool ALIGN_EPI = false, bool SP2 = false>
__device__ __forceinline__ void gemm_phase(LAS unsigned char* lds, const Gemm g, const Sched& S, const Epi& E) {
    const int tid = opaque_tid(), wid = __builtin_amdgcn_readfirstlane(tid >> 6), lane = tid & 63, wr = wid >> 2, wc = wid & 3, fr = lane & 15, fq = lane >> 4;
    const int K = g.K, nt = K / BK;
    unsigned voffA[2], voffB[2];
#pragma unroll
    for (int i = 0; i < 2; ++i) { int R, C; stage_rc(tid * 16 + i * 8192, R, C); const int Rb = Epi::PERM ? ((R & ~31) + perm32(R & 31)) : R;
        voffA[i] = (unsigned)(R * K + C) * 2u; voffB[i] = (unsigned)(Rb * K + C) * 2u; }
    const size_t kstep = (size_t)(BK * 2);
    const size_t hstep = (size_t)HALF * K * 2;
    const size_t tstep = 2 * hstep;
    const unsigned ldsw = (unsigned)wid * 1024u;
    const int aoff = lds_byte(wr * 64 + fr, fq * 8), boff = lds_byte(wc * 32 + fr, fq * 8);
#define PG8_SA(b, h) (((b) * 2 + (h)) * HTB)
#define PG8_SB(b, h) ((4 + (b) * 2 + (h)) * HTB)
#define PG8_STAGE(bufoff, gbase, voff) do { _Pragma("unroll") for (int _i = 0; _i < 2; ++_i) \
        __builtin_amdgcn_global_load_lds((const unsigned*)((const char*)(gbase) + (voff)[_i]), (LAS unsigned*)(lds + (bufoff) + ldsw + _i * 8192), 16, 0, 0); } while (0)
#define PG8_LDA(dst, b, h) do { _Pragma("unroll") for (int m = 0; m < 4; ++m) _Pragma("unroll") for (int k = 0; k < 2; ++k) dst[m][k] = *(const LAS bf16x8*)(lds + PG8_SA(b, h) + aoff + m * 2048 + k * 1024); } while (0)
#define PG8_LDB(dst, b, h) do { _Pragma("unroll") for (int n = 0; n < 2; ++n) _Pragma("unroll") for (int k = 0; k < 2; ++k) dst[n][k] = *(const LAS bf16x8*)(lds + PG8_SB(b, h) + boff + n * 2048 + k * 1024); } while (0)
#define PG8_MMA(ai, bj, At, Bt) do { __builtin_amdgcn_s_setprio(1); _Pragma("unroll") for (int m = 0; m < 4; ++m) _Pragma("unroll") for (int n = 0; n < 2; ++n) _Pragma("unroll") for (int k = 0; k < 2; ++k) \
        acc[ai][bj][m][n] = __builtin_amdgcn_mfma_f32_16x16x32_bf16(Bt[n][k], At[m][k], acc[ai][bj][m][n], 0, 0, 0); __builtin_amdgcn_s_setprio(0); } while (0)
#define PG8_WAIT_V(n) asm volatile("s_waitcnt vmcnt(" #n ")" ::: "memory")
#define PG8_WAIT_L(n) asm volatile("s_waitcnt lgkmcnt(" #n ")" ::: "memory")
#define PG8_BAR __builtin_amdgcn_s_barrier()
#define PG8_SCHED __builtin_amdgcn_sched_barrier(0)
    Unit cur, nxt; int ui = 0;
    if (!S.next(0, cur)) return;
    f32x4 acc[2][2][4][2];
#pragma unroll
    for (int a = 0; a < 2; ++a)
#pragma unroll
        for (int b = 0; b < 2; ++b)
#pragma unroll
            for (int m = 0; m < 4; ++m)
#pragma unroll
                for (int n = 0; n < 2; ++n) acc[a][b][m][n] = (f32x4){0.f, 0.f, 0.f, 0.f};
    bf16x8 At[4][2], B0[2][2], B1[2][2];
    const char* cA = (const char*)g.A + (size_t)cur.pm * tstep; const char* cB = (const char*)g.Bt + (size_t)cur.pn * tstep;
    S.a_ready(cur);
    if constexpr (SP2) {
        PG8_STAGE(PG8_SB(0, 0), cB, voffB); PG8_STAGE(PG8_SB(0, 1), cB + hstep, voffB); PG8_STAGE(PG8_SA(0, 0), cA, voffA); PG8_STAGE(PG8_SA(0, 1), cA + hstep, voffA);
        if (wr == 1) PG8_BAR;
        PG8_WAIT_V(2); PG8_BAR;
        PG8_STAGE(PG8_SB(1, 0), cB + kstep, voffB); PG8_STAGE(PG8_SA(1, 0), cA + kstep, voffA); PG8_STAGE(PG8_SB(1, 1), cB + hstep + kstep, voffB);
        PG8_WAIT_V(6); PG8_BAR;
    } else {
        PG8_STAGE(PG8_SB(0, 0), cB, voffB); PG8_STAGE(PG8_SA(0, 0), cA, voffA); PG8_STAGE(PG8_SB(0, 1), cB + hstep, voffB); PG8_STAGE(PG8_SA(0, 1), cA + hstep, voffA);
        if (wr == 1) PG8_BAR;
        PG8_WAIT_V(4); PG8_BAR;
        PG8_STAGE(PG8_SB(1, 0), cB + kstep, voffB); PG8_STAGE(PG8_SA(1, 0), cA + kstep, voffA); PG8_STAGE(PG8_SB(1, 1), cB + hstep + kstep, voffB);
        PG8_WAIT_V(6); PG8_BAR;
    }
    for (;;) {
        const bool has_next = S.next(ui + 1, nxt);
        const char* nA = has_next ? (const char*)g.A + (size_t)nxt.pm * tstep : cA; const char* nB = has_next ? (const char*)g.Bt + (size_t)nxt.pn * tstep : cB;
        for (int t = 0; t < nt; t += 2) {
            const bool last = (t == nt - 2);
            const char* a1 = cA + (size_t)(t + 1) * kstep;
            const char* a2 = last ? nA : cA + (size_t)(t + 2) * kstep; const char* b2 = last ? nB : cB + (size_t)(t + 2) * kstep;
            const char* a3 = a2 + kstep; const char* b3 = b2 + kstep;
            if (last && has_next) S.a_ready(nxt);
            if constexpr (SP2) {
            PG8_LDB(B0, 0, 0); PG8_LDB(B1, 0, 1); PG8_SCHED; PG8_LDA(At, 0, 0); PG8_STAGE(PG8_SA(1, 1), a1 + hstep, voffA);
            PG8_WAIT_V(8); PG8_WAIT_L(0); PG8_BAR; PG8_MMA(0, 0, At, B0); PG8_MMA(0, 1, At, B1); PG8_BAR; PG8_SCHED;
            PG8_LDA(At, 0, 1); PG8_STAGE(PG8_SB(0, 0), b2, voffB); PG8_STAGE(PG8_SB(0, 1), b2 + hstep, voffB); PG8_STAGE(PG8_SA(0, 0), a2, voffA);
            PG8_WAIT_V(8); PG8_WAIT_L(0); PG8_BAR; PG8_MMA(1, 0, At, B0); PG8_MMA(1, 1, At, B1); PG8_BAR; PG8_SCHED;
            PG8_LDB(B0, 1, 0); PG8_LDB(B1, 1, 1); PG8_SCHED; PG8_LDA(At, 1, 0); PG8_STAGE(PG8_SA(0, 1), a2 + hstep, voffA);
            PG8_WAIT_V(8); PG8_WAIT_L(0); PG8_BAR; PG8_MMA(0, 0, At, B0); PG8_MMA(0, 1, At, B1); PG8_BAR; PG8_SCHED;
            PG8_LDA(At, 1, 1); PG8_STAGE(PG8_SB(1, 0), b3, voffB); PG8_STAGE(PG8_SB(1, 1), b3 + hstep, voffB); PG8_STAGE(PG8_SA(1, 0), a3, voffA);
            PG8_WAIT_V(8); PG8_WAIT_L(0); PG8_BAR; PG8_MMA(1, 0, At, B0); PG8_MMA(1, 1, At, B1); PG8_BAR; PG8_SCHED;
            } else {
            PG8_LDB(B0, 0, 0); PG8_SCHED; PG8_LDA(At, 0, 0); PG8_STAGE(PG8_SA(1, 1), a1 + hstep, voffA);
            PG8_WAIT_L(8); PG8_BAR; PG8_WAIT_L(0); PG8_MMA(0, 0, At, B0); PG8_BAR; PG8_SCHED;
            PG8_LDB(B1, 0, 1); PG8_STAGE(PG8_SB(0, 0), b2, voffB);
            PG8_BAR; PG8_WAIT_L(0); PG8_MMA(0, 1, At, B1); PG8_BAR;
            PG8_LDA(At, 0, 1); PG8_STAGE(PG8_SA(0, 0), a2, voffA);
            PG8_BAR; PG8_WAIT_L(0); PG8_MMA(1, 0, At, B0); PG8_BAR; PG8_SCHED;
            PG8_STAGE(PG8_SB(0, 1), b2 + hstep, voffB);
            PG8_WAIT_V(6); PG8_BAR; PG8_MMA(1, 1, At, B1); PG8_BAR;
            PG8_LDB(B0, 1, 0); PG8_SCHED; PG8_LDA(At, 1, 0); PG8_STAGE(PG8_SA(0, 1), a2 + hstep, voffA);
            PG8_WAIT_L(8); PG8_BAR; PG8_WAIT_L(0); PG8_MMA(0, 0, At, B0); PG8_BAR; PG8_SCHED;
            PG8_LDB(B1, 1, 1); PG8_STAGE(PG8_SB(1, 0), b3, voffB);
            PG8_BAR; PG8_WAIT_L(0); PG8_MMA(0, 1, At, B1); PG8_BAR;
            PG8_LDA(At, 1, 1); PG8_STAGE(PG8_SA(1, 0), a3, voffA);
            PG8_BAR; PG8_WAIT_L(0); PG8_MMA(1, 0, At, B0); PG8_BAR; PG8_SCHED;
            PG8_STAGE(PG8_SB(1, 1), b3 + hstep, voffB);
            PG8_WAIT_V(6); PG8_BAR; PG8_MMA(1, 1, At, B1); PG8_BAR;
            }
        }
        if constexpr (ALIGN_EPI) { if (wr == 0) PG8_BAR; }
        if constexpr (!Epi::AFTER_DRAIN) { E(acc, cur, wr, wc, fr, fq); S.done(cur); }
        if (!has_next) break;
#pragma unroll
        for (int a = 0; a < 2; ++a)
#pragma unroll
            for (int b = 0; b < 2; ++b)
#pragma unroll
                for (int m = 0; m < 4; ++m)
#pragma unroll
                    for (int n = 0; n < 2; ++n) acc[a][b][m][n] = (f32x4){0.f, 0.f, 0.f, 0.f};
        cur = nxt; cA = nA; cB = nB; ++ui;
        if constexpr (ALIGN_EPI) { if (wr == 1) PG8_BAR; }
    }
    PG8_WAIT_V(0);
    if constexpr (!ALIGN_EPI) { if (wr == 0) PG8_BAR; }
    PG8_BAR;
#undef PG8_SA
#undef PG8_SB
#undef PG8_STAGE
#undef PG8_LDA
#undef PG8_LDB
#undef PG8_MMA
#undef PG8_WAIT_V
#undef PG8_WAIT_L
#undef PG8_BAR
#undef PG8_SCHED
}
}

struct Args {
    const float* x; const float* norm_g; const float* w_in; const float* qa_g; const float* w_uq; const float* kva_g; const float* w_ukv;
    const float* dlam; const float* subg; const float* conv_w; const float* w_out; const float* rel_bias; const float* final_g;
    float* out; unsigned char* ws;
    float lambda_init[2]; int pad[2];
};

typedef const __attribute__((address_space(4))) Args* ArgsP;
__device__ __forceinline__ ArgsP get_args() { ArgsP p = (ArgsP)__builtin_amdgcn_kernarg_segment_ptr(); asm volatile("" : "+s"(p)); return p; }

#define XB_TMO      128
#define XB_XCNT(j)  (256  + 64 * (j))
#define XB_XSUB(j)  (1280 + 64 * (j))
#define XB_XGEN(j)  (2304 + 64 * (j))
#define XB_TOP      3328
#define XB_TOPGEN   3392
#define XCD_BAR_WORDS 3456
#define XB_SPIN_CAP (1u << 18)
constexpr int LDS_XB = 148464;
__device__ __forceinline__ unsigned xb_ld(unsigned* p)              { return __hip_atomic_load(p, __ATOMIC_RELAXED, __HIP_MEMORY_SCOPE_AGENT); }
__device__ __forceinline__ unsigned xb_add(unsigned* p, unsigned v) { return __hip_atomic_fetch_add(p, v, __ATOMIC_RELAXED, __HIP_MEMORY_SCOPE_AGENT); }
__device__ __forceinline__ unsigned xb_xcc_id() { return (unsigned)__builtin_amdgcn_s_getreg((3 << 11) | 20) & 0xFu; }
#define XB_SPIN(cond, bar) do { unsigned _sp = 0; while (cond) { __builtin_amdgcn_s_sleep(1); \
    if ((++_sp & 255u) == 0u) { if (xb_ld(&(bar)[XB_TMO])) break; if (_sp > XB_SPIN_CAP) { atomicAdd(&(bar)[XB_TMO], 1u); break; } } } } while (0)
__device__ __forceinline__ void xcd_barrier_complete(unsigned* bar, unsigned x, unsigned& nloc, unsigned& nx) {
    const unsigned G = gridDim.x * gridDim.y * gridDim.z;
    unsigned sum, cnt, mine, sp = 0u;
    for (;;) {
        sum = 0u; cnt = 0u; mine = 0u;
#pragma unroll
        for (unsigned j = 0; j < 16; ++j) { const unsigned c = xb_ld(&bar[XB_XCNT(j)]); sum += c; cnt += (c > 0u) ? 1u : 0u; mine = (j == x) ? c : mine; }
        if (sum == G) break;
        __builtin_amdgcn_s_sleep(1);
        if ((++sp & 255u) == 0u) { if (xb_ld(&bar[XB_TMO])) break; if (sp > XB_SPIN_CAP) { atomicAdd(&bar[XB_TMO], 1u); break; } }
    }
    nloc = mine > 0u ? mine : 1u; nx = cnt > 0u ? cnt : 1u;
}
__device__ __forceinline__ void xcd_barrier_post(LAS unsigned char* lds) {
    ArgsP A = get_args(); unsigned* bar = (unsigned*)A->ws;
    if (threadIdx.x == 0) { ((volatile LAS unsigned*)(lds + LDS_XB))[0] = 0u; ((volatile LAS unsigned*)(lds + LDS_XB))[1] = 0u;
        (void)xb_add(&bar[XB_XCNT(xb_xcc_id())], 1u); }
    __syncthreads();
}
__device__ __forceinline__ void xcd_barrier(LAS unsigned char* lds) {
    ArgsP A = get_args(); unsigned* bar = (unsigned*)A->ws;
    asm volatile("s_waitcnt vmcnt(0)" ::: "memory");
    __syncthreads();
    if (threadIdx.x == 0) {
        const unsigned x = xb_xcc_id();
        volatile LAS unsigned* st = (volatile LAS unsigned*)(lds + LDS_XB);
        __builtin_amdgcn_s_waitcnt(0);
        unsigned nloc = st[0], nx = st[1];
        if (nloc == 0u) { xcd_barrier_complete(bar, x, nloc, nx); st[0] = nloc; st[1] = nx; }
        const unsigned old = xb_add(&bar[XB_XSUB(x)], 1u);
        const unsigned gen = old / nloc;
        if (old + 1u == (gen + 1u) * nloc) {
            __builtin_amdgcn_fence(__ATOMIC_RELEASE, "agent");
            asm volatile("s_waitcnt vmcnt(0)" ::: "memory");
            const unsigned og = xb_add(&bar[XB_TOP], 1u);
            const unsigned tg = og / nx;
            if (og + 1u == (tg + 1u) * nx) xb_add(&bar[XB_TOPGEN], 1u);
            else XB_SPIN(xb_ld(&bar[XB_TOPGEN]) == tg, bar);
            __builtin_amdgcn_fence(__ATOMIC_ACQUIRE, "agent");
            xb_add(&bar[XB_XGEN(x)], 1u);
            asm volatile("s_waitcnt vmcnt(0)" ::: "memory");
        } else {
            XB_SPIN(xb_ld(&bar[XB_XGEN(x)]) == gen, bar);
            __builtin_amdgcn_fence(__ATOMIC_ACQUIRE, "agent");
            asm volatile("s_waitcnt vmcnt(0)" ::: "memory");
        }
    }
    __syncthreads();
}

constexpr float QS_MLA = 0.10206207261596575f * 1.4426950408889634f;
constexpr float QS_DIFF = 0.17677669529663687f * 1.4426950408889634f;
constexpr float QS_DSA = 0.125f * 1.4426950408889634f;
template <bool OUT_BF16>
__device__ __forceinline__ void rms_rows4(const float* xbase, size_t rstride, const float* g, bf16_t* obase, float* fbase, int lane) {
    f32x4 v[4][4]; float ss[4];
#pragma unroll
    for (int k = 0; k < 4; ++k) { const f32x4* xr = (const f32x4*)(xbase + k * rstride) + lane;
#pragma unroll
        for (int j = 0; j < 4; ++j) v[k][j] = xr[64 * j]; }
#pragma unroll
    for (int k = 0; k < 4; ++k) { float s = 0.f;
#pragma unroll
        for (int j = 0; j < 4; ++j) s += v[k][j].x * v[k][j].x + v[k][j].y * v[k][j].y + v[k][j].z * v[k][j].z + v[k][j].w * v[k][j].w;
        ss[k] = s; }
#pragma unroll
    for (int o = 1; o < 64; o <<= 1) {
#pragma unroll
        for (int k = 0; k < 4; ++k) ss[k] += __shfl_xor(ss[k], o); }
    f32x4 gv[4];
#pragma unroll
    for (int j = 0; j < 4; ++j) gv[j] = ((const f32x4*)g)[lane + 64 * j];
#pragma unroll
    for (int k = 0; k < 4; ++k) { const float r = rsqrtf(ss[k] * (1.f / D) + EPS);
#pragma unroll
        for (int j = 0; j < 4; ++j) {
            const f32x4 o = (f32x4){v[k][j].x * r * gv[j].x, v[k][j].y * r * gv[j].y, v[k][j].z * r * gv[j].z, v[k][j].w * r * gv[j].w};
            if (OUT_BF16) { u32x2 w; w.x = pg8::cvt_pk_bf16(o.x, o.y); w.y = pg8::cvt_pk_bf16(o.z, o.w); ((u32x2*)(obase + k * rstride))[lane + 64 * j] = w; }
            else ((f32x4*)(fbase + k * rstride))[lane + 64 * j] = o;
        } }
}
template <bool OUT_BF16>
__device__ __forceinline__ void rms_rows4b(const bf16_t* xbase, size_t rstride, const float* g, bf16_t* obase, float* fbase, int lane) {
    u16x8 v[4][2]; float ss[4];
#pragma unroll
    for (int k = 0; k < 4; ++k) { const u16x8* xr = (const u16x8*)(xbase + k * rstride) + lane;
#pragma unroll
        for (int j = 0; j < 2; ++j) v[k][j] = xr[64 * j]; }
#pragma unroll
    for (int k = 0; k < 4; ++k) { float s = 0.f;
#pragma unroll
        for (int j = 0; j < 2; ++j)
#pragma unroll
            for (int e = 0; e < 8; ++e) { const float f = bf2f(v[k][j][e]); s += f * f; }
        ss[k] = s; }
#pragma unroll
    for (int o = 1; o < 64; o <<= 1) {
#pragma unroll
        for (int k = 0; k < 4; ++k) ss[k] += __shfl_xor(ss[k], o); }
    f32x4 gv[2][2];
#pragma unroll
    for (int j = 0; j < 2; ++j) { gv[j][0] = ((const f32x4*)g)[2 * lane + 128 * j]; gv[j][1] = ((const f32x4*)g)[2 * lane + 1 + 128 * j]; }
#pragma unroll
    for (int k = 0; k < 4; ++k) { const float r = rsqrtf(ss[k] * (1.f / D) + EPS);
#pragma unroll
        for (int j = 0; j < 2; ++j) {
            f32x4 o0, o1;
#pragma unroll
            for (int e = 0; e < 4; ++e) { o0[e] = bf2f(v[k][j][e]) * r * gv[j][0][e]; o1[e] = bf2f(v[k][j][4 + e]) * r * gv[j][1][e]; }
            if (OUT_BF16) { u32x4 w; w.x = pg8::cvt_pk_bf16(o0[0], o0[1]); w.y = pg8::cvt_pk_bf16(o0[2], o0[3]); w.z = pg8::cvt_pk_bf16(o1[0], o1[1]); w.w = pg8::cvt_pk_bf16(o1[2], o1[3]);
                ((u32x4*)(obase + k * rstride))[lane + 64 * j] = w; }
            else { ((f32x4*)(fbase + k * rstride))[2 * lane + 128 * j] = o0; ((f32x4*)(fbase + k * rstride))[2 * lane + 1 + 128 * j] = o1; }
        } }
}
__device__ __forceinline__ void convert_tile(LAS float* scr, const float* W, bf16_t* Wt, int K, int Nsrc, int remap, float uscale, int k0, int n0, int tid) {
    __syncthreads();
#pragma unroll
    for (int i = 0; i < 8; ++i) { const int e = tid + 512 * i, kk = e >> 6, nn = e & 63, n = n0 + nn;
        const int sc = remap ? orig_col(n) : n;
        float s = uscale;
        if (remap) { if (n >= CB_Q && n < CB_Q + 256) s = QS_DIFF; if (n >= CC_Q && n < CC_Q + 256) s = QS_DSA; }
        scr[kk * 65 + nn] = (sc >= 0) ? W[(size_t)(k0 + kk) * Nsrc + sc] * s : 0.f; }
    __syncthreads();
    { const int nn = tid >> 3, kc = (tid & 7) * 8;
        u32x4 w; w.x = pg8::cvt_pk_bf16(scr[(kc + 0) * 65 + nn], scr[(kc + 1) * 65 + nn]); w.y = pg8::cvt_pk_bf16(scr[(kc + 2) * 65 + nn], scr[(kc + 3) * 65 + nn]);
        w.z = pg8::cvt_pk_bf16(scr[(kc + 4) * 65 + nn], scr[(kc + 5) * 65 + nn]); w.w = pg8::cvt_pk_bf16(scr[(kc + 6) * 65 + nn], scr[(kc + 7) * 65 + nn]);
        *(u32x4*)(Wt + (size_t)(n0 + nn) * K + k0 + kc) = w; }
}
namespace fa {
typedef short ps16x2 __attribute__((ext_vector_type(2)));
typedef unsigned short pu16x2 __attribute__((ext_vector_type(2)));
__device__ __forceinline__ unsigned ppk_lt(unsigned v, unsigned c) { const ps16x2 d = __builtin_elementwise_sub_sat(__builtin_bit_cast(ps16x2, v), __builtin_bit_cast(ps16x2, c)); return __builtin_bit_cast(unsigned, __builtin_bit_cast(pu16x2, d) >> 15); }
__device__ __forceinline__ unsigned ppk_add(unsigned a, unsigned b) { return __builtin_bit_cast(unsigned, __builtin_bit_cast(pu16x2, a) + __builtin_bit_cast(pu16x2, b)); }
typedef float f32x16 __attribute__((ext_vector_type(16)));
typedef short s16x4 __attribute__((ext_vector_type(4)));
typedef short v4i16_t __attribute__((ext_vector_type(4)));
constexpr int KCS = 1040;
constexpr int KBUF = 12 * KCS + 64;
constexpr int L_K0 = 0, L_V0 = 4 * KBUF, L_WSF = L_V0 + 4 * 8192, L_BIAS = L_WSF + 8 * 256, L_END = L_BIAS + 12 * 320 * 4, L_FLAG = L_END;
constexpr float THR = 6.0f;
constexpr float LOG2E = 1.4426950408889634f;
__device__ __forceinline__ int crow(int r, int hi) { return (r & 3) + 8 * (r >> 2) + 4 * hi; }
__device__ __forceinline__ unsigned cvtpk(float lo, float hi) { typedef float f2 __attribute__((ext_vector_type(2))); typedef __bf16 b2 __attribute__((ext_vector_type(2)));
    f2 v = {lo, hi}; b2 r = __builtin_convertvector(v, b2); return __builtin_bit_cast(unsigned, r); }
__device__ __forceinline__ s16x4 vtr(const LAS unsigned char* p) { return __builtin_bit_cast(s16x4, __builtin_amdgcn_ds_read_tr16_b64_v4i16((LAS v4i16_t*)p)); }
__device__ __forceinline__ float max3f(float a, float b, float c) { float r; asm("v_max3_f32 %0, %1, %2, %3" : "=v"(r) : "v"(a), "v"(b), "v"(c)); return r; }
__device__ __forceinline__ float max2f(float a, float b) { float r; asm("v_max_f32_e32 %0, %1, %2" : "=v"(r) : "v"(a), "v"(b)); return r; }
#define FA_ROWMAX(rm, S0, S1) do { asm volatile("s_nop 15\n\ts_nop 7" : "+v"(S0), "+v"(S1)); \
        float a_ = max3f(S0[0], S0[1], S1[0]), b_ = max3f(S0[2], S0[3], S1[1]); a_ = max3f(a_, S1[2], S1[3]); \
        _Pragma("unroll") for (int r = 4; r < 16; r += 4) { a_ = max3f(a_, S0[r], S0[r + 1]); b_ = max3f(b_, S0[r + 2], S0[r + 3]); a_ = max3f(a_, S1[r], S1[r + 1]); b_ = max3f(b_, S1[r + 2], S1[r + 3]); } \
        rm = max2f(a_, b_); } while (0)
__device__ __forceinline__ float xhalf_max(float v) { auto rr = __builtin_amdgcn_permlane32_swap(__float_as_uint(v), __float_as_uint(v), false, false); return fmaxf(__uint_as_float(rr[0]), __uint_as_float(rr[1])); }
__device__ __forceinline__ float xhalf_sum(float v) { auto rr = __builtin_amdgcn_permlane32_swap(__float_as_uint(v), __float_as_uint(v), false, false); return __uint_as_float(rr[0]) + __uint_as_float(rr[1]); }

__device__ __forceinline__ void build_bias(LAS unsigned char* lds, const float* rel_bias) {
    LAS float* bt = (LAS float*)(lds + L_BIAS);
    for (int e = opaque_tid(); e < 12 * 320; e += NTHR) { const int col = e / 320, i = e % 320;
        bt[e] = (rel_bias[rel_bucket(i - 256) * 12 + col] - rel_bias[15 * 12 + col]) * LOG2E; }
}

template <int TYPE>
__device__ __forceinline__ void attn_unit(LAS unsigned char* lds, int b, int h, int qb, int layer) {
    ArgsP A = get_args();
    unsigned char* ws = A->ws;
    const bf16_t* P = (const bf16_t*)(ws + WS_P);
    const int tid = opaque_tid(), lane = tid & 63, r32 = lane & 31, hi = lane >> 5, wid = __builtin_amdgcn_readfirstlane(tid >> 6);
    constexpr int DK = (TYPE == 0) ? 96 : 64, NCH = DK / 8, NPASS = (TYPE == 1) ? 2 : 1, DQ = (TYPE == 0) ? 96 : (TYPE == 1) ? 32 : 64, NQF = DQ / 16;
    const size_t row0 = (size_t)b * S;
    const bf16_t* Kg; const bf16_t* Vg; int kpitch, vpitch;
    if (TYPE == 0) { Kg = (const bf16_t*)(ws + WS_KA) + row0 * 384 + h * 96; kpitch = 384; Vg = (const bf16_t*)(ws + WS_VA) + row0 * 256 + h * 64; vpitch = 256; }
    else { Kg = P + row0 * PC + ((TYPE == 1) ? CB_K : CC_K) + h * 64; kpitch = PC; Vg = P + row0 * PC + ((TYPE == 1) ? CB_V : CC_V) + h * 64; vpitch = PC; }
    const int k0key = tid / NCH, k0ch = tid % NCH;
    const int k1key = (tid + 512) / NCH, k1ch = (tid + 512) % NCH;
    const bool has_k1 = (NCH == 12) && (tid < 256);
    const int vkey = tid >> 3, vc8 = tid & 7;
    const bf16_t* kg0 = Kg + (size_t)k0key * kpitch + k0ch * 8;
    const bf16_t* kg1 = Kg + (size_t)k1key * kpitch + k1ch * 8;
    const bf16_t* vg0 = Vg + (size_t)vkey * vpitch + vc8 * 8;
    const int kl0 = k0ch * KCS + k0key * 16, kl1 = k1ch * KCS + k1key * 16;
    const int vl0 = ((vc8 >> 2) * 4 + (vkey >> 4)) * 1024 + (vkey & 15) * 64 + (vc8 & 3) * 16;
    const int qw = qb * 256 + wid * 32;
    const size_t tq = row0 + qw + r32;
    const int NT = 4 * qb + 4, NTw = 4 * qb + (wid >> 1) + 1, TM = 4 * qb;
    LAS float* wsf = (LAS float*)(lds + L_WSF) + wid * 64;
    const LAS unsigned char* vfb = lds + L_V0 + ((lane >> 4) & 1) * 32 + (lane & 3) * 8 + (4 * hi + ((lane & 15) >> 2)) * 64;
    const unsigned* mrow = (const unsigned*)(ws + WS_MASK) + tq * 128;
    float* okl = (float*)(ws + WS_OKL) + ((size_t)opaque_bid() * 8 + wid) * 2048 + lane;
    f32x16 o0 = f32x16{}, o1 = f32x16{};
    float mhat = 0.f, lsum = 0.f;
    int fast = 1; asm volatile("" : "+s"(fast));
#pragma unroll 1
    for (;;) {
#pragma unroll 1
    for (int mp = 0; mp < NPASS; ++mp) {
    bf16x8 qf[NQF];
#pragma unroll
    for (int d0 = 0; d0 < NQF; ++d0) {
        const bf16_t* qp = (TYPE == 0) ? (const bf16_t*)(ws + WS_QA) + tq * 384 + h * 96 + 16 * d0 + 8 * hi
                                       : P + tq * PC + ((TYPE == 1) ? CB_Q + mp * 32 : CC_Q) + h * 64 + 16 * d0 + 8 * hi;
        qf[d0] = *(const bf16x8*)qp;
    }
    mhat = 0.f; lsum = 0.f; o0 = f32x16{}; o1 = f32x16{};
    const LAS unsigned char* kfb = lds + L_K0 + hi * KCS + r32 * 16 + ((TYPE == 1) ? mp * 4 * KCS : 0);
    const LAS unsigned char* btb = lds + L_BIAS + (256 + 4 * hi - r32 - qw) * 4 + ((TYPE == 1) ? 2 * h + mp : 8 + h) * 1280;
    u32x4 kr0, kr1, vr;
    const bf16_t* kp0 = kg0; const bf16_t* kp1 = kg1; const bf16_t* vp0 = vg0;
    const size_t kstep = (size_t)64 * kpitch, vstep = (size_t)64 * vpitch;
#define FA_BIAS(S0, S1, t) do { if (TYPE != 0) { if (64 * (t) > qw - 154) { const LAS float* bt = (const LAS float*)(btb + (t) * 256); \
            _Pragma("unroll") for (int r = 0; r < 16; ++r) { S0[r] += bt[(r & 3) + 8 * (r >> 2)]; S1[r] += bt[32 + (r & 3) + 8 * (r >> 2)]; } } } } while (0)
#define FA_RESCALE(S0, S1, t) do { if (fast) break; \
        float rm; FA_ROWMAX(rm, S0, S1); \
        rm = xhalf_max(rm); \
        const bool first = ((t) == 0); \
        if (__any(first || rm > THR)) { \
            const float dl = first ? fmaxf(rm, -64.f) : fmaxf(rm, 0.f);     \
            mhat += dl; \
            _Pragma("unroll") for (int r = 0; r < 16; ++r) { S0[r] -= dl; S1[r] -= dl; } \
            if (!first) { const float f = __builtin_amdgcn_exp2f(-dl); lsum *= f; \
                if (hi == 0) wsf[r32] = f; \
                _Pragma("unroll") for (int r = 0; r < 16; ++r) { const float fr_ = wsf[crow(r, hi)]; o0[r] *= fr_; o1[r] *= fr_; } \
                asm volatile("" ::: "memory"); } \
        } } while (0)
#define FA_EXP(S0, S1) do { float sacc = 0.f; \
        _Pragma("unroll") for (int r = 0; r < 16; ++r) { \
            S0[r] = __builtin_amdgcn_exp2f(S0[r]); S1[r] = __builtin_amdgcn_exp2f(S1[r]); \
            sacc += S0[r] + S1[r]; } \
        lsum += sacc; \
        _Pragma("unroll") for (int i = 0; i < 4; ++i) { pw[0][i] = cvtpk(S0[2 * i], S0[2 * i + 1]); pw[1][i] = cvtpk(S0[8 + 2 * i], S0[8 + 2 * i + 1]); \
                                                       pw[2][i] = cvtpk(S1[2 * i], S1[2 * i + 1]); pw[3][i] = cvtpk(S1[8 + 2 * i], S1[8 + 2 * i + 1]); } } while (0)
#define FA_PV() do { \
        _Pragma("unroll") for (int ks = 0; ks < 4; ++ks) { const bf16x8 vfrag = (bf16x8){vlo_[ks][0], vlo_[ks][1], vlo_[ks][2], vlo_[ks][3], vhi_[ks][0], vhi_[ks][1], vhi_[ks][2], vhi_[ks][3]}; \
            o0 = __builtin_amdgcn_mfma_f32_32x32x16_bf16(__builtin_bit_cast(bf16x8, pw[ks]), vfrag, o0, 0, 0, 0); } \
        _Pragma("unroll") for (int i = 0; i < 4; ++i) { vlo_[i] = vtr(vb_ + (4 + i) * 1024); vhi_[i] = vtr(vb_ + (4 + i) * 1024 + 512); } \
        _Pragma("unroll") for (int ks = 0; ks < 4; ++ks) { const bf16x8 vfrag = (bf16x8){vlo_[ks][0], vlo_[ks][1], vlo_[ks][2], vlo_[ks][3], vhi_[ks][0], vhi_[ks][1], vhi_[ks][2], vhi_[ks][3]}; \
            o1 = __builtin_amdgcn_mfma_f32_32x32x16_bf16(__builtin_bit_cast(bf16x8, pw[ks]), vfrag, o1, 0, 0, 0); } } while (0)
#define FA_KLOAD(ks_off) do { const LAS unsigned char* kb_ = kfb + (ks_off); \
        _Pragma("unroll") for (int d0 = 0; d0 < NQF; ++d0) { ka_[d0][0] = *(const LAS bf16x8*)(kb_ + d0 * 2 * KCS); ka_[d0][1] = *(const LAS bf16x8*)(kb_ + d0 * 2 * KCS + 512); } } while (0)
#define FA_QKMFMA(N0, N1, tt, MW0, MW1) do { \
        if (TYPE == 2) { const unsigned w0_ = MW0 >> (4 * hi), w1_ = MW1 >> (4 * hi); const unsigned nm_ = __float_as_uint(-mhat); unsigned neg_ = 0xF149F2CAu; asm volatile("" : "+v"(neg_)); \
            _Pragma("unroll") for (int r = 0; r < 16; ++r) { const int pos_ = (r & 3) + 8 * (r >> 2); \
                const unsigned k0m = (unsigned)((int)(w0_ << (31 - pos_)) >> 31), k1m = (unsigned)((int)(w1_ << (31 - pos_)) >> 31); \
                N0[r] = __uint_as_float(__builtin_amdgcn_bitop3_b32(k0m, nm_, neg_, 0xCA)); N1[r] = __uint_as_float(__builtin_amdgcn_bitop3_b32(k1m, nm_, neg_, 0xCA)); } }     \
        else if (fast) { N0 = __builtin_amdgcn_mfma_f32_32x32x16_bf16(ka_[0][0], qf[0], f32x16{}, 0, 0, 0); N1 = __builtin_amdgcn_mfma_f32_32x32x16_bf16(ka_[0][1], qf[0], f32x16{}, 0, 0, 0); } \
        else { const float nm_ = -mhat; N0 = (f32x16){nm_, nm_, nm_, nm_, nm_, nm_, nm_, nm_, nm_, nm_, nm_, nm_, nm_, nm_, nm_, nm_}; N1 = N0; \
            N0 = __builtin_amdgcn_mfma_f32_32x32x16_bf16(ka_[0][0], qf[0], N0, 0, 0, 0); N1 = __builtin_amdgcn_mfma_f32_32x32x16_bf16(ka_[0][1], qf[0], N1, 0, 0, 0); } \
        _Pragma("unroll") for (int d0 = (TYPE == 2) ? 0 : 1; d0 < NQF; ++d0) { \
            N0 = __builtin_amdgcn_mfma_f32_32x32x16_bf16(ka_[d0][0], qf[d0], N0, 0, 0, 0); \
            N1 = __builtin_amdgcn_mfma_f32_32x32x16_bf16(ka_[d0][1], qf[d0], N1, 0, 0, 0); } } while (0)
#define FA_VLOAD(vs_off) const LAS unsigned char* vb_ = vfb + (vs_off); \
        _Pragma("unroll") for (int i = 0; i < 4; ++i) { vlo_[i] = vtr(vb_ + i * 1024); vhi_[i] = vtr(vb_ + i * 1024 + 512); }
#define FA_MASKW(t)
#define FA_STEP_U(C0, C1, N0, N1, t, vs_off, nks_off, MW0, MW1) do { \
        bf16x8 ka_[NQF][2]; s16x4 vlo_[4], vhi_[4]; u32x4 pw[4]; \
        FA_KLOAD(nks_off); FA_VLOAD(vs_off); FA_MASKW(t); \
        FA_BIAS(C0, C1, t); FA_RESCALE(C0, C1, t); \
        FA_QKMFMA(N0, N1, (t) + 1, MW0, MW1); FA_EXP(C0, C1); FA_PV(); } while (0)
#define FA_STEP_C(C0, C1, N0, N1, t, vs_off, nks_off, MW0, MW1) do { \
        if ((t) + 1 < NTw) { bf16x8 ka_[NQF][2]; FA_KLOAD(nks_off); FA_QKMFMA(N0, N1, (t) + 1, MW0, MW1); } \
        if ((t) < NTw) { s16x4 vlo_[4], vhi_[4]; u32x4 pw[4]; FA_VLOAD(vs_off); FA_MASKW(t); \
            FA_BIAS(C0, C1, t); \
            if (!fast) { float rm; FA_ROWMAX(rm, C0, C1); \
              rm = xhalf_max(rm); \
              const bool first = ((t) == 0); \
              if (__any(first || rm > THR)) { \
                const float dl = first ? fmaxf(rm, -64.f) : fmaxf(rm, 0.f);     \
                mhat += dl; \
                _Pragma("unroll") for (int r = 0; r < 16; ++r) { C0[r] -= dl; C1[r] -= dl; N0[r] -= dl; N1[r] -= dl; } \
                if (!first) { const float f = __builtin_amdgcn_exp2f(-dl); lsum *= f; \
                    if (hi == 0) wsf[r32] = f; \
                    _Pragma("unroll") for (int r = 0; r < 16; ++r) { const float fr_ = wsf[crow(r, hi)]; o0[r] *= fr_; o1[r] *= fr_; } \
                    asm volatile("" ::: "memory"); } } } \
            FA_EXP(C0, C1); FA_PV(); } } while (0)
#define FA_LOADKV(tk, tv) do { if (FA_UNC || (tk) < NT) { kr0 = *(const u32x4*)kp0; if (has_k1) kr1 = *(const u32x4*)kp1; kp0 += kstep; kp1 += kstep; } \
        if (FA_UNC || (tv) < NT) { vr = *(const u32x4*)vp0; vp0 += vstep; } } while (0)
#define FA_COMMIT(tk, kslot, tv, vslot) do { if (FA_UNC || (tk) < NT) { *(LAS u32x4*)(lds + L_K0 + (kslot) + kl0) = kr0; if (has_k1) *(LAS u32x4*)(lds + L_K0 + (kslot) + kl1) = kr1; } \
        if (FA_UNC || (tv) < NT) *(LAS u32x4*)(lds + L_V0 + (vslot) + vl0) = vr; } while (0)
#define FA_UNC 0
    {
        FA_LOADKV(0, 0);
        const u32x4 ka0 = kr0, ka1 = kr1, va = vr;
        FA_LOADKV(1, 1);
        const u32x4 kb0 = kr0, kb1 = kr1, vb = vr;
        FA_LOADKV(2, NT);
        __syncthreads();
        *(LAS u32x4*)(lds + L_K0 + kl0) = ka0; if (has_k1) *(LAS u32x4*)(lds + L_K0 + kl1) = ka1; *(LAS u32x4*)(lds + L_V0 + vl0) = va;
        *(LAS u32x4*)(lds + L_K0 + KBUF + kl0) = kb0; if (has_k1) *(LAS u32x4*)(lds + L_K0 + KBUF + kl1) = kb1; *(LAS u32x4*)(lds + L_V0 + 8192 + vl0) = vb;
        FA_COMMIT(2, 2 * KBUF, NT, 0);
        if (fast && mp == 0 && tid == 0) *(volatile LAS unsigned*)(lds + L_FLAG) = 0u;
    }
    __syncthreads();
    f32x16 sA0, sA1, sB0, sB1;
    unsigned mwA0 = 0u, mwA1 = 0u, mwB0 = 0u, mwB1 = 0u;
#define FA_MLOAD(W0, W1, tt) do { if (TYPE == 2 && (FA_UNC || (tt) < NT)) { W0 = mrow[2 * (tt)]; W1 = mrow[2 * (tt) + 1]; } } while (0)
    FA_MLOAD(mwA0, mwA1, 0); FA_MLOAD(mwB0, mwB1, 1);
    { bf16x8 ka_[NQF][2]; FA_KLOAD(0); FA_QKMFMA(sA0, sA1, 0, mwA0, mwA1); }
    __syncthreads();
#pragma unroll
    for (int r = 0; r < 16; ++r) { sB0[r] = 0.f; sB1[r] = 0.f; }
#define FA_KS(tt) ((((tt)) & 3) * KBUF)
#define FA_VS(tt) ((((tt)) & 3) * 8192)
    int t = 0;
#undef FA_UNC
#define FA_UNC 1
    for (; t < TM; t += 2) {
        FA_LOADKV(t + 3, t + 2); FA_MLOAD(mwA0, mwA1, t + 2);
        FA_STEP_U(sA0, sA1, sB0, sB1, t, FA_VS(t), FA_KS(t + 1), mwB0, mwB1);
        FA_COMMIT(t + 3, FA_KS(t + 3), t + 2, FA_VS(t + 2));
        FA_LOADKV(t + 4, t + 3); FA_MLOAD(mwB0, mwB1, t + 3);
        FA_STEP_U(sB0, sB1, sA0, sA1, t + 1, FA_VS(t + 1), FA_KS(t + 2), mwA0, mwA1);
        FA_COMMIT(t + 4, FA_KS(t + 4), t + 3, FA_VS(t + 3));
        __syncthreads();
    }
#undef FA_UNC
#define FA_UNC 0
    for (; t < NT; t += 2) {
        FA_LOADKV(t + 3, t + 2); FA_MLOAD(mwA0, mwA1, t + 2);
        FA_STEP_C(sA0, sA1, sB0, sB1, t, FA_VS(t), FA_KS(t + 1), mwB0, mwB1);
        FA_COMMIT(t + 3, FA_KS(t + 3), t + 2, FA_VS(t + 2));
        FA_LOADKV(t + 4, t + 3); FA_MLOAD(mwB0, mwB1, t + 3);
        FA_STEP_C(sB0, sB1, sA0, sA1, t + 1, FA_VS(t + 1), FA_KS(t + 2), mwA0, mwA1);
        FA_COMMIT(t + 4, FA_KS(t + 4), t + 3, FA_VS(t + 3));
        __syncthreads();
    }
#undef FA_KS
#undef FA_UNC
#undef FA_MLOAD
#undef FA_VS
#undef FA_BIAS
#undef FA_RESCALE
#undef FA_EXP
#undef FA_PV
#undef FA_KLOAD
#undef FA_QKMFMA
#undef FA_VLOAD
#undef FA_MASKW
#undef FA_STEP_U
#undef FA_STEP_C
#undef FA_LOADKV
#undef FA_COMMIT
    {
        const float lt = xhalf_sum(lsum);
        if (fast) { if (!(lt >= 0x1p-90f && lt <= 0x1p90f)) *(volatile LAS unsigned*)(lds + L_FLAG) = 1u; }
        if (hi == 0) wsf[32 + r32] = __builtin_amdgcn_rcpf(lt);
#pragma unroll
        for (int r = 0; r < 16; ++r) { const float iv = wsf[32 + crow(r, hi)]; o0[r] *= iv; o1[r] *= iv; }
        asm volatile("" ::: "memory");
    }
    if (TYPE == 1 && mp == 0) {
#pragma unroll
        for (int r = 0; r < 16; ++r) { okl[r * 64] = o0[r]; okl[(16 + r) * 64] = o1[r]; }
    }
    }
    if (!fast) break;
    __syncthreads();
    if (__builtin_amdgcn_readfirstlane(*(volatile LAS unsigned*)(lds + L_FLAG)) == 0u) break;
    fast = 0;
    }
    const int gcol = (TYPE == 0) ? CA_G : (TYPE == 1) ? CB_G : CC_G;
    bf16_t* Y = (bf16_t*)(ws + WS_Y);
    float gs0[16], gs1[16];
    {
        bf16_t gr0[16], gr1[16];
#pragma unroll
        for (int r = 0; r < 16; ++r) { const bf16_t* gp = P + (row0 + qw + crow(r, hi)) * PC + gcol + h * 64; gr0[r] = gp[r32]; gr1[r] = gp[32 + r32]; }
#pragma unroll
        for (int r = 0; r < 16; ++r) { const float a0 = bf2f(gr0[r]), a1 = bf2f(gr1[r]);
            gs0[r] = a0 * __builtin_amdgcn_rcpf(1.f + __expf(-a0)); gs1[r] = a1 * __builtin_amdgcn_rcpf(1.f + __expf(-a1)); }
    }
    if (TYPE == 1) {
        const float* lamp = A->dlam + layer * 128;
        float s1 = 0.f, s2 = 0.f;
        for (int i = 0; i < 32; ++i) { s1 += lamp[i] * lamp[32 + i]; s2 += lamp[64 + i] * lamp[96 + i]; }
        const float lambda_init = A->lambda_init[layer];
        const float lam = __expf(s1) - __expf(s2) + lambda_init;
        const float g0 = A->subg[layer * 64 + r32], g1 = A->subg[layer * 64 + 32 + r32];
#pragma unroll
        for (int r = 0; r < 16; ++r) {
            const float v0 = okl[r * 64] - lam * o0[r];
            const float v1 = okl[(16 + r) * 64] - lam * o1[r];
            float ss = v0 * v0 + v1 * v1;
#pragma unroll
            for (int off = 1; off < 32; off <<= 1) ss += __shfl_xor(ss, off);
            const float rr = rsqrtf(ss * (1.f / 64.f) + EPS) * (1.f - lambda_init);
            bf16_t* yp = Y + (row0 + qw + crow(r, hi)) * D + 256 + h * 64;
            yp[r32] = f2bf(v0 * rr * g0 * gs0[r]);
            yp[32 + r32] = f2bf(v1 * rr * g1 * gs1[r]);
        }
    } else {
#pragma unroll
        for (int r = 0; r < 16; ++r) {
            bf16_t* yp = Y + (row0 + qw + crow(r, hi)) * D + TYPE * 256 + h * 64;
            yp[r32] = f2bf(o0[r] * gs0[r]);
            yp[32 + r32] = f2bf(o1[r] * gs1[r]);
        }
    }
}
__device__ __forceinline__ void attn_unit_diff(LAS unsigned char* lds, int b, int h, int qb, int layer) {
    ArgsP A = get_args();
    unsigned char* ws = A->ws;
    const bf16_t* P = (const bf16_t*)(ws + WS_P);
    const int tid = opaque_tid(), lane = tid & 63, r32 = lane & 31, hi = lane >> 5, wid = __builtin_amdgcn_readfirstlane(tid >> 6);
    const size_t row0 = (size_t)b * S;
    const int skey = tid >> 3, sch = tid & 7;
    const bf16_t* kg0 = P + (row0 + skey) * PC + CB_K + h * 64 + sch * 8;
    const bf16_t* vg0 = P + (row0 + skey) * PC + CB_V + h * 64 + sch * 8;
    const int kl0 = sch * KCS + skey * 16;
    const int vl0 = ((sch >> 2) * 4 + (skey >> 4)) * 1024 + (skey & 15) * 64 + (sch & 3) * 16;
    const int qw = qb * 256 + wid * 32;
    const size_t tq = row0 + qw + r32;
    const int NT = 4 * qb + 4, NTw = 4 * qb + (wid >> 1) + 1, TM = 4 * qb;
    LAS float* wsf = (LAS float*)(lds + L_WSF) + wid * 64;
    const LAS unsigned char* vfb = lds + L_V0 + ((lane >> 4) & 1) * 32 + (lane & 3) * 8 + (4 * hi + ((lane & 15) >> 2)) * 64;
    const LAS unsigned char* kfA = lds + L_K0 + hi * KCS + r32 * 16;
    const LAS unsigned char* kfB = kfA + 4 * KCS;
    const LAS unsigned char* btA = lds + L_BIAS + (256 + 4 * hi - r32 - qw) * 4 + (2 * h) * 1280;
    const LAS unsigned char* btB = btA + 1280;
    bf16x8 qA[2], qB[2];
#pragma unroll
    for (int d0 = 0; d0 < 2; ++d0) { qA[d0] = *(const bf16x8*)(P + tq * PC + CB_Q + h * 64 + 16 * d0 + 8 * hi); qB[d0] = *(const bf16x8*)(P + tq * PC + CB_Q + 32 + h * 64 + 16 * d0 + 8 * hi); }
    f32x16 oA0, oA1, oB0, oB1;
    float mA, mB, lA, lB;
    const size_t tstep = (size_t)64 * PC;
    int fast = 1; asm volatile("" : "+s"(fast));
#define DF_KS(tt) ((((tt)) & 3) * KBUF)
#define DF_VS(tt) ((((tt)) & 3) * 8192)
#define DF_QK(N0, N1, KF, ks_off, QF, MH) do { const LAS unsigned char* kb_ = (KF) + (ks_off); \
        const bf16x8 k00 = *(const LAS bf16x8*)kb_, k01 = *(const LAS bf16x8*)(kb_ + 512), k10 = *(const LAS bf16x8*)(kb_ + 2 * KCS), k11 = *(const LAS bf16x8*)(kb_ + 2 * KCS + 512); \
        if (fast) { N0 = __builtin_amdgcn_mfma_f32_32x32x16_bf16(k00, QF[0], f32x16{}, 0, 0, 0); N1 = __builtin_amdgcn_mfma_f32_32x32x16_bf16(k01, QF[0], f32x16{}, 0, 0, 0); } \
        else { const float nm_ = -(MH); N0 = (f32x16){nm_, nm_, nm_, nm_, nm_, nm_, nm_, nm_, nm_, nm_, nm_, nm_, nm_, nm_, nm_, nm_}; N1 = N0; \
            N0 = __builtin_amdgcn_mfma_f32_32x32x16_bf16(k00, QF[0], N0, 0, 0, 0); N1 = __builtin_amdgcn_mfma_f32_32x32x16_bf16(k01, QF[0], N1, 0, 0, 0); } \
        N0 = __builtin_amdgcn_mfma_f32_32x32x16_bf16(k10, QF[1], N0, 0, 0, 0); N1 = __builtin_amdgcn_mfma_f32_32x32x16_bf16(k11, QF[1], N1, 0, 0, 0); } while (0)
#define DF_SOFTMAX(S0, S1, O0, O1, MH, LS, BT, WOFF, t, PW) do { \
        if (64 * (t) > qw - 154) { const LAS float* bt = (const LAS float*)((BT) + (t) * 256); \
            _Pragma("unroll") for (int r = 0; r < 16; ++r) { S0[r] += bt[(r & 3) + 8 * (r >> 2)]; S1[r] += bt[32 + (r & 3) + 8 * (r >> 2)]; } } \
        if (!fast) { float rm; FA_ROWMAX(rm, S0, S1); rm = xhalf_max(rm); const bool first = ((t) == 0); \
            if (__any(first || rm > THR)) { const float dl = first ? fmaxf(rm, -64.f) : fmaxf(rm, 0.f); MH += dl; \
                _Pragma("unroll") for (int r = 0; r < 16; ++r) { S0[r] -= dl; S1[r] -= dl; } \
                if (!first) { const float f = __builtin_amdgcn_exp2f(-dl); LS *= f; if (hi == 0) wsf[(WOFF) + r32] = f; \
                    _Pragma("unroll") for (int r = 0; r < 16; ++r) { const float fr_ = wsf[(WOFF) + crow(r, hi)]; O0[r] *= fr_; O1[r] *= fr_; } \
                    asm volatile("" ::: "memory"); } } } \
        { float sacc = 0.f; \
          _Pragma("unroll") for (int r = 0; r < 16; ++r) { S0[r] = __builtin_amdgcn_exp2f(S0[r]); S1[r] = __builtin_amdgcn_exp2f(S1[r]); sacc += S0[r] + S1[r]; } \
          LS += sacc; } \
        _Pragma("unroll") for (int i = 0; i < 4; ++i) { PW[0][i] = cvtpk(S0[2 * i], S0[2 * i + 1]); PW[1][i] = cvtpk(S0[8 + 2 * i], S0[8 + 2 * i + 1]); \
                                                       PW[2][i] = cvtpk(S1[2 * i], S1[2 * i + 1]); PW[3][i] = cvtpk(S1[8 + 2 * i], S1[8 + 2 * i + 1]); } } while (0)
#define DF_VLOAD(vs_off, G0) do { const LAS unsigned char* vb_ = vfb + (vs_off); \
        _Pragma("unroll") for (int i = 0; i < 4; ++i) { vlo_[i] = vtr(vb_ + ((G0) + i) * 1024); vhi_[i] = vtr(vb_ + ((G0) + i) * 1024 + 512); } } while (0)
#define DF_PV(O0, O1, PW, vs_off) do { \
        DF_VLOAD(vs_off, 0); \
        _Pragma("unroll") for (int ks = 0; ks < 4; ++ks) { const bf16x8 vf = (bf16x8){vlo_[ks][0], vlo_[ks][1], vlo_[ks][2], vlo_[ks][3], vhi_[ks][0], vhi_[ks][1], vhi_[ks][2], vhi_[ks][3]}; \
            O0 = __builtin_amdgcn_mfma_f32_32x32x16_bf16(__builtin_bit_cast(bf16x8, PW[ks]), vf, O0, 0, 0, 0); } \
        DF_VLOAD(vs_off, 4); \
        _Pragma("unroll") for (int ks = 0; ks < 4; ++ks) { const bf16x8 vf = (bf16x8){vlo_[ks][0], vlo_[ks][1], vlo_[ks][2], vlo_[ks][3], vhi_[ks][0], vhi_[ks][1], vhi_[ks][2], vhi_[ks][3]}; \
            O1 = __builtin_amdgcn_mfma_f32_32x32x16_bf16(__builtin_bit_cast(bf16x8, PW[ks]), vf, O1, 0, 0, 0); } } while (0)
#define DF_STEP(COND, t) do { \
        if (!(COND) || (t) + 2 < NT) { kr = *(const u32x4*)kp; kp += tstep; } \
        if (!(COND) || (t) + 1 < NT) { vr = *(const u32x4*)vp; vp += tstep; } \
        if (!(COND) || (t) < NTw) { s16x4 vlo_[4], vhi_[4]; u32x4 pw[4]; \
            DF_QK(sB0, sB1, kfB, DF_KS(t), qB, mB); \
            DF_SOFTMAX(sA0, sA1, oA0, oA1, mA, lA, btA, 0, t, pw); \
            DF_PV(oA0, oA1, pw, DF_VS(t)); \
            DF_SOFTMAX(sB0, sB1, oB0, oB1, mB, lB, btB, 32, t, pw); \
            if (!(COND) || (t) + 1 < NTw) DF_QK(sA0, sA1, kfA, DF_KS((t) + 1), qA, mA); \
            DF_PV(oB0, oB1, pw, DF_VS(t)); } \
        if (!(COND) || (t) + 2 < NT) *(LAS u32x4*)(lds + L_K0 + DF_KS((t) + 2) + kl0) = kr; \
        if (!(COND) || (t) + 1 < NT) *(LAS u32x4*)(lds + L_V0 + DF_VS((t) + 1) + vl0) = vr; \
        __syncthreads(); } while (0)
#pragma unroll 1
    for (;;) {
        mA = 0.f; mB = 0.f; lA = 0.f; lB = 0.f; oA0 = f32x16{}; oA1 = f32x16{}; oB0 = f32x16{}; oB1 = f32x16{};
        const bf16_t* kp = kg0; const bf16_t* vp = vg0;
        u32x4 kr, vr;
        {
            const u32x4 ka = *(const u32x4*)kp; kp += tstep; const u32x4 va = *(const u32x4*)vp; vp += tstep; const u32x4 kb = *(const u32x4*)kp; kp += tstep;
            __syncthreads();
            *(LAS u32x4*)(lds + L_K0 + kl0) = ka; *(LAS u32x4*)(lds + L_V0 + vl0) = va; *(LAS u32x4*)(lds + L_K0 + KBUF + kl0) = kb;
            if (fast && tid == 0) *(volatile LAS unsigned*)(lds + L_FLAG) = 0u;
        }
        __syncthreads();
        f32x16 sA0, sA1, sB0, sB1;
        DF_QK(sA0, sA1, kfA, 0, qA, mA);
#pragma unroll
        for (int r = 0; r < 16; ++r) { sB0[r] = 0.f; sB1[r] = 0.f; }
        int t = 0;
        _Pragma("unroll 1") for (; t < TM; ++t) { DF_STEP(false, t); }
        _Pragma("unroll 1") for (; t < NT; ++t) { DF_STEP(true, t); }
        {
            const float ltA = xhalf_sum(lA), ltB = xhalf_sum(lB);
            if (fast) { if (!(ltA >= 0x1p-90f && ltA <= 0x1p90f && ltB >= 0x1p-90f && ltB <= 0x1p90f)) *(volatile LAS unsigned*)(lds + L_FLAG) = 1u; }
            if (hi == 0) { wsf[r32] = __builtin_amdgcn_rcpf(ltA); wsf[32 + r32] = __builtin_amdgcn_rcpf(ltB); }
#pragma unroll
            for (int r = 0; r < 16; ++r) { const float ia = wsf[crow(r, hi)], ib = wsf[32 + crow(r, hi)]; oA0[r] *= ia; oA1[r] *= ia; oB0[r] *= ib; oB1[r] *= ib; }
            asm volatile("" ::: "memory");
        }
        if (!fast) break;
        __syncthreads();
        if (__builtin_amdgcn_readfirstlane(*(volatile LAS unsigned*)(lds + L_FLAG)) == 0u) break;
        fast = 0;
    }
#undef DF_STEP
#undef DF_PV
#undef DF_VLOAD
#undef DF_SOFTMAX
#undef DF_QK
#undef DF_KS
#undef DF_VS
    bf16_t* Y = (bf16_t*)(ws + WS_Y);
    float gs0[16], gs1[16];
    {
        bf16_t gr0[16], gr1[16];
#pragma unroll
        for (int r = 0; r < 16; ++r) { const bf16_t* gp = P + (row0 + qw + crow(r, hi)) * PC + CB_G + h * 64; gr0[r] = gp[r32]; gr1[r] = gp[32 + r32]; }
#pragma unroll
        for (int r = 0; r < 16; ++r) { const float a0 = bf2f(gr0[r]), a1 = bf2f(gr1[r]);
            gs0[r] = a0 * __builtin_amdgcn_rcpf(1.f + __expf(-a0)); gs1[r] = a1 * __builtin_amdgcn_rcpf(1.f + __expf(-a1)); }
    }
    {
        const float* lamp = A->dlam + layer * 128;
        float s1 = 0.f, s2 = 0.f;
        for (int i = 0; i < 32; ++i) { s1 += lamp[i] * lamp[32 + i]; s2 += lamp[64 + i] * lamp[96 + i]; }
        const float lambda_init = A->lambda_init[layer];
        const float lam = __expf(s1) - __expf(s2) + lambda_init;
        const float g0 = A->subg[layer * 64 + r32], g1 = A->subg[layer * 64 + 32 + r32];
#pragma unroll
        for (int r = 0; r < 16; ++r) {
            const float v0 = oA0[r] - lam * oB0[r];
            const float v1 = oA1[r] - lam * oB1[r];
            float ss = v0 * v0 + v1 * v1;
#pragma unroll
            for (int off = 1; off < 32; off <<= 1) ss += __shfl_xor(ss, off);
            const float rr = rsqrtf(ss * (1.f / 64.f) + EPS) * (1.f - lambda_init);
            bf16_t* yp = Y + (row0 + qw + crow(r, hi)) * D + 256 + h * 64;
            yp[r32] = f2bf(v0 * rr * g0 * gs0[r]);
            yp[32 + r32] = f2bf(v1 * rr * g1 * gs1[r]);
        }
    }
}
}

namespace sel {
__device__ __forceinline__ float relu_s(float x) { const int i = __builtin_bit_cast(int, x); return __builtin_bit_cast(float, i > 0 ? i : 0); }
}

namespace sel2 {
typedef float f32x16 __attribute__((ext_vector_type(16)));
typedef short s16x2 __attribute__((ext_vector_type(2)));
typedef unsigned short u16x2 __attribute__((ext_vector_type(2)));
__device__ __forceinline__ unsigned pk_lt(unsigned v, unsigned c) {
    const s16x2 d = __builtin_elementwise_sub_sat(__builtin_bit_cast(s16x2, v), __builtin_bit_cast(s16x2, c));
    return __builtin_bit_cast(unsigned, __builtin_bit_cast(u16x2, d) >> 15);
}
__device__ __forceinline__ unsigned pk_add(unsigned a, unsigned b) { return __builtin_bit_cast(unsigned, __builtin_bit_cast(u16x2, a) + __builtin_bit_cast(u16x2, b)); }
__device__ __forceinline__ unsigned half_sum(unsigned x) {
    x = pk_add(x, (unsigned)__builtin_amdgcn_update_dpp(0, (int)x, 0xB1, 0xf, 0xf, false));
    x = pk_add(x, (unsigned)__builtin_amdgcn_update_dpp(0, (int)x, 0x4E, 0xf, 0xf, false));
    x = pk_add(x, (unsigned)__builtin_amdgcn_update_dpp(0, (int)x, 0x141, 0xf, 0xf, false));
    x = pk_add(x, (unsigned)__builtin_amdgcn_update_dpp(0, (int)x, 0x140, 0xf, 0xf, false));
    x = pk_add(x, (unsigned)__builtin_amdgcn_ds_swizzle((int)x, 0x401F));
    return x;
}
__device__ __forceinline__ float mul_s(float a, float b) { float d; asm("v_mul_f32_e32 %0, %1, %2" : "=v"(d) : "v"(a), "v"(b)); return d; }
__device__ __forceinline__ float fma_s(float a, float b, float c) { float d; asm("v_fma_f32 %0, %1, %2, %3" : "=v"(d) : "v"(a), "v"(b), "v"(c)); return d; }
__device__ __forceinline__ void select_unit(LAS unsigned char* lds, int b, int c, int half) {
    ArgsP A = get_args();
    unsigned char* ws = A->ws;
    const bf16_t* P = (const bf16_t*)(ws + WS_P);
    unsigned* MASK = (unsigned*)(ws + WS_MASK);
    const int tid = opaque_tid(), lane = tid & 63, r32 = lane & 31, hi = lane >> 5; const int wid = __builtin_amdgcn_readfirstlane(tid >> 6);
    const int ni = c + 1, nb = 2 * ni;
    const size_t tq0 = (size_t)b * S + 64 * c + 32 * half + 4 * wid;
    if (c <= 3) {
        for (int e = lane; e < 4 * nb; e += 64) MASK[(tq0 + e / nb) * 128 + e % nb] = 0xffffffffu;
        return;
    }
    int nkeys_v = 64 * ni; asm volatile("" : "+v"(nkeys_v));
    unsigned vals[64];
    LAS unsigned* ldsv = (LAS unsigned*)lds + wid * 4096 + lane;
#define SVAL(blk) (((blk) < 64) ? vals[(blk) & 63] : ldsv[(((blk) - 64) & 63) * 64])
    {
        const int ql = 2 * ((r32 >> 2) & 1) + (r32 >> 4), hh = ((r32 >> 3) & 1) * 4 + (r32 & 3);
        const bf16x8 af0 = *(const bf16x8*)(P + (tq0 + ql) * PC + CC_QI + hh * 32 + 8 * hi), af1 = *(const bf16x8*)(P + (tq0 + ql) * PC + CC_QI + hh * 32 + 16 + 8 * hi);
        const float idx_scale = 0.35355339059327373f * 0.17677669529663687f * 0.125f;
        float wv[16];
#pragma unroll
        for (int qh = 0; qh < 2; ++qh) { const u16x8 w8 = *(const u16x8*)(P + (tq0 + 2 * hi + qh) * PC + CC_WI);
#pragma unroll
            for (int e = 0; e < 8; ++e) wv[8 * qh + e] = bf2f(w8[e]) * idx_scale; }
        const bf16_t* kgl = P + ((size_t)b * S) * PC + CC_KI;
        LAS unsigned char* kch = lds + 131072;
        const int sk0 = tid >> 2, sq = tid & 3;
        const bf16_t* sg = kgl + (size_t)sk0 * PC + sq * 8;
        const int sl0 = sk0 * 64 + ((sq ^ ((sk0 >> 2) & 3)) * 16), sl1 = sl0 + 128 * 64;
        const int sw = (r32 >> 2) & 3;
        const LAS unsigned char* rd0 = kch + r32 * 64 + ((hi ^ sw) * 16);
        const LAS unsigned char* rd1 = kch + r32 * 64 + (((2 + hi) ^ sw) * 16);
        bf16x8 afc[2][2] = {{af0, af1}, {af0, af1}};
        u32x4 st0 = *(const u32x4*)sg, st1 = *(const u32x4*)(sg + (size_t)128 * PC);
        const int ngc = 2 * ((nb + 15) >> 4);
#define SEL_BAR() do { asm volatile("s_waitcnt lgkmcnt(0)" ::: "memory"); __builtin_amdgcn_s_barrier(); asm volatile("" ::: "memory"); } while (0)
#pragma unroll
        for (int g = 0; g < 16; ++g) if (g < ngc) {
            SEL_BAR();
            *(LAS u32x4*)(kch + sl0) = st0; *(LAS u32x4*)(kch + sl1) = st1;
            SEL_BAR();
            if (g + 1 < ngc) { st0 = *(const u32x4*)(sg + (size_t)(256 * (g + 1)) * PC); st1 = *(const u32x4*)(sg + (size_t)(256 * (g + 1) + 128) * PC); }
            bf16x8 pb[2][2];
            pb[0][0] = *(const LAS bf16x8*)rd0; pb[0][1] = *(const LAS bf16x8*)rd1;
#pragma unroll
            for (int jb = 0; jb < 8; ++jb) { const int blk = 8 * g + jb;
                if (jb + 1 < 8) { pb[(jb + 1) & 1][0] = *(const LAS bf16x8*)(rd0 + (jb + 1) * 2048); pb[(jb + 1) & 1][1] = *(const LAS bf16x8*)(rd1 + (jb + 1) * 2048); }
                f32x16 acc = f32x16{};
                acc = __builtin_amdgcn_mfma_f32_32x32x16_bf16(afc[blk & 1][0], pb[jb & 1][0], acc, 0, 0, 0);
                acc = __builtin_amdgcn_mfma_f32_32x32x16_bf16(afc[blk & 1][1], pb[jb & 1][1], acc, 0, 0, 0);
                float pr_[16];
#pragma unroll
                for (int r = 0; r < 16; ++r) pr_[r] = sel::relu_s(acc[r]);
                float v0 = mul_s(wv[0], pr_[0]), v1 = mul_s(wv[8], pr_[8]);
#pragma unroll
                for (int e = 1; e < 8; ++e) { v0 = fma_s(wv[e], pr_[e], v0); v1 = fma_s(wv[8 + e], pr_[8 + e], v1); }
                unsigned sv_ = __builtin_bit_cast(unsigned, __builtin_amdgcn_cvt_pknorm_i16(v0, v1));
                if (8 * g + 8 > nb) sv_ = (32 * blk + r32 < nkeys_v) ? sv_ : 0x80008000u;
                asm volatile("" : "+v"(afc[blk & 1][0]) : "v"(sv_));
                if (blk < 64) vals[blk & 63] = sv_; else ldsv[((blk - 64) & 63) * 64] = sv_;
            }
        }
        SEL_BAR();
#undef SEL_BAR
    }
    const int ng16 = (nb + 15) >> 4;
    const unsigned total = (unsigned)ng16 * 512u;
#define SEL2_COUNT_LT(res, c2) do { unsigned a0_ = 0u, a1_ = 0u, a2_ = 0u, a3_ = 0u; \
        _Pragma("unroll") for (int g = 0; g < 8; ++g) if (g < ng16) { \
            unsigned sv_[16]; _Pragma("unroll") for (int j = 0; j < 16; ++j) sv_[j] = SVAL(16 * g + j); \
            __builtin_amdgcn_sched_barrier(0); \
            s16x2 dd_[16]; _Pragma("unroll") for (int j = 0; j < 16; ++j) dd_[j] = __builtin_elementwise_sub_sat(__builtin_bit_cast(s16x2, sv_[j]), __builtin_bit_cast(s16x2, (unsigned)(c2))); \
            __builtin_amdgcn_sched_barrier(0); \
            u16x2 ss_[16]; _Pragma("unroll") for (int j = 0; j < 16; ++j) ss_[j] = __builtin_bit_cast(u16x2, dd_[j]) >> 15; \
            __builtin_amdgcn_sched_barrier(0); \
            _Pragma("unroll") for (int j = 0; j < 8; ++j) ss_[j] += ss_[j + 8]; \
            __builtin_amdgcn_sched_barrier(0); \
            _Pragma("unroll") for (int j = 0; j < 4; ++j) ss_[j] += ss_[j + 4]; \
            __builtin_amdgcn_sched_barrier(0); \
            a0_ = pk_add(a0_, __builtin_bit_cast(unsigned, ss_[0])); a1_ = pk_add(a1_, __builtin_bit_cast(unsigned, ss_[1])); a2_ = pk_add(a2_, __builtin_bit_cast(unsigned, ss_[2])); a3_ = pk_add(a3_, __builtin_bit_cast(unsigned, ss_[3])); \
            __builtin_amdgcn_sched_barrier(0); } \
        res = half_sum(pk_add(pk_add(a0_, a1_), pk_add(a2_, a3_))); } while (0)
    unsigned Tu2 = 0u;
    unsigned cge_lo = total, cge_hi = total;
#pragma unroll 1
    for (int bit = 15; bit >= 0; --bit) {
        const unsigned cand2 = Tu2 | ((1u << bit) * 0x10001u);
        unsigned clt; SEL2_COUNT_LT(clt, cand2 ^ 0x80008000u);
        const unsigned g_lo = total - (clt & 0xffffu), g_hi = total - (clt >> 16);
        if (g_lo >= 256u) { Tu2 = (Tu2 & 0xffff0000u) | (cand2 & 0x0000ffffu); cge_lo = g_lo; }
        if (g_hi >= 256u) { Tu2 = (Tu2 & 0x0000ffffu) | (cand2 & 0xffff0000u); cge_hi = g_hi; }
        if (__all((cge_lo == 256u) && (cge_hi == 256u))) break;
    }
    const unsigned Ts2 = Tu2 ^ 0x80008000u;
    const bool anytie = __any((cge_lo != 256u) || (cge_hi != 256u));
    LAS unsigned* m0 = (LAS unsigned*)(lds + 131072) + wid * 512; LAS unsigned* m1 = m0 + 128; LAS unsigned* m2 = m0 + 256; LAS unsigned* m3 = m0 + 384;
    if (!anytie) {
#pragma unroll
        for (int g = 0; g < 8; ++g) if (g < ng16)
#pragma unroll
        for (int jb = 0; jb < 16; ++jb) { const int blk = 16 * g + jb;
            const unsigned d = __builtin_bit_cast(unsigned, __builtin_elementwise_sub_sat(__builtin_bit_cast(s16x2, SVAL(blk)), __builtin_bit_cast(s16x2, Ts2)));
            const unsigned long long bl = __ballot((d & 0x8000u) == 0u), bh = __ballot((int)d >= 0);
            if (lane == 0) { m0[blk] = (unsigned)bl; m2[blk] = (unsigned)(bl >> 32); m1[blk] = (unsigned)bh; m3[blk] = (unsigned)(bh >> 32); }
        }
    } else {
        const s16x2 tp1 = __builtin_elementwise_add_sat(__builtin_bit_cast(s16x2, Ts2), (s16x2){1, 1});
        unsigned clt_u; SEL2_COUNT_LT(clt_u, __builtin_bit_cast(unsigned, tp1));
        const int cgt_lo = ((Ts2 & 0xffffu) == 0x7fffu) ? 0 : (int)(total - (clt_u & 0xffffu)), cgt_hi = ((Ts2 >> 16) == 0x7fffu) ? 0 : (int)(total - (clt_u >> 16));
        const int need_lo = 256 - cgt_lo, need_hi = 256 - cgt_hi;
        int taken_lo = 0, taken_hi = 0;
#pragma unroll
        for (int g = 0; g < 8; ++g) if (g < ng16)
#pragma unroll
        for (int jb = 0; jb < 16; ++jb) { const int blk = 16 * g + jb;
            const unsigned d = __builtin_bit_cast(unsigned, __builtin_elementwise_sub_sat(__builtin_bit_cast(s16x2, SVAL(blk)), __builtin_bit_cast(s16x2, Ts2)));
            const bool eq_lo = ((d & 0xffffu) == 0u), eq_hi = ((d >> 16) == 0u);
            const bool gt_lo = !eq_lo && ((d & 0x8000u) == 0u), gt_hi = !eq_hi && ((int)d >= 0);
            const unsigned long long el = __ballot(eq_lo), eh = __ballot(eq_hi);
            const int cl0 = __popc((unsigned)el), cl1 = __popc((unsigned)(el >> 32)), ch0 = __popc((unsigned)eh), ch1 = __popc((unsigned)(eh >> 32));
            const int pre_lo = (int)__builtin_amdgcn_mbcnt_hi((unsigned)(el >> 32), __builtin_amdgcn_mbcnt_lo((unsigned)el, 0u)) - (hi ? cl0 : 0);
            const int pre_hi = (int)__builtin_amdgcn_mbcnt_hi((unsigned)(eh >> 32), __builtin_amdgcn_mbcnt_lo((unsigned)eh, 0u)) - (hi ? ch0 : 0);
            const bool s_lo = gt_lo || (eq_lo && (taken_lo + pre_lo) < need_lo), s_hi = gt_hi || (eq_hi && (taken_hi + pre_hi) < need_hi);
            taken_lo += hi ? cl1 : cl0; taken_hi += hi ? ch1 : ch0;
            const unsigned long long bl = __ballot(s_lo), bh = __ballot(s_hi);
            if (lane == 0) { m0[blk] = (unsigned)bl; m2[blk] = (unsigned)(bl >> 32); m1[blk] = (unsigned)bh; m3[blk] = (unsigned)(bh >> 32); }
        }
    }
    asm volatile("s_waitcnt lgkmcnt(0)" ::: "memory");
#pragma unroll
    for (int q = 0; q < 4; ++q)
#pragma unroll
        for (int hf = 0; hf < 2; ++hf) { const int bw = lane + 64 * hf; if (bw < nb) MASK[(tq0 + q) * 128 + bw] = m0[q * 128 + bw]; }
#undef SEL2_COUNT_LT
#undef SVAL
}
}

namespace mp {
constexpr int AQ_STRIDE = 528, AKV_STRIDE = 272, L_AQ = 0, L_AKV = 128 * AQ_STRIDE;
constexpr int L_RK = L_AKV + 128 * AKV_STRIDE;
constexpr int ST_STRIDE = 208, L_ST = L_RK + 128 * 64;
__device__ __forceinline__ void stage4(LAS unsigned char* p, const f32x4 v) { u32x2 w; w.x = pg8::cvt_pk_bf16(v[0], v[1]); w.y = pg8::cvt_pk_bf16(v[2], v[3]); *(LAS u32x2*)p = w; }
__device__ __forceinline__ void store4(bf16_t* p, const f32x4 v) { uint2 w; w.x = pg8::cvt_pk_bf16(v[0], v[1]); w.y = pg8::cvt_pk_bf16(v[2], v[3]); *(uint2*)p = w; }
template <int CTRL> __device__ __forceinline__ float dppf(float v) { return __builtin_bit_cast(float, __builtin_amdgcn_update_dpp(0, __builtin_bit_cast(int, v), CTRL, 0xf, 0xf, false)); }
__device__ __forceinline__ float wave_sum64(float v) {
    v += dppf<0xB1>(v); v += dppf<0x4E>(v); v += dppf<0x141>(v); v += dppf<0x140>(v);
    v += __builtin_bit_cast(float, __builtin_amdgcn_ds_swizzle(__builtin_bit_cast(int, v), 0x401F));
    return fa::xhalf_sum(v);
}
__device__ __forceinline__ void mla_prep_unit(LAS unsigned char* lds, int tile, int l) {
    ArgsP A = get_args();
    unsigned char* ws = A->ws;
    const bf16_t* P = (const bf16_t*)(ws + WS_P);
    const float* ROPE = (const float*)(ws + WS_ROPE);
    bf16_t* QA = (bf16_t*)(ws + WS_QA); bf16_t* KA = (bf16_t*)(ws + WS_KA); bf16_t* VA = (bf16_t*)(ws + WS_VA);
    const int tid = opaque_tid(), lane = tid & 63, fr = lane & 15, fq = lane >> 4, wid = __builtin_amdgcn_readfirstlane(tid >> 6);
    const size_t t0 = (size_t)tile * 128;
    const int h = wid >> 1, half = wid & 1;
    bf16x8 wq[8][3];
    {
        const bf16_t* W = (const bf16_t*)(ws + WS_WTUQ) + (size_t)l * 384 * 256 + (size_t)(48 * wid + fr) * 256 + 8 * fq;
#pragma unroll
        for (int ks = 0; ks < 8; ++ks)
#pragma unroll
            for (int nf = 0; nf < 3; ++nf) wq[ks][nf] = *(const bf16x8*)(W + (size_t)(16 * nf) * 256 + 32 * ks);
    }
    __syncthreads();
    {
        const float* qg = A->qa_g + l * 256; const float* kg = A->kva_g + l * 128;
        float gq[4], gk[4];
#pragma unroll
        for (int j = 0; j < 4; ++j) { gq[j] = qg[4 * lane + j]; gk[j] = kg[(4 * lane + j) & 127]; }
#pragma unroll 1
        for (int bt = 0; bt < 4; ++bt) {
            uint2 cq[4], ck[4]; bf16_t kr1[4], kr2[4]; float rcs[4], rsn[4];
#pragma unroll
            for (int i = 0; i < 4; ++i) {
                const int row = 16 * wid + 4 * bt + i; const size_t t = t0 + row;
                const bf16_t* p = P + t * PC;
                cq[i] = *(const uint2*)(p + CA_CQ + 4 * lane);
                ck[i] = *(const uint2*)(p + CA_CKV + 4 * (lane & 31));
                if (lane < 16) { const int pos = (int)(t % S); kr1[i] = p[CA_KR + lane]; kr2[i] = p[CA_KR + 16 + lane]; rcs[i] = ROPE[pos * 16 + lane]; rsn[i] = ROPE[S * 16 + pos * 16 + lane]; }
            }
#pragma unroll
            for (int i = 0; i < 4; ++i) {
                const int row = 16 * wid + 4 * bt + i; const size_t t = t0 + row;
                float a[4] = {bf2f((bf16_t)(cq[i].x & 0xffff)), bf2f((bf16_t)(cq[i].x >> 16)), bf2f((bf16_t)(cq[i].y & 0xffff)), bf2f((bf16_t)(cq[i].y >> 16))};
                float c[4] = {bf2f((bf16_t)(ck[i].x & 0xffff)), bf2f((bf16_t)(ck[i].x >> 16)), bf2f((bf16_t)(ck[i].y & 0xffff)), bf2f((bf16_t)(ck[i].y >> 16))};
                float sa = a[0] * a[0] + a[1] * a[1] + a[2] * a[2] + a[3] * a[3];
                float sb = (lane < 32) ? (c[0] * c[0] + c[1] * c[1] + c[2] * c[2] + c[3] * c[3]) : 0.f;
                sa = wave_sum64(sa); sb = wave_sum64(sb);
                const float ra = rsqrtf(sa * (1.f / 256.f) + EPS), rb = rsqrtf(sb * (1.f / 128.f) + EPS);
                u32x2 w; w.x = pg8::cvt_pk_bf16(a[0] * ra * gq[0], a[1] * ra * gq[1]); w.y = pg8::cvt_pk_bf16(a[2] * ra * gq[2], a[3] * ra * gq[3]);
                *(LAS u32x2*)(lds + L_AQ + row * AQ_STRIDE + 8 * lane) = w;
                if (lane < 32) { u32x2 v; v.x = pg8::cvt_pk_bf16(c[0] * rb * gk[0], c[1] * rb * gk[1]); v.y = pg8::cvt_pk_bf16(c[2] * rb * gk[2], c[3] * rb * gk[3]);
                    *(LAS u32x2*)(lds + L_AKV + row * AKV_STRIDE + 8 * lane) = v; }
                if (lane < 16) {
                    const float k1 = bf2f(kr1[i]), k2 = bf2f(kr2[i]);
                    const bf16_t o1 = f2bf(k1 * rcs[i] - k2 * rsn[i]), o2 = f2bf(k2 * rcs[i] + k1 * rsn[i]);
                    LAS bf16_t* rk = (LAS bf16_t*)(lds + L_RK + row * 64); rk[lane] = o1; rk[16 + lane] = o2;
                }
            }
        }
    }
    __syncthreads();
    f32x4 acc[8][3];
#pragma unroll
    for (int mi = 0; mi < 8; ++mi)
#pragma unroll
        for (int nf = 0; nf < 3; ++nf) acc[mi][nf] = (f32x4){0.f, 0.f, 0.f, 0.f};
#pragma unroll
    for (int ks = 0; ks < 8; ++ks) {
#pragma unroll
        for (int mi = 0; mi < 8; ++mi) {
            const bf16x8 xf = *(const LAS bf16x8*)(lds + L_AQ + (16 * mi + fr) * AQ_STRIDE + 64 * ks + 16 * fq);
#pragma unroll
            for (int nf = 0; nf < 3; ++nf) acc[mi][nf] = __builtin_amdgcn_mfma_f32_16x16x32_bf16(wq[ks][nf], xf, acc[mi][nf], 0, 0, 0);
        }
    }
    __builtin_amdgcn_sched_barrier(0);
    bf16x8 wkv[4][4];
    {
        const bf16_t* W = (const bf16_t*)(ws + WS_WTUKV) + (size_t)l * 512 * 128 + (size_t)(64 * wid + fr) * 128 + 8 * fq;
#pragma unroll
        for (int ks = 0; ks < 4; ++ks)
#pragma unroll
            for (int nf = 0; nf < 4; ++nf) wkv[ks][nf] = *(const bf16x8*)(W + (size_t)(16 * nf) * 128 + 32 * ks);
    }
    LAS unsigned char* stg = lds + L_ST + wid * (16 * ST_STRIDE);
#pragma unroll
    for (int mb = 0; mb < 2; ++mb) {
        f32x4 cs[4], sn[4];
        if (half == 1) {
#pragma unroll
            for (int i = 0; i < 4; ++i) { const int pos = (int)((t0 + 16 * (4 * mb + i) + fr) % S);
                cs[i] = *(const f32x4*)(ROPE + pos * 16 + 4 * fq); sn[i] = *(const f32x4*)(ROPE + S * 16 + pos * 16 + 4 * fq); }
        }
#pragma unroll
        for (int i = 0; i < 4; ++i) { const int mi = 4 * mb + i;
            LAS unsigned char* sp = stg + fr * ST_STRIDE + 8 * fq;
            if (half == 0) { stage4(sp, acc[mi][0]); stage4(sp + 32, acc[mi][1]); stage4(sp + 64, acc[mi][2]); }
            else { const f32x4 x1 = acc[mi][1], x2 = acc[mi][2];
                stage4(sp, acc[mi][0]); stage4(sp + 32, x1 * cs[i] - x2 * sn[i]); stage4(sp + 64, x2 * cs[i] + x1 * sn[i]); }
            asm volatile("" ::: "memory");
#pragma unroll
            for (int j = 0; j < 2; ++j) { const int pc = lane + 64 * j; const int row = pc / 6, c = pc % 6;
                if (pc < 96) { const u32x4 v = *(const LAS u32x4*)(stg + row * ST_STRIDE + c * 16);
                    *(u32x4*)(QA + (t0 + 16 * mi + row) * 384 + h * 96 + 48 * half + c * 8) = v; } }
            asm volatile("" ::: "memory");
        }
    }
    {
        f32x4 ac2[8][4];
#pragma unroll
        for (int mi = 0; mi < 8; ++mi)
#pragma unroll
            for (int nf = 0; nf < 4; ++nf) ac2[mi][nf] = (f32x4){0.f, 0.f, 0.f, 0.f};
#pragma unroll
        for (int ks = 0; ks < 4; ++ks) {
#pragma unroll
            for (int mi = 0; mi < 8; ++mi) {
                const bf16x8 xf = *(const LAS bf16x8*)(lds + L_AKV + (16 * mi + fr) * AKV_STRIDE + 64 * ks + 16 * fq);
#pragma unroll
                for (int nf = 0; nf < 4; ++nf) ac2[mi][nf] = __builtin_amdgcn_mfma_f32_16x16x32_bf16(wkv[ks][nf], xf, ac2[mi][nf], 0, 0, 0);
            }
        }
#pragma unroll
        for (int mi = 0; mi < 8; ++mi) {
            LAS unsigned char* sp = stg + fr * ST_STRIDE + 8 * fq;
#pragma unroll
            for (int nf = 0; nf < 4; ++nf) stage4(sp + 32 * nf, ac2[mi][nf]);
            asm volatile("" ::: "memory");
            if (half == 0) {
#pragma unroll
                for (int j = 0; j < 3; ++j) { const int pc = lane + 64 * j; const int row = pc / 12, c = pc % 12;
                    const u32x4 v = (c < 8) ? *(const LAS u32x4*)(stg + row * ST_STRIDE + c * 16) : *(const LAS u32x4*)(lds + L_RK + (16 * mi + row) * 64 + (c - 8) * 16);
                    *(u32x4*)(KA + (t0 + 16 * mi + row) * 384 + h * 96 + c * 8) = v; }
            } else {
#pragma unroll
                for (int j = 0; j < 2; ++j) { const int pc = lane + 64 * j; const int row = pc >> 3, c = pc & 7;
                    const u32x4 v = *(const LAS u32x4*)(stg + row * ST_STRIDE + c * 16);
                    *(u32x4*)(VA + (t0 + 16 * mi + row) * 256 + h * 64 + c * 8) = v; }
            }
            asm volatile("" ::: "memory");
        }
    }
}
}

__device__ __forceinline__ void conv_tokens(int t, int cg, const bf16_t* P, const float* cw, bf16_t* Y) {
    const int pos = t % S, ch = cg * 8;
    const bf16_t* p = P + (size_t)t * PC;
    const u16x8 zero = (u16x8){0, 0, 0, 0, 0, 0, 0, 0};
    const u16x8 c2 = *(const u16x8*)(p + CD_C + ch), h2 = *(const u16x8*)(p + CD_H + ch);
    const u16x8 c1 = (pos >= 1) ? *(const u16x8*)(p - PC + CD_C + ch) : zero, h1 = (pos >= 1) ? *(const u16x8*)(p - PC + CD_H + ch) : zero;
    const u16x8 c0 = (pos >= 2) ? *(const u16x8*)(p - 2 * PC + CD_C + ch) : zero, h0 = (pos >= 2) ? *(const u16x8*)(p - 2 * PC + CD_H + ch) : zero;
    const u16x8 bb = *(const u16x8*)(p + CD_B + ch), gg = *(const u16x8*)(p + CD_G + ch);
    u16x8 out;
#pragma unroll
    for (int e = 0; e < 8; ++e) {
        const float y = cw[ch + e] * (bf2f(c0[e]) * bf2f(h0[e])) + cw[256 + ch + e] * (bf2f(c1[e]) * bf2f(h1[e])) + cw[512 + ch + e] * (bf2f(c2[e]) * bf2f(h2[e]));
        const float g = bf2f(gg[e]);
        out[e] = f2bf(bf2f(bb[e]) * y * (g * __builtin_amdgcn_rcpf(1.f + __expf(-g))));
    }
    *(u16x8*)(Y + (size_t)t * D + 768 + ch) = out;
}

#define PH_PRE const int tid = opaque_tid(), lane = tid & 63, wave = __builtin_amdgcn_readfirstlane(tid >> 6); const int G = opaque_grid(), bid = opaque_bid(); \
    ArgsP A = get_args(); unsigned char* ws = A->ws; (void)lane; (void)wave; (void)G; (void)bid; (void)ws;
__device__ __forceinline__ void ph_prologue(LAS unsigned char* lds) {
    PH_PRE
    const long gtid = (long)bid * NTHR + tid, gthreads = (long)G * NTHR;
    {
        LAS float* scr = (LAS float*)lds;
        constexpr int T_IN = 16 * 64, T_OUT = 16 * 16, T_UQ = 4 * 6, T_UKV = 2 * 8, T_L = T_IN + T_OUT + T_UQ + T_UKV;
        for (int it = bid; it < NL * T_L; it += G) {
            const int l = it / T_L; int r = it % T_L;
            if (r < T_IN) { convert_tile(scr, A->w_in + (size_t)l * 1024 * INC, (bf16_t*)(ws + WS_WTIN) + (size_t)l * PC * 1024, 1024, INC, 1, 1.f, (r >> 6) * 64, (r & 63) * 64, tid); continue; } r -= T_IN;
            if (r < T_OUT) { convert_tile(scr, A->w_out + (size_t)l * 1024 * 1024, (bf16_t*)(ws + WS_WTOUT) + (size_t)l * 1024 * 1024, 1024, 1024, 0, 1.f, (r >> 4) * 64, (r & 15) * 64, tid); continue; } r -= T_OUT;
            if (r < T_UQ) { convert_tile(scr, A->w_uq + (size_t)l * 256 * 384, (bf16_t*)(ws + WS_WTUQ) + (size_t)l * 384 * 256, 256, 384, 0, QS_MLA, (r / 6) * 64, (r % 6) * 64, tid); continue; } r -= T_UQ;
            convert_tile(scr, A->w_ukv + (size_t)l * 128 * 512, (bf16_t*)(ws + WS_WTUKV) + (size_t)l * 512 * 128, 128, 512, 0, 1.f, (r >> 3) * 64, (r & 7) * 64, tid);
        }
        __syncthreads();
    }
    float* ROPE = (float*)(ws + WS_ROPE);
    for (long i = gtid; i < S * 16; i += gthreads) {
        const int s = (int)(i >> 4), f = (int)(i & 15);
        const float inv = powf(10000.0f, -(float)f / 16.0f);
        const float ang = (float)s * inv;
        float sn, c; sincosf(ang, &sn, &c);
        ROPE[i] = c; ROPE[S * 16 + i] = sn;
    }
}
__device__ __forceinline__ void ph_rms(int l) {
    PH_PRE
    bf16_t* HN = (bf16_t*)(ws + WS_HN);
    const int NGW = G * NWAVE;
    if (l == 0) { for (int r = bid * NWAVE + wave; r < T; r += 4 * NGW) rms_rows4<true>(A->x + (size_t)r * D, (size_t)NGW * D, A->norm_g + l * D, HN + (size_t)r * D, nullptr, lane); }
    else { const bf16_t* XR = (const bf16_t*)(ws + WS_XR);
        for (int r = bid * NWAVE + wave; r < T; r += 4 * NGW) rms_rows4b<true>(XR + (size_t)r * D, (size_t)NGW * D, A->norm_g + l * D, HN + (size_t)r * D, nullptr, lane); }
}
__device__ __forceinline__ void ph_gemm_in(LAS unsigned char* lds, int l) {
    PH_PRE
    pg8::Gemm g{(const bf16_t*)(ws + WS_HN), (const bf16_t*)(ws + WS_WTIN) + (size_t)l * PC * 1024, T, PC, 1024}; pg8::StaticOrder So; So.init(T, PC, G, bid);
    pg8::EpiBf16 E{(bf16_t*)(ws + WS_P), PC};
    pg8::gemm_phase<pg8::EpiBf16, pg8::StaticOrder, true, true>(lds, g, So, E);
}
__device__ __forceinline__ void ph_mid(LAS unsigned char* lds, int l) {
    const int G = opaque_grid(), bid = opaque_bid();
    for (int u = bid; u < T / 128; u += G) mp::mla_prep_unit(lds, u, l);
    __syncthreads();
    {
        const int vcu = (bid & 7) * (G >> 3) + (bid >> 3);
        const int b = vcu >> 5, j = vcu & 31;
        for (int m = 0; m < 4; ++m) { const int c = ((m & 1) ? (15 - (j >> 1)) : (j >> 1)) + 16 * m; sel2::select_unit(lds, b, c, j & 1); }
    }
}
__device__ __forceinline__ void ph_attn(LAS unsigned char* lds, int l) {
    const int G = opaque_grid(), bid = opaque_bid();
    {
        const int vcu = (bid & 7) * (G >> 3) + (bid >> 3);
        const int b = vcu >> 5, h = (vcu >> 3) & 3, s = vcu & 7;
        { ArgsP A = get_args(); fa::build_bias(lds, A->rel_bias); }
#define ATTN_UNIT(TY) do { _Pragma("unroll 1") for (int u_ = 0; u_ < 2; ++u_) { int b_ = b, h_ = h, q_ = u_ ? s : 15 - s, l_ = l; asm volatile("" : "+s"(b_), "+s"(h_), "+s"(q_), "+s"(l_)); \
            fa::attn_unit<TY>(lds, b_, h_, q_, l_); } } while (0)
        ATTN_UNIT(0);
        { _Pragma("unroll 1") for (int u_ = 0; u_ < 2; ++u_) { int b_ = b, h_ = h, q_ = u_ ? s : 15 - s, l_ = l; asm volatile("" : "+s"(b_), "+s"(h_), "+s"(q_), "+s"(l_)); fa::attn_unit_diff(lds, b_, h_, q_, l_); } }
        ATTN_UNIT(2);
#undef ATTN_UNIT
        __syncthreads();
    }
    {
        PH_PRE
        for (int t = bid * 16 + (tid >> 5); t < T; t += 16 * G) conv_tokens(t, tid & 31, (const bf16_t*)(ws + WS_P), A->conv_w + l * 768, (bf16_t*)(ws + WS_Y));
    }
}
__device__ __forceinline__ void ph_gemm_out(LAS unsigned char* lds, int l) {
    PH_PRE
    pg8::Gemm g{(const bf16_t*)(ws + WS_Y), (const bf16_t*)(ws + WS_WTOUT) + (size_t)l * 1024 * 1024, T, 1024, 1024}; pg8::StaticOrder So; So.init(T, 1024, G, bid);
    bf16_t* XR = (bf16_t*)(ws + WS_XR);
    if (l == 0) { pg8::EpiResBf16<false> E{A->x, XR, 1024}; pg8::gemm_phase<pg8::EpiResBf16<false>, pg8::StaticOrder, true, true>(lds, g, So, E); }
    else { pg8::EpiResBf16<true> E{XR, XR, 1024}; pg8::gemm_phase<pg8::EpiResBf16<true>, pg8::StaticOrder, true, true>(lds, g, So, E); }
}
__device__ __forceinline__ void ph_final() {
    PH_PRE
    const int NGW = G * NWAVE;
    const bf16_t* XR = (const bf16_t*)(ws + WS_XR);
    for (int r = bid * NWAVE + wave; r < T; r += 4 * NGW) rms_rows4b<false>(XR + (size_t)r * D, (size_t)NGW * D, A->final_g, nullptr, A->out + (size_t)r * D, lane);
}

#define GRID_SYNC() xcd_barrier(lds)
__global__ void __launch_bounds__(NTHR, 2) mk_fwd(Args Akernarg) {
    extern __shared__ __attribute__((aligned(16))) unsigned char lds_raw[];
    LAS unsigned char* lds = (LAS unsigned char*)lds_raw;
    xcd_barrier_post(lds);
    ph_prologue(lds);
    for (int l = 0; l < NL; ++l) {
        ph_rms(l);
        GRID_SYNC();
        ph_gemm_in(lds, l);
        GRID_SYNC();
        ph_mid(lds, l);
        GRID_SYNC();
        ph_attn(lds, l);
        GRID_SYNC();
        ph_gemm_out(lds, l);
        GRID_SYNC();
    }
    ph_final();
}

extern "C" void kernel_launch(void* const* d_in, const int* in_sizes, int n_in, void* d_out, int out_size, void* d_ws, size_t ws_size, hipStream_t stream) {
    static int grid = 0;
    if (grid == 0) {
        if (ws_size < WS_END) { fprintf(stderr, "kernel_launch: workspace too small (%zu < %zu)\n", ws_size, (size_t)WS_END); grid = -1; return; }
        int dev = 0, cus = 0, per_cu = 0;
        hipGetDevice(&dev);
        hipDeviceGetAttribute(&cus, hipDeviceAttributeMultiprocessorCount, dev);
        hipFuncSetAttribute((const void*)mk_fwd, hipFuncAttributeMaxDynamicSharedMemorySize, LDS_BYTES);
        hipOccupancyMaxActiveBlocksPerMultiprocessor(&per_cu, (const void*)mk_fwd, NTHR, LDS_BYTES);
        if (per_cu < 1) fprintf(stderr, "kernel_launch: note: the occupancy query reports %d workgroups per CU; 145 KiB of LDS per workgroup admits exactly one\n", per_cu);
        (void)hipGetLastError();
        if (cus != 256) { fprintf(stderr, "kernel_launch: built for a 256-CU device (one workgroup per CU, 32 per batch); found %d CUs; nothing launched\n", cus); grid = -1; return; }
        grid = cus;
    }
    if (grid < 0) return;
    Args a{};
    a.x = (const float*)d_in[0]; a.norm_g = (const float*)d_in[1]; a.w_in = (const float*)d_in[2]; a.qa_g = (const float*)d_in[3];
    a.w_uq = (const float*)d_in[4]; a.kva_g = (const float*)d_in[5]; a.w_ukv = (const float*)d_in[6]; a.dlam = (const float*)d_in[7];
    a.subg = (const float*)d_in[8]; a.conv_w = (const float*)d_in[9]; a.w_out = (const float*)d_in[10]; a.rel_bias = (const float*)d_in[11];
    a.final_g = (const float*)d_in[12];
    a.out = (float*)d_out; a.ws = (unsigned char*)d_ws;
    a.lambda_init[0] = 0.8f - 0.6f * expf(-0.3f * 0.f); a.lambda_init[1] = 0.8f - 0.6f * expf(-0.3f * 1.f);
    if (hipMemsetAsync(d_ws, 0, 65536, stream) != hipSuccess) { fprintf(stderr, "kernel_launch: memset of the barrier words failed\n"); return; }
    hipLaunchKernelGGL(mk_fwd, dim3(grid), dim3(NTHR), LDS_BYTES, stream, a);
    const hipError_t e = hipPeekAtLastError();
    if (e != hipSuccess) fprintf(stderr, "launch failed: %s (grid %d)\n", hipGetErrorString(e), grid);
}
```

```cpp
#include <hip/hip_runtime.h>
#include <hip/hip_bf16.h>
#include <cstdint>
#include <cstdio>

#define LAS __attribute__((address_space(3)))
typedef unsigned short bf16_t;
typedef short bf16x8 __attribute__((ext_vector_type(8)));
typedef unsigned short u16x8 __attribute__((ext_vector_type(8)));
typedef float f32x4 __attribute__((ext_vector_type(4)));
typedef unsigned u32x4 __attribute__((ext_vector_type(4)));
typedef unsigned u32x2 __attribute__((ext_vector_type(2)));

constexpr int NB = 8, S = 4096, T = NB * S, D = 1024, NL = 2;
constexpr int PC = 4096;
constexpr int INC = 4040;
constexpr int CA_CQ = 0, CA_CKV = 256, CA_KR = 384, CA_G = 448;
constexpr int CB_Q = 704, CB_K = 960, CB_V = 1216, CB_G = 1472;
constexpr int CC_Q = 1728, CC_K = 1984, CC_V = 2240, CC_QI = 2496, CC_KI = 2752, CC_WI = 2784, CC_G = 2816;
constexpr int CD_B = 3072, CD_C = 3328, CD_H = 3584, CD_G = 3840;
constexpr float EPS = 1e-6f;
constexpr int NTHR = 512, NWAVE = 8;

constexpr size_t MiB = 1u << 20;
constexpr size_t WS_WTIN = 1 * MiB;
constexpr size_t WS_WTOUT = 17 * MiB;
constexpr size_t WS_WTUQ = 21 * MiB;
constexpr size_t WS_WTUKV = 22 * MiB;
constexpr size_t WS_ROPE = 23 * MiB;
constexpr size_t WS_HN = 24 * MiB;
constexpr size_t WS_Y = WS_HN;
constexpr size_t WS_Q384 = WS_HN;
constexpr size_t WS_KV512 = WS_HN + 24 * MiB;
constexpr size_t WS_P = 88 * MiB;
constexpr size_t WS_QA = 344 * MiB;
constexpr size_t WS_KA = 368 * MiB;
constexpr size_t WS_VA = 392 * MiB;
constexpr size_t WS_CQN = WS_VA;
constexpr size_t WS_MASK = 408 * MiB;
constexpr size_t WS_CKVN = WS_MASK;
constexpr size_t WS_OKL = 424 * MiB;
constexpr size_t WS_XR = 440 * MiB;
constexpr size_t WS_END = 504 * MiB;

constexpr int LDS_BYTES = 148480;

__device__ __forceinline__ bf16_t f2bf(float f) {
    unsigned u = __builtin_bit_cast(unsigned, f);
    return (bf16_t)((u + 0x7fffu + ((u >> 16) & 1u)) >> 16);
}
__device__ __forceinline__ float bf2f(bf16_t h) { return __builtin_bit_cast(float, (unsigned)h << 16); }
__device__ __forceinline__ float silu(float x) { return x / (1.f + __expf(-x)); }
__device__ __forceinline__ int orig_col(int pc) {
    if (pc < 416) return pc;
    if (pc < 448) return -1;
    if (pc < 2792) return pc - 32;
    if (pc < 2816) return -1;
    return pc - 56;
}
__device__ __forceinline__ int rel_bucket(int rel) {
    const int ret = rel > 0 ? 16 : 0;
    const int n = rel < 0 ? -rel : rel;
    if (n < 8) return ret + n;
    int large = 2 + (31 - __clz(n * n));
    if (large > 15) large = 15;
    return ret + large;
}

__device__ __forceinline__ int opaque_tid() { int t = threadIdx.x; asm volatile("" : "+v"(t)); return t; }
__device__ __forceinline__ int opaque_bid() { int b = blockIdx.x; asm volatile("" : "+s"(b)); return b; }
__device__ __forceinline__ int opaque_grid() { int g = gridDim.x; asm volatile("" : "+s"(g)); return g; }
namespace pg8 {
constexpr int BM = 256, BK = 64, HALF = 128, HTB = HALF * BK * 2, STAGE_BYTES = 8 * HTB, NXCD = 8, WGM = 8;
__host__ __device__ __forceinline__ int lds_byte(int r, int c) { const int st = (r >> 4) * 2 + (c >> 5), rr = r & 15, cc = c & 31, ob = rr * 64 + cc * 2; return st * 1024 + (ob ^ (((ob >> 9) & 1) << 5)); }
__host__ __device__ __forceinline__ void stage_rc(int b, int& R, int& C) { const int st = b / 1024, sb = b % 1024, swz = sb ^ (((sb >> 9) & 1) << 5); R = (st >> 1) * 16 + swz / 64; C = (st & 1) * 32 + (swz % 64) / 2; }
__host__ __device__ __forceinline__ int perm32(int rho) { const int n = rho >> 4, i = rho & 15; return 8 * (i >> 2) + 4 * n + (i & 3); }
struct Unit { int pm, pn; };
struct Gemm { const bf16_t* A; const bf16_t* Bt; int M, N, K; };
struct StaticOrder {
    int nM, nN, nwg, G, c;
    __host__ __device__ void init(int M, int N, int G_, int c_) { nM = M / BM; nN = N / BM; nwg = nM * nN; G = G_; c = c_; }
    __host__ __device__ bool next(int i, Unit& u) const {
        const long L = (long)i * G + c; if (L >= nwg) return false;
        int wgid = (int)L; { const int q = nwg / NXCD, r = nwg % NXCD, xcd = wgid % NXCD, off = wgid / NXCD; wgid = (xcd < r ? xcd * (q + 1) : r * (q + 1) + (xcd - r) * q) + off; }
        const int nig = WGM * nN, gid = wgid / nig, fm = gid * WGM, gsz = (nM - fm) < WGM ? (nM - fm) : WGM;
        u.pm = fm + ((wgid % nig) % gsz); u.pn = (wgid % nig) / gsz; return true;
    }
    __device__ __forceinline__ void a_ready(const Unit&) const {}
    __device__ __forceinline__ void done(const Unit&) const {}
};
__device__ __forceinline__ unsigned cvt_pk_bf16(float lo, float hi) { unsigned r; asm volatile("v_cvt_pk_bf16_f32 %0, %1, %2" : "=v"(r) : "v"(lo), "v"(hi)); return r; }
struct EpiBf16 {
    static constexpr bool PERM = true, AFTER_DRAIN = false, HAS_WT = true;
    bf16_t* O; int ldc; LAS unsigned char* stage;
    unsigned nbytes; mutable int wt;
    __device__ __forceinline__ void operator()(const f32x4 (&acc)[2][2][4][2], const Unit& u, int wr, int wc, int fr, int fq) const {
        const __amdgpu_buffer_rsrc_t rs = __builtin_amdgcn_make_buffer_rsrc(O, 0, nbytes, 0x00020000);
        LAS unsigned char* st = stage + (wr * 4 + wc) * 2048;
        const int lane = fq * 16 + fr, rr = lane >> 3, pc = lane & 7;
        LAS unsigned char* wp0 = st + fr * 128 + ((fq ^ (fr & 7)) * 16);
        LAS unsigned char* wp1 = st + fr * 128 + (((4 + fq) ^ (fr & 7)) * 16);
        const LAS unsigned char* rp0 = st + rr * 128 + ((pc ^ (rr & 7)) * 16);
        const LAS unsigned char* rp1 = st + (8 + rr) * 128 + ((pc ^ ((8 + rr) & 7)) * 16);
        bf16_t* ob = O + (size_t)(u.pm * BM + wr * 64 + rr) * ldc + u.pn * BM + wc * 64 + pc * 8;
#pragma unroll
        for (int ai = 0; ai < 2; ++ai)
#pragma unroll
            for (int m = 0; m < 4; ++m) {
#pragma unroll
                for (int bj = 0; bj < 2; ++bj) { const f32x4 v0 = acc[ai][bj][m][0], v1 = acc[ai][bj][m][1];
                    u32x4 w; w.x = cvt_pk_bf16(v0[0], v0[1]); w.y = cvt_pk_bf16(v0[2], v0[3]); w.z = cvt_pk_bf16(v1[0], v1[1]); w.w = cvt_pk_bf16(v1[2], v1[3]);
                    *(LAS u32x4*)(bj ? wp1 : wp0) = w; }
                asm volatile("" ::: "memory");
                const u32x4 a = *(const LAS u32x4*)rp0, b = *(const LAS u32x4*)rp1;
                bf16_t* op = ob + (size_t)(ai * HALF + m * 16) * ldc;
                if (wt) { const unsigned bo = (unsigned)((op - O) * 2);
                    __builtin_amdgcn_raw_buffer_store_b128(a, rs, bo, 0,   16); __builtin_amdgcn_raw_buffer_store_b128(b, rs, bo + (unsigned)(8 * ldc * 2), 0,   16); }
                else { *(u32x4*)op = a; *(u32x4*)(op + (size_t)8 * ldc) = b; }
                asm volatile("" ::: "memory");
            }
    }
};
struct EpiResF32 {
    static constexpr bool PERM = false, AFTER_DRAIN = false, HAS_WT = false;
    const float* base; float* out; int ldc;
    __device__ __forceinline__ void operator()(const f32x4 (&acc)[2][2][4][2], const Unit& u, int wr, int wc, int fr, int fq) const {
        const int col0 = u.pn * BM + wc * 32 + 4 * fq;
#pragma unroll
        for (int ai = 0; ai < 2; ++ai)
#pragma unroll
            for (int m = 0; m < 4; ++m) { const size_t off = (size_t)(u.pm * BM + ai * HALF + wr * 64 + m * 16 + fr) * ldc + col0;
#pragma unroll
                for (int bj = 0; bj < 2; ++bj)
#pragma unroll
                    for (int n = 0; n < 2; ++n) { const f32x4 bs = *(const f32x4*)(base + off + bj * HALF + n * 16); *(f32x4*)(out + off + bj * HALF + n * 16) = bs + acc[ai][bj][m][n]; } }
    }
};
template <bool BASE_BF16>
struct EpiResBf16 {
    static constexpr bool PERM = true, AFTER_DRAIN = false, HAS_WT = false;
    const void* base; bf16_t* out; int ldc;
    __device__ __forceinline__ void operator()(const f32x4 (&acc)[2][2][4][2], const Unit& u, int wr, int wc, int fr, int fq) const {
        const int row0 = u.pm * BM + wr * 64 + fr; const int col0 = u.pn * BM + wc * 64 + 8 * fq;
#pragma unroll
        for (int ai = 0; ai < 2; ++ai)
#pragma unroll
            for (int m = 0; m < 4; ++m) { const size_t ro = (size_t)(row0 + ai * HALF + m * 16) * ldc + col0;
#pragma unroll
                for (int bj = 0; bj < 2; ++bj) { const f32x4 v0 = acc[ai][bj][m][0], v1 = acc[ai][bj][m][1]; const size_t off = ro + bj * 32;
                    f32x4 b0, b1;
                    if (BASE_BF16) { const u16x8 bb = *(const u16x8*)((const bf16_t*)base + off);
                        b0 = (f32x4){bf2f(bb[0]), bf2f(bb[1]), bf2f(bb[2]), bf2f(bb[3])}; b1 = (f32x4){bf2f(bb[4]), bf2f(bb[5]), bf2f(bb[6]), bf2f(bb[7])}; }
                    else { b0 = *(const f32x4*)((const float*)base + off); b1 = *(const f32x4*)((const float*)base + off + 4); }
                    const f32x4 s0 = b0 + v0, s1 = b1 + v1;
                    u32x4 w; w.x = cvt_pk_bf16(s0[0], s0[1]); w.y = cvt_pk_bf16(s0[2], s0[3]); w.z = cvt_pk_bf16(s1[0], s1[1]); w.w = cvt_pk_bf16(s1[2], s1[3]);
                    *(u32x4*)(out + off) = w; } }
    }
};
template <class Epi, class Sched, bool ALIGN_EPI = false, bool SP2 = false>
__device__ __forceinline__ void gemm_phase(LAS unsigned char* lds, const Gemm g, const Sched& S, const Epi& E) {
    const int tid = opaque_tid(), wid = __builtin_amdgcn_readfirstlane(tid >> 6), lane = tid & 63, wr = wid >> 2, wc = wid & 3, fr = lane & 15, fq = lane >> 4;
    const int K = g.K, nt = K / BK;
    unsigned voffA[2], voffB[2];
#pragma unroll
    for (int i = 0; i < 2; ++i) { int R, C; stage_rc(tid * 16 + i * 8192, R, C); const int Rb = Epi::PERM ? ((R >> 5) * 64 + perm32(R & 31)) : R;
        voffA[i] = (unsigned)(R * K + C) * 2u; voffB[i] = (unsigned)(Rb * K + C) * 2u; }
    const size_t kstep = (size_t)(BK * 2);
    const size_t hstep = (size_t)HALF * K * 2;
    const size_t bhs = Epi::PERM ? (size_t)32 * K * 2 : hstep;
    const size_t tstep = 2 * hstep;
    const unsigned ldsw = (unsigned)wid * 1024u;
    const int aoff = lds_byte(wr * 64 + fr, fq * 8), boff = lds_byte(wc * 32 + fr, fq * 8);
#define PG8_SA(b, h) (((b) * 2 + (h)) * HTB)
#define PG8_SB(b, h) ((4 + (b) * 2 + (h)) * HTB)
#define PG8_STAGE(bufoff, gbase, voff) do { _Pragma("unroll") for (int _i = 0; _i < 2; ++_i) \
        __builtin_amdgcn_global_load_lds((const unsigned*)((const char*)(gbase) + (voff)[_i]), (LAS unsigned*)(lds + (bufoff) + ldsw + _i * 8192), 16, 0, 0); } while (0)
#define PG8_LDA(dst, b, h) do { _Pragma("unroll") for (int m = 0; m < 4; ++m) _Pragma("unroll") for (int k = 0; k < 2; ++k) dst[m][k] = *(const LAS bf16x8*)(lds + PG8_SA(b, h) + aoff + m * 2048 + k * 1024); } while (0)
#define PG8_LDB(dst, b, h) do { _Pragma("unroll") for (int n = 0; n < 2; ++n) _Pragma("unroll") for (int k = 0; k < 2; ++k) dst[n][k] = *(const LAS bf16x8*)(lds + PG8_SB(b, h) + boff + n * 2048 + k * 1024); } while (0)
#define PG8_MMA(ai, bj, At, Bt) do { __builtin_amdgcn_s_setprio(1); _Pragma("unroll") for (int m = 0; m < 4; ++m) _Pragma("unroll") for (int n = 0; n < 2; ++n) _Pragma("unroll") for (int k = 0; k < 2; ++k) \
        acc[ai][bj][m][n] = __builtin_amdgcn_mfma_f32_16x16x32_bf16(Bt[n][k], At[m][k], acc[ai][bj][m][n], 0, 0, 0); __builtin_amdgcn_s_setprio(0); } while (0)
#define PG8_WAIT_V(n) asm volatile("s_waitcnt vmcnt(" #n ")" ::: "memory")
#define PG8_WAIT_L(n) asm volatile("s_waitcnt lgkmcnt(" #n ")" ::: "memory")
#define PG8_BAR __builtin_amdgcn_s_barrier()
#define PG8_SCHED __builtin_amdgcn_sched_barrier(0)
    Unit cur, nxt; int ui = 0;
    if (!S.next(0, cur)) return;
    f32x4 acc[2][2][4][2];
#pragma unroll
    for (int a = 0; a < 2; ++a)
#pragma unroll
        for (int b = 0; b < 2; ++b)
#pragma unroll
            for (int m = 0; m < 4; ++m)
#pragma unroll
                for (int n = 0; n < 2; ++n) acc[a][b][m][n] = (f32x4){0.f, 0.f, 0.f, 0.f};
    bf16x8 At[4][2], B0[2][2], B1[2][2];
    const char* cA = (const char*)g.A + (size_t)cur.pm * tstep; const char* cB = (const char*)g.Bt + (size_t)cur.pn * tstep;
    S.a_ready(cur);
    if constexpr (SP2) {
        PG8_STAGE(PG8_SB(0, 0), cB, voffB); PG8_STAGE(PG8_SB(0, 1), cB + bhs, voffB); PG8_STAGE(PG8_SA(0, 0), cA, voffA); PG8_STAGE(PG8_SA(0, 1), cA + hstep, voffA);
        if (wr == 1) PG8_BAR;
        PG8_WAIT_V(2); PG8_BAR;
        PG8_STAGE(PG8_SB(1, 0), cB + kstep, voffB); PG8_STAGE(PG8_SA(1, 0), cA + kstep, voffA); PG8_STAGE(PG8_SB(1, 1), cB + bhs + kstep, voffB);
        PG8_WAIT_V(6); PG8_BAR;
    } else {
        PG8_STAGE(PG8_SB(0, 0), cB, voffB); PG8_STAGE(PG8_SA(0, 0), cA, voffA); PG8_STAGE(PG8_SB(0, 1), cB + bhs, voffB); PG8_STAGE(PG8_SA(0, 1), cA + hstep, voffA);
        if (wr == 1) PG8_BAR;
        PG8_WAIT_V(4); PG8_BAR;
        PG8_STAGE(PG8_SB(1, 0), cB + kstep, voffB); PG8_STAGE(PG8_SA(1, 0), cA + kstep, voffA); PG8_STAGE(PG8_SB(1, 1), cB + bhs + kstep, voffB);
        PG8_WAIT_V(6); PG8_BAR;
    }
    for (;;) {
        const bool has_next = S.next(ui + 1, nxt);
        const char* nA = has_next ? (const char*)g.A + (size_t)nxt.pm * tstep : cA; const char* nB = has_next ? (const char*)g.Bt + (size_t)nxt.pn * tstep : cB;
        for (int t = 0; t < nt; t += 2) {
            const bool last = (t == nt - 2);
            const char* a1 = cA + (size_t)(t + 1) * kstep;
            const char* a2 = last ? nA : cA + (size_t)(t + 2) * kstep; const char* b2 = last ? nB : cB + (size_t)(t + 2) * kstep;
            const char* a3 = a2 + kstep; const char* b3 = b2 + kstep;
            if (last && has_next) S.a_ready(nxt);
            if constexpr (SP2) {
            PG8_LDB(B0, 0, 0); PG8_LDB(B1, 0, 1); PG8_SCHED; PG8_LDA(At, 0, 0); PG8_STAGE(PG8_SA(1, 1), a1 + hstep, voffA);
            PG8_WAIT_V(8); PG8_WAIT_L(0); PG8_BAR; PG8_MMA(0, 0, At, B0); PG8_MMA(0, 1, At, B1); PG8_BAR; PG8_SCHED;
            PG8_LDA(At, 0, 1); PG8_STAGE(PG8_SB(0, 0), b2, voffB); PG8_STAGE(PG8_SB(0, 1), b2 + bhs, voffB); PG8_STAGE(PG8_SA(0, 0), a2, voffA);
            PG8_WAIT_V(8); PG8_WAIT_L(0); PG8_BAR; PG8_MMA(1, 0, At, B0); PG8_MMA(1, 1, At, B1); PG8_BAR; PG8_SCHED;
            PG8_LDB(B0, 1, 0); PG8_LDB(B1, 1, 1); PG8_SCHED; PG8_LDA(At, 1, 0); PG8_STAGE(PG8_SA(0, 1), a2 + hstep, voffA);
            PG8_WAIT_V(8); PG8_WAIT_L(0); PG8_BAR; PG8_MMA(0, 0, At, B0); PG8_MMA(0, 1, At, B1); PG8_BAR; PG8_SCHED;
            PG8_LDA(At, 1, 1); PG8_STAGE(PG8_SB(1, 0), b3, voffB); PG8_STAGE(PG8_SB(1, 1), b3 + bhs, voffB); PG8_STAGE(PG8_SA(1, 0), a3, voffA);
            PG8_WAIT_V(8); PG8_WAIT_L(0); PG8_BAR; PG8_MMA(1, 0, At, B0); PG8_MMA(1, 1, At, B1); PG8_BAR; PG8_SCHED;
            } else {
            PG8_LDB(B0, 0, 0); PG8_SCHED; PG8_LDA(At, 0, 0); PG8_STAGE(PG8_SA(1, 1), a1 + hstep, voffA);
            PG8_WAIT_L(8); PG8_BAR; PG8_WAIT_L(0); PG8_MMA(0, 0, At, B0); PG8_BAR; PG8_SCHED;
            PG8_LDB(B1, 0, 1); PG8_STAGE(PG8_SB(0, 0), b2, voffB);
            PG8_BAR; PG8_WAIT_L(0); PG8_MMA(0, 1, At, B1); PG8_BAR;
            PG8_LDA(At, 0, 1); PG8_STAGE(PG8_SA(0, 0), a2, voffA);
            PG8_BAR; PG8_WAIT_L(0); PG8_MMA(1, 0, At, B0); PG8_BAR; PG8_SCHED;
            PG8_STAGE(PG8_SB(0, 1), b2 + bhs, voffB);
            PG8_WAIT_V(6); PG8_BAR; PG8_MMA(1, 1, At, B1); PG8_BAR;
            PG8_LDB(B0, 1, 0); PG8_SCHED; PG8_LDA(At, 1, 0); PG8_STAGE(PG8_SA(0, 1), a2 + hstep, voffA);
            PG8_WAIT_L(8); PG8_BAR; PG8_WAIT_L(0); PG8_MMA(0, 0, At, B0); PG8_BAR; PG8_SCHED;
            PG8_LDB(B1, 1, 1); PG8_STAGE(PG8_SB(1, 0), b3, voffB);
            PG8_BAR; PG8_WAIT_L(0); PG8_MMA(0, 1, At, B1); PG8_BAR;
            PG8_LDA(At, 1, 1); PG8_STAGE(PG8_SA(1, 0), a3, voffA);
            PG8_BAR; PG8_WAIT_L(0); PG8_MMA(1, 0, At, B0); PG8_BAR; PG8_SCHED;
            PG8_STAGE(PG8_SB(1, 1), b3 + bhs, voffB);
            PG8_WAIT_V(6); PG8_BAR; PG8_MMA(1, 1, At, B1); PG8_BAR;
            }
        }
        if constexpr (ALIGN_EPI) { if (wr == 0) PG8_BAR; }
        if constexpr (!Epi::AFTER_DRAIN) { if constexpr (Epi::HAS_WT) E.wt = has_next ? 0 : 1; E(acc, cur, wr, wc, fr, fq); S.done(cur); }
        if (!has_next) break;
#pragma unroll
        for (int a = 0; a < 2; ++a)
#pragma unroll
            for (int b = 0; b < 2; ++b)
#pragma unroll
                for (int m = 0; m < 4; ++m)
#pragma unroll
                    for (int n = 0; n < 2; ++n) acc[a][b][m][n] = (f32x4){0.f, 0.f, 0.f, 0.f};
        cur = nxt; cA = nA; cB = nB; ++ui;
        if constexpr (ALIGN_EPI) { if (wr == 1) PG8_BAR; }
    }
    PG8_WAIT_V(0);
    if constexpr (!ALIGN_EPI) { if (wr == 0) PG8_BAR; }
    PG8_BAR;
#undef PG8_SA
#undef PG8_SB
#undef PG8_STAGE
#undef PG8_LDA
#undef PG8_LDB
#undef PG8_MMA
#undef PG8_WAIT_V
#undef PG8_WAIT_L
#undef PG8_BAR
#undef PG8_SCHED
}
}

struct Args {
    const float* x; const float* norm_g; const float* w_in; const float* qa_g; const float* w_uq; const float* kva_g; const float* w_ukv;
    const float* dlam; const float* subg; const float* conv_w; const float* w_out; const float* rel_bias; const float* final_g;
    float* out; unsigned char* ws;
    float lambda_init[2]; int pad[2];
};

typedef const __attribute__((address_space(4))) Args* ArgsP;
__device__ __forceinline__ ArgsP get_args() { ArgsP p = (ArgsP)__builtin_amdgcn_kernarg_segment_ptr(); asm volatile("" : "+s"(p)); return p; }

#define XB_TMO      128
#define XB_XCNT(j)  (256  + 64 * (j))
#define XB_XSUB(j)  (1280 + 64 * (j))
#define XB_XGEN(j)  (2304 + 64 * (j))
#define XB_TOP      3328
#define XB_TOPGEN   3392
#define XCD_BAR_WORDS 3456
#define XB_LSUB(j)  (3456 + 64 * (j))
#define XB_LGEN(j)  (4480 + 64 * (j))
#define XB_GMAX(g)  (5504 + 64 * (g))
#define XB_GMINV(g) (6016 + 64 * (g))
#define XB_SPIN_CAP (1u << 18)
constexpr int LDS_XB = 148464;
__device__ __forceinline__ unsigned xb_ld(unsigned* p)              { return __hip_atomic_load(p, __ATOMIC_RELAXED, __HIP_MEMORY_SCOPE_AGENT); }
__device__ __forceinline__ unsigned xb_add(unsigned* p, unsigned v) { return __hip_atomic_fetch_add(p, v, __ATOMIC_RELAXED, __HIP_MEMORY_SCOPE_AGENT); }
__device__ __forceinline__ unsigned xb_xcc_id() { return (unsigned)__builtin_amdgcn_s_getreg((3 << 11) | 20) & 0xFu; }
#define XB_SPIN(cond, bar) do { unsigned _sp = 0; while (cond) { __builtin_amdgcn_s_sleep(1); \
    if ((++_sp & 255u) == 0u) { if (xb_ld(&(bar)[XB_TMO])) break; if (_sp > XB_SPIN_CAP) { atomicAdd(&(bar)[XB_TMO], 1u); break; } } } } while (0)
__device__ __forceinline__ void xcd_barrier_complete(unsigned* bar, unsigned x, unsigned& nloc, unsigned& nx) {
    const unsigned G = gridDim.x * gridDim.y * gridDim.z;
    unsigned sum, cnt, mine, sp = 0u;
    for (;;) {
        sum = 0u; cnt = 0u; mine = 0u;
#pragma unroll
        for (unsigned j = 0; j < 16; ++j) { const unsigned c = xb_ld(&bar[XB_XCNT(j)]); sum += c; cnt += (c > 0u) ? 1u : 0u; mine = (j == x) ? c : mine; }
        if (sum == G) break;
        __builtin_amdgcn_s_sleep(1);
        if ((++sp & 255u) == 0u) { if (xb_ld(&bar[XB_TMO])) break; if (sp > XB_SPIN_CAP) { atomicAdd(&bar[XB_TMO], 1u); break; } }
    }
    nloc = mine > 0u ? mine : 1u; nx = cnt > 0u ? cnt : 1u;
}
__device__ __forceinline__ void xcd_barrier_post(LAS unsigned char* lds) {
    ArgsP A = get_args(); unsigned* bar = (unsigned*)A->ws;
    const unsigned x = xb_xcc_id(), g = (unsigned)opaque_bid() & 7u;
    unsigned* pmax = &bar[XB_GMAX(g)]; unsigned* pmin = &bar[XB_GMINV(g)]; unsigned* pcnt = &bar[XB_XCNT(x)];
    if (threadIdx.x == 0) { ((volatile LAS unsigned*)(lds + LDS_XB))[0] = 0u; ((volatile LAS unsigned*)(lds + LDS_XB))[1] = 0u; ((volatile LAS unsigned*)(lds + LDS_XB))[2] = 0u;
        (void)__hip_atomic_fetch_max(pmax, x + 1u, __ATOMIC_RELAXED, __HIP_MEMORY_SCOPE_AGENT);
        (void)__hip_atomic_fetch_max(pmin, 16u - x, __ATOMIC_RELAXED, __HIP_MEMORY_SCOPE_AGENT);
        (void)xb_add(pcnt, 1u); }
    __syncthreads();
}
__device__ __forceinline__ void xcd_decide_scope(LAS unsigned char* lds) {
    ArgsP A = get_args(); unsigned* bar = (unsigned*)A->ws;
    if (threadIdx.x == 0) {
        unsigned ok = 1u;
#pragma unroll
        for (unsigned g = 0; g < 8; ++g) { const unsigned mx = xb_ld(&bar[XB_GMAX(g)]), mi = xb_ld(&bar[XB_GMINV(g)]); if (mx == 0u || mx - 1u != 16u - mi) ok = 0u; }
        ((volatile LAS unsigned*)(lds + LDS_XB))[2] = ok;
    }
    __syncthreads();
}
__device__ __forceinline__ void xcd_barrier(LAS unsigned char* lds, bool allow_local) {
    ArgsP A = get_args(); unsigned* bar = (unsigned*)A->ws;
    asm volatile("s_waitcnt vmcnt(0)" ::: "memory");
    __syncthreads();
    if (threadIdx.x == 0) {
        const unsigned x = xb_xcc_id();
        volatile LAS unsigned* st = (volatile LAS unsigned*)(lds + LDS_XB);
        __builtin_amdgcn_s_waitcnt(0);
        unsigned nloc = st[0], nx = st[1];
        if (allow_local && st[2] != 0u) {
            const unsigned old = xb_add(&bar[XB_LSUB(x)], 1u);
            const unsigned gen = old / nloc;
            if (old + 1u == (gen + 1u) * nloc) xb_add(&bar[XB_LGEN(x)], 1u);
            else XB_SPIN(xb_ld(&bar[XB_LGEN(x)]) == gen, bar);
            __builtin_amdgcn_fence(__ATOMIC_ACQUIRE, "agent");
            asm volatile("s_waitcnt vmcnt(0)" ::: "memory");
        } else {
        if (nloc == 0u) { xcd_barrier_complete(bar, x, nloc, nx); st[0] = nloc; st[1] = nx; }
        const unsigned old = xb_add(&bar[XB_XSUB(x)], 1u);
        const unsigned gen = old / nloc;
        if (old + 1u == (gen + 1u) * nloc) {
            __builtin_amdgcn_fence(__ATOMIC_RELEASE, "agent");
            asm volatile("s_waitcnt vmcnt(0)" ::: "memory");
            const unsigned og = xb_add(&bar[XB_TOP], 1u);
            const unsigned tg = og / nx;
            if (og + 1u == (tg + 1u) * nx) xb_add(&bar[XB_TOPGEN], 1u);
            else XB_SPIN(xb_ld(&bar[XB_TOPGEN]) == tg, bar);
            __builtin_amdgcn_fence(__ATOMIC_ACQUIRE, "agent");
            xb_add(&bar[XB_XGEN(x)], 1u);
            asm volatile("s_waitcnt vmcnt(0)" ::: "memory");
        } else {
            XB_SPIN(xb_ld(&bar[XB_XGEN(x)]) == gen, bar);
            __builtin_amdgcn_fence(__ATOMIC_ACQUIRE, "agent");
            asm volatile("s_waitcnt vmcnt(0)" ::: "memory");
        }
        }
    }
    __syncthreads();
}

constexpr float QS_MLA = 0.10206207261596575f * 1.4426950408889634f;
constexpr float QS_DIFF = 0.17677669529663687f * 1.4426950408889634f;
constexpr float QS_DSA = 0.125f * 1.4426950408889634f;
template <bool OUT_BF16>
__device__ __forceinline__ void rms_rows4(const float* xbase, size_t rstride, const float* g, bf16_t* obase, float* fbase, int lane) {
    f32x4 v[4][4]; float ss[4];
#pragma unroll
    for (int k = 0; k < 4; ++k) { const f32x4* xr = (const f32x4*)(xbase + k * rstride) + lane;
#pragma unroll
        for (int j = 0; j < 4; ++j) v[k][j] = xr[64 * j]; }
#pragma unroll
    for (int k = 0; k < 4; ++k) { float s = 0.f;
#pragma unroll
        for (int j = 0; j < 4; ++j) s += v[k][j].x * v[k][j].x + v[k][j].y * v[k][j].y + v[k][j].z * v[k][j].z + v[k][j].w * v[k][j].w;
        ss[k] = s; }
#pragma unroll
    for (int o = 1; o < 64; o <<= 1) {
#pragma unroll
        for (int k = 0; k < 4; ++k) ss[k] += __shfl_xor(ss[k], o); }
    f32x4 gv[4];
#pragma unroll
    for (int j = 0; j < 4; ++j) gv[j] = ((const f32x4*)g)[lane + 64 * j];
#pragma unroll
    for (int k = 0; k < 4; ++k) { const float r = rsqrtf(ss[k] * (1.f / D) + EPS);
#pragma unroll
        for (int j = 0; j < 4; ++j) {
            const f32x4 o = (f32x4){v[k][j].x * r * gv[j].x, v[k][j].y * r * gv[j].y, v[k][j].z * r * gv[j].z, v[k][j].w * r * gv[j].w};
            if (OUT_BF16) { u32x2 w; w.x = pg8::cvt_pk_bf16(o.x, o.y); w.y = pg8::cvt_pk_bf16(o.z, o.w); ((u32x2*)(obase + k * rstride))[lane + 64 * j] = w; }
            else ((f32x4*)(fbase + k * rstride))[lane + 64 * j] = o;
        } }
}
template <bool OUT_BF16>
__device__ __forceinline__ void rms_rows4b(const bf16_t* xbase, size_t rstride, const float* g, bf16_t* obase, float* fbase, int lane) {
    u16x8 v[4][2]; float ss[4];
#pragma unroll
    for (int k = 0; k < 4; ++k) { const u16x8* xr = (const u16x8*)(xbase + k * rstride) + lane;
#pragma unroll
        for (int j = 0; j < 2; ++j) v[k][j] = xr[64 * j]; }
#pragma unroll
    for (int k = 0; k < 4; ++k) { float s = 0.f;
#pragma unroll
        for (int j = 0; j < 2; ++j)
#pragma unroll
            for (int e = 0; e < 8; ++e) { const float f = bf2f(v[k][j][e]); s += f * f; }
        ss[k] = s; }
#pragma unroll
    for (int o = 1; o < 64; o <<= 1) {
#pragma unroll
        for (int k = 0; k < 4; ++k) ss[k] += __shfl_xor(ss[k], o); }
    f32x4 gv[2][2];
#pragma unroll
    for (int j = 0; j < 2; ++j) { gv[j][0] = ((const f32x4*)g)[2 * lane + 128 * j]; gv[j][1] = ((const f32x4*)g)[2 * lane + 1 + 128 * j]; }
#pragma unroll
    for (int k = 0; k < 4; ++k) { const float r = rsqrtf(ss[k] * (1.f / D) + EPS);
#pragma unroll
        for (int j = 0; j < 2; ++j) {
            f32x4 o0, o1;
#pragma unroll
            for (int e = 0; e < 4; ++e) { o0[e] = bf2f(v[k][j][e]) * r * gv[j][0][e]; o1[e] = bf2f(v[k][j][4 + e]) * r * gv[j][1][e]; }
            if (OUT_BF16) { u32x4 w; w.x = pg8::cvt_pk_bf16(o0[0], o0[1]); w.y = pg8::cvt_pk_bf16(o0[2], o0[3]); w.z = pg8::cvt_pk_bf16(o1[0], o1[1]); w.w = pg8::cvt_pk_bf16(o1[2], o1[3]);
                ((u32x4*)(obase + k * rstride))[lane + 64 * j] = w; }
            else { ((f32x4*)(fbase + k * rstride))[2 * lane + 128 * j] = o0; ((f32x4*)(fbase + k * rstride))[2 * lane + 1 + 128 * j] = o1; }
        } }
}
__device__ __forceinline__ void convert_tile(LAS float* scr, const float* W, bf16_t* Wt, int K, int Nsrc, int remap, float uscale, int k0, int n0, int tid) {
    __syncthreads();
#pragma unroll
    for (int i = 0; i < 8; ++i) { const int e = tid + 512 * i, kk = e >> 6, nn = e & 63, n = n0 + nn;
        const int sc = remap ? orig_col(n) : n;
        float s = uscale;
        if (remap) { if (n >= CB_Q && n < CB_Q + 256) s = QS_DIFF; if (n >= CC_Q && n < CC_Q + 256) s = QS_DSA; }
        scr[kk * 65 + nn] = (sc >= 0) ? W[(size_t)(k0 + kk) * Nsrc + sc] * s : 0.f; }
    __syncthreads();
    { const int nn = tid >> 3, kc = (tid & 7) * 8;
        u32x4 w; w.x = pg8::cvt_pk_bf16(scr[(kc + 0) * 65 + nn], scr[(kc + 1) * 65 + nn]); w.y = pg8::cvt_pk_bf16(scr[(kc + 2) * 65 + nn], scr[(kc + 3) * 65 + nn]);
        w.z = pg8::cvt_pk_bf16(scr[(kc + 4) * 65 + nn], scr[(kc + 5) * 65 + nn]); w.w = pg8::cvt_pk_bf16(scr[(kc + 6) * 65 + nn], scr[(kc + 7) * 65 + nn]);
        *(u32x4*)(Wt + (size_t)(n0 + nn) * K + k0 + kc) = w; }
}
namespace fa {
typedef short ps16x2 __attribute__((ext_vector_type(2)));
typedef unsigned short pu16x2 __attribute__((ext_vector_type(2)));
__device__ __forceinline__ unsigned ppk_lt(unsigned v, unsigned c) { const ps16x2 d = __builtin_elementwise_sub_sat(__builtin_bit_cast(ps16x2, v), __builtin_bit_cast(ps16x2, c)); return __builtin_bit_cast(unsigned, __builtin_bit_cast(pu16x2, d) >> 15); }
__device__ __forceinline__ unsigned ppk_add(unsigned a, unsigned b) { return __builtin_bit_cast(unsigned, __builtin_bit_cast(pu16x2, a) + __builtin_bit_cast(pu16x2, b)); }
typedef float f32x16 __attribute__((ext_vector_type(16)));
typedef short s16x4 __attribute__((ext_vector_type(4)));
typedef short v4i16_t __attribute__((ext_vector_type(4)));
constexpr int KCS = 1040;
constexpr int KBUF = 12 * KCS + 64;
constexpr int L_K0 = 0, L_V0 = 4 * KBUF, L_WSF = L_V0 + 4 * 8192, L_BIAS = L_WSF + 8 * 256, L_END = L_BIAS + 12 * 320 * 4, L_FLAG = L_END;
constexpr float THR = 6.0f;
constexpr float LOG2E = 1.4426950408889634f;
__device__ __forceinline__ int crow(int r, int hi) { return (r & 3) + 8 * (r >> 2) + 4 * hi; }
__device__ __forceinline__ unsigned cvtpk(float lo, float hi) { typedef float f2 __attribute__((ext_vector_type(2))); typedef __bf16 b2 __attribute__((ext_vector_type(2)));
    f2 v = {lo, hi}; b2 r = __builtin_convertvector(v, b2); return __builtin_bit_cast(unsigned, r); }
__device__ __forceinline__ s16x4 vtr(const LAS unsigned char* p) { return __builtin_bit_cast(s16x4, __builtin_amdgcn_ds_read_tr16_b64_v4i16((LAS v4i16_t*)p)); }
__device__ __forceinline__ float max3f(float a, float b, float c) { float r; asm("v_max3_f32 %0, %1, %2, %3" : "=v"(r) : "v"(a), "v"(b), "v"(c)); return r; }
__device__ __forceinline__ float max2f(float a, float b) { float r; asm("v_max_f32_e32 %0, %1, %2" : "=v"(r) : "v"(a), "v"(b)); return r; }
#define FA_ROWMAX(rm, S0, S1) do { asm volatile("s_nop 15\n\ts_nop 7" : "+v"(S0), "+v"(S1)); \
        float a_ = max3f(S0[0], S0[1], S1[0]), b_ = max3f(S0[2], S0[3], S1[1]); a_ = max3f(a_, S1[2], S1[3]); \
        _Pragma("unroll") for (int r = 4; r < 16; r += 4) { a_ = max3f(a_, S0[r], S0[r + 1]); b_ = max3f(b_, S0[r + 2], S0[r + 3]); a_ = max3f(a_, S1[r], S1[r + 1]); b_ = max3f(b_, S1[r + 2], S1[r + 3]); } \
        rm = max2f(a_, b_); } while (0)
__device__ __forceinline__ float xhalf_max(float v) { auto rr = __builtin_amdgcn_permlane32_swap(__float_as_uint(v), __float_as_uint(v), false, false); return fmaxf(__uint_as_float(rr[0]), __uint_as_float(rr[1])); }
__device__ __forceinline__ float xhalf_sum(float v) { auto rr = __builtin_amdgcn_permlane32_swap(__float_as_uint(v), __float_as_uint(v), false, false); return __uint_as_float(rr[0]) + __uint_as_float(rr[1]); }

__device__ __forceinline__ void build_bias(LAS unsigned char* lds, const float* rel_bias) {
    LAS float* bt = (LAS float*)(lds + L_BIAS);
    for (int e = opaque_tid(); e < 12 * 320; e += NTHR) { const int col = e / 320, i = e % 320;
        bt[e] = (rel_bias[rel_bucket(i - 256) * 12 + col] - rel_bias[15 * 12 + col]) * LOG2E; }
}

template <int TYPE>
__device__ __forceinline__ void attn_unit(LAS unsigned char* lds, int b, int h, int qb, int layer) {
    ArgsP A = get_args();
    unsigned char* ws = A->ws;
    const bf16_t* P = (const bf16_t*)(ws + WS_P);
    const int tid = opaque_tid(), lane = tid & 63, r32 = lane & 31, hi = lane >> 5, wid = __builtin_amdgcn_readfirstlane(tid >> 6);
    constexpr int DK = (TYPE == 0) ? 96 : 64, NCH = DK / 8, NPASS = (TYPE == 1) ? 2 : 1, DQ = (TYPE == 0) ? 96 : (TYPE == 1) ? 32 : 64, NQF = DQ / 16;
    const size_t row0 = (size_t)b * S;
    const bf16_t* Kg; const bf16_t* Vg; int kpitch, vpitch;
    if (TYPE == 0) { Kg = (const bf16_t*)(ws + WS_KA) + row0 * 384 + h * 96; kpitch = 384; Vg = (const bf16_t*)(ws + WS_VA) + row0 * 256 + h * 64; vpitch = 256; }
    else { Kg = P + row0 * PC + ((TYPE == 1) ? CB_K : CC_K) + h * 64; kpitch = PC; Vg = P + row0 * PC + ((TYPE == 1) ? CB_V : CC_V) + h * 64; vpitch = PC; }
    const int k0key = tid / NCH, k0ch = tid % NCH;
    const int k1key = (tid + 512) / NCH, k1ch = (tid + 512) % NCH;
    const bool has_k1 = (NCH == 12) && (tid < 256);
    const int vkey = tid >> 3, vc8 = tid & 7;
    const bf16_t* kg0 = Kg + (size_t)k0key * kpitch + k0ch * 8;
    const bf16_t* kg1 = Kg + (size_t)k1key * kpitch + k1ch * 8;
    const bf16_t* vg0 = Vg + (size_t)vkey * vpitch + vc8 * 8;
    const int kl0 = k0ch * KCS + k0key * 16, kl1 = k1ch * KCS + k1key * 16;
    const int vl0 = ((vc8 >> 2) * 4 + (vkey >> 4)) * 1024 + (vkey & 15) * 64 + (vc8 & 3) * 16;
    const int qw = qb * 256 + wid * 32;
    const size_t tq = row0 + qw + r32;
    const int NT = 4 * qb + 4, NTw = 4 * qb + (wid >> 1) + 1, TM = 4 * qb;
    LAS float* wsf = (LAS float*)(lds + L_WSF) + wid * 64;
    const LAS unsigned char* vfb = lds + L_V0 + ((lane >> 4) & 1) * 32 + (lane & 3) * 8 + (4 * hi + ((lane & 15) >> 2)) * 64;
    const unsigned* mrow = (const unsigned*)(ws + WS_MASK) + tq * 128;
    float* okl = (float*)(ws + WS_OKL) + ((size_t)opaque_bid() * 8 + wid) * 2048 + lane;
    f32x16 o0 = f32x16{}, o1 = f32x16{};
    float mhat = 0.f, lsum = 0.f;
    constexpr bool LMF = false;
    f32x16 lac = f32x16{};
    int fast = 1; asm volatile("" : "+s"(fast));
#pragma unroll 1
    for (;;) {
#pragma unroll 1
    for (int mp = 0; mp < NPASS; ++mp) {
    bf16x8 qf[NQF];
#pragma unroll
    for (int d0 = 0; d0 < NQF; ++d0) {
        const bf16_t* qp = (TYPE == 0) ? (const bf16_t*)(ws + WS_QA) + tq * 384 + h * 96 + 16 * d0 + 8 * hi
                                       : P + tq * PC + ((TYPE == 1) ? CB_Q + mp * 32 : CC_Q) + h * 64 + 16 * d0 + 8 * hi;
        qf[d0] = *(const bf16x8*)qp;
    }
    mhat = 0.f; lsum = 0.f; o0 = f32x16{}; o1 = f32x16{}; lac = f32x16{};
    const LAS unsigned char* kfb = lds + L_K0 + hi * KCS + r32 * 16 + ((TYPE == 1) ? mp * 4 * KCS : 0);
    const LAS unsigned char* btb = lds + L_BIAS + (256 + 4 * hi - r32 - qw) * 4 + ((TYPE == 1) ? 2 * h + mp : 8 + h) * 1280;
    u32x4 kr0, kr1, vr;
    const bf16_t* kp0 = kg0; const bf16_t* kp1 = kg1; const bf16_t* vp0 = vg0;
    const size_t kstep = (size_t)64 * kpitch, vstep = (size_t)64 * vpitch;
#define FA_BIAS(S0, S1, t) do { if (TYPE != 0) { if (64 * (t) > qw - 154) { const LAS float* bt = (const LAS float*)(btb + (t) * 256); \
            _Pragma("unroll") for (int r = 0; r < 16; ++r) { S0[r] += bt[(r & 3) + 8 * (r >> 2)]; S1[r] += bt[32 + (r & 3) + 8 * (r >> 2)]; } } } } while (0)
#define FA_RESCALE(S0, S1, t) do { if (fast) break; \
        float rm; FA_ROWMAX(rm, S0, S1); \
        rm = xhalf_max(rm); \
        const bool first = ((t) == 0); \
        if (__any(first || rm > THR)) { \
            const float dl = first ? fmaxf(rm, -64.f) : fmaxf(rm, 0.f);     \
            mhat += dl; \
            _Pragma("unroll") for (int r = 0; r < 16; ++r) { S0[r] -= dl; S1[r] -= dl; } \
            if (!first) { const float f = __builtin_amdgcn_exp2f(-dl); lsum *= f; \
                if (hi == 0) wsf[r32] = f; \
                _Pragma("unroll") for (int r = 0; r < 16; ++r) { const float fr_ = wsf[crow(r, hi)]; o0[r] *= fr_; o1[r] *= fr_; if (LMF) lac[r] *= fr_; } \
                asm volatile("" ::: "memory"); } \
        } } while (0)
#define FA_EXP(S0, S1) do { float sacc = 0.f; \
        _Pragma("unroll") for (int r = 0; r < 16; ++r) { \
            S0[r] = __builtin_amdgcn_exp2f(S0[r]); S1[r] = __builtin_amdgcn_exp2f(S1[r]); \
            if (!LMF) sacc += S0[r] + S1[r]; } \
        if (!LMF) lsum += sacc; \
        _Pragma("unroll") for (int i = 0; i < 4; ++i) { pw[0][i] = cvtpk(S0[2 * i], S0[2 * i + 1]); pw[1][i] = cvtpk(S0[8 + 2 * i], S0[8 + 2 * i + 1]); \
                                                       pw[2][i] = cvtpk(S1[2 * i], S1[2 * i + 1]); pw[3][i] = cvtpk(S1[8 + 2 * i], S1[8 + 2 * i + 1]); } } while (0)
#define FA_PV() do { \
        _Pragma("unroll") for (int ks = 0; ks < 4; ++ks) { const bf16x8 vfrag = (bf16x8){vlo_[ks][0], vlo_[ks][1], vlo_[ks][2], vlo_[ks][3], vhi_[ks][0], vhi_[ks][1], vhi_[ks][2], vhi_[ks][3]}; \
            o0 = __builtin_amdgcn_mfma_f32_32x32x16_bf16(__builtin_bit_cast(bf16x8, pw[ks]), vfrag, o0, 0, 0, 0); \
            if (LMF) lac = __builtin_amdgcn_mfma_f32_32x32x16_bf16(__builtin_bit_cast(bf16x8, pw[ks]), (bf16x8){0x3F80, 0x3F80, 0x3F80, 0x3F80, 0x3F80, 0x3F80, 0x3F80, 0x3F80}, lac, 0, 0, 0); } \
        _Pragma("unroll") for (int i = 0; i < 4; ++i) { vlo_[i] = vtr(vb_ + (4 + i) * 1024); vhi_[i] = vtr(vb_ + (4 + i) * 1024 + 512); } \
        _Pragma("unroll") for (int ks = 0; ks < 4; ++ks) { const bf16x8 vfrag = (bf16x8){vlo_[ks][0], vlo_[ks][1], vlo_[ks][2], vlo_[ks][3], vhi_[ks][0], vhi_[ks][1], vhi_[ks][2], vhi_[ks][3]}; \
            o1 = __builtin_amdgcn_mfma_f32_32x32x16_bf16(__builtin_bit_cast(bf16x8, pw[ks]), vfrag, o1, 0, 0, 0); } } while (0)
#define FA_KLOAD(ks_off) do { const LAS unsigned char* kb_ = kfb + (ks_off); \
        _Pragma("unroll") for (int d0 = 0; d0 < NQF; ++d0) { ka_[d0][0] = *(const LAS bf16x8*)(kb_ + d0 * 2 * KCS); ka_[d0][1] = *(const LAS bf16x8*)(kb_ + d0 * 2 * KCS + 512); } } while (0)
#define FA_QKMFMA(N0, N1, tt, MW0, MW1) do { \
        if (TYPE == 2) { const unsigned w0_ = MW0 >> (4 * hi), w1_ = MW1 >> (4 * hi); const unsigned nm_ = __float_as_uint(-mhat); unsigned neg_ = 0xF149F2CAu; asm volatile("" : "+v"(neg_)); \
            _Pragma("unroll") for (int r = 0; r < 16; ++r) { const int pos_ = (r & 3) + 8 * (r >> 2); \
                const unsigned k0m = (unsigned)((int)(w0_ << (31 - pos_)) >> 31), k1m = (unsigned)((int)(w1_ << (31 - pos_)) >> 31); \
                N0[r] = __uint_as_float(__builtin_amdgcn_bitop3_b32(k0m, nm_, neg_, 0xCA)); N1[r] = __uint_as_float(__builtin_amdgcn_bitop3_b32(k1m, nm_, neg_, 0xCA)); } }     \
        else if (fast) { N0 = __builtin_amdgcn_mfma_f32_32x32x16_bf16(ka_[0][0], qf[0], f32x16{}, 0, 0, 0); N1 = __builtin_amdgcn_mfma_f32_32x32x16_bf16(ka_[0][1], qf[0], f32x16{}, 0, 0, 0); } \
        else { const float nm_ = -mhat; N0 = (f32x16){nm_, nm_, nm_, nm_, nm_, nm_, nm_, nm_, nm_, nm_, nm_, nm_, nm_, nm_, nm_, nm_}; N1 = N0; \
            N0 = __builtin_amdgcn_mfma_f32_32x32x16_bf16(ka_[0][0], qf[0], N0, 0, 0, 0); N1 = __builtin_amdgcn_mfma_f32_32x32x16_bf16(ka_[0][1], qf[0], N1, 0, 0, 0); } \
        _Pragma("unroll") for (int d0 = (TYPE == 2) ? 0 : 1; d0 < NQF; ++d0) { \
            N0 = __builtin_amdgcn_mfma_f32_32x32x16_bf16(ka_[d0][0], qf[d0], N0, 0, 0, 0); \
            N1 = __builtin_amdgcn_mfma_f32_32x32x16_bf16(ka_[d0][1], qf[d0], N1, 0, 0, 0); } } while (0)
#define FA_VLOAD(vs_off) const LAS unsigned char* vb_ = vfb + (vs_off); \
        _Pragma("unroll") for (int i = 0; i < 4; ++i) { vlo_[i] = vtr(vb_ + i * 1024); vhi_[i] = vtr(vb_ + i * 1024 + 512); }
#define FA_MASKW(t)
#define FA_STEP_U(C0, C1, N0, N1, t, vs_off, nks_off, MW0, MW1) do { \
        bf16x8 ka_[NQF][2]; s16x4 vlo_[4], vhi_[4]; u32x4 pw[4]; \
        FA_KLOAD(nks_off); FA_VLOAD(vs_off); FA_MASKW(t); \
        FA_BIAS(C0, C1, t); FA_RESCALE(C0, C1, t); \
        FA_QKMFMA(N0, N1, (t) + 1, MW0, MW1); FA_EXP(C0, C1); FA_PV(); } while (0)
#define FA_STEP_C(C0, C1, N0, N1, t, vs_off, nks_off, MW0, MW1) do { \
        if ((t) + 1 < NTw) { bf16x8 ka_[NQF][2]; FA_KLOAD(nks_off); FA_QKMFMA(N0, N1, (t) + 1, MW0, MW1); } \
        if ((t) < NTw) { s16x4 vlo_[4], vhi_[4]; u32x4 pw[4]; FA_VLOAD(vs_off); FA_MASKW(t); \
            FA_BIAS(C0, C1, t); \
            if (!fast) { float rm; FA_ROWMAX(rm, C0, C1); \
              rm = xhalf_max(rm); \
              const bool first = ((t) == 0); \
              if (__any(first || rm > THR)) { \
                const float dl = first ? fmaxf(rm, -64.f) : fmaxf(rm, 0.f);     \
                mhat += dl; \
                _Pragma("unroll") for (int r = 0; r < 16; ++r) { C0[r] -= dl; C1[r] -= dl; N0[r] -= dl; N1[r] -= dl; } \
                if (!first) { const float f = __builtin_amdgcn_exp2f(-dl); lsum *= f; \
                    if (hi == 0) wsf[r32] = f; \
                    _Pragma("unroll") for (int r = 0; r < 16; ++r) { const float fr_ = wsf[crow(r, hi)]; o0[r] *= fr_; o1[r] *= fr_; if (LMF) lac[r] *= fr_; } \
                    asm volatile("" ::: "memory"); } } } \
            FA_EXP(C0, C1); FA_PV(); } } while (0)
#define FA_LOADKV(tk, tv) do { if (FA_UNC || (tk) < NT) { kr0 = *(const u32x4*)kp0; if (has_k1) kr1 = *(const u32x4*)kp1; kp0 += kstep; kp1 += kstep; } \
        if (FA_UNC || (tv) < NT) { vr = *(const u32x4*)vp0; vp0 += vstep; } } while (0)
#define FA_COMMIT(tk, kslot, tv, vslot) do { if (FA_UNC || (tk) < NT) { *(LAS u32x4*)(lds + L_K0 + (kslot) + kl0) = kr0; if (has_k1) *(LAS u32x4*)(lds + L_K0 + (kslot) + kl1) = kr1; } \
        if (FA_UNC || (tv) < NT) *(LAS u32x4*)(lds + L_V0 + (vslot) + vl0) = vr; } while (0)
#define FA_UNC 0
    {
        FA_LOADKV(0, 0);
        const u32x4 ka0 = kr0, ka1 = kr1, va = vr;
        FA_LOADKV(1, 1);
        const u32x4 kb0 = kr0, kb1 = kr1, vb = vr;
        FA_LOADKV(2, NT);
        __syncthreads();
        *(LAS u32x4*)(lds + L_K0 + kl0) = ka0; if (has_k1) *(LAS u32x4*)(lds + L_K0 + kl1) = ka1; *(LAS u32x4*)(lds + L_V0 + vl0) = va;
        *(LAS u32x4*)(lds + L_K0 + KBUF + kl0) = kb0; if (has_k1) *(LAS u32x4*)(lds + L_K0 + KBUF + kl1) = kb1; *(LAS u32x4*)(lds + L_V0 + 8192 + vl0) = vb;
        FA_COMMIT(2, 2 * KBUF, NT, 0);
        if (fast && mp == 0 && tid == 0) *(volatile LAS unsigned*)(lds + L_FLAG) = 0u;
    }
    __syncthreads();
    f32x16 sA0, sA1, sB0, sB1;
    unsigned mwA0 = 0u, mwA1 = 0u, mwB0 = 0u, mwB1 = 0u;
#define FA_MLOAD(W0, W1, tt) do { if (TYPE == 2 && (FA_UNC || (tt) < NT)) { W0 = mrow[2 * (tt)]; W1 = mrow[2 * (tt) + 1]; } } while (0)
    FA_MLOAD(mwA0, mwA1, 0); FA_MLOAD(mwB0, mwB1, 1);
    { bf16x8 ka_[NQF][2]; FA_KLOAD(0); FA_QKMFMA(sA0, sA1, 0, mwA0, mwA1); }
    __syncthreads();
#pragma unroll
    for (int r = 0; r < 16; ++r) { sB0[r] = 0.f; sB1[r] = 0.f; }
#define FA_KS(tt) ((((tt)) & 3) * KBUF)
#define FA_VS(tt) ((((tt)) & 3) * 8192)
    int t = 0;
#undef FA_UNC
#define FA_UNC 1
    for (; t < TM; t += 2) {
        FA_LOADKV(t + 3, t + 2); FA_MLOAD(mwA0, mwA1, t + 2);
        FA_STEP_U(sA0, sA1, sB0, sB1, t, FA_VS(t), FA_KS(t + 1), mwB0, mwB1);
        FA_COMMIT(t + 3, FA_KS(t + 3), t + 2, FA_VS(t + 2));
        FA_LOADKV(t + 4, t + 3); FA_MLOAD(mwB0, mwB1, t + 3);
        FA_STEP_U(sB0, sB1, sA0, sA1, t + 1, FA_VS(t + 1), FA_KS(t + 2), mwA0, mwA1);
        FA_COMMIT(t + 4, FA_KS(t + 4), t + 3, FA_VS(t + 3));
        __syncthreads();
    }
#undef FA_UNC
#define FA_UNC 0
    for (; t < NT; t += 2) {
        FA_LOADKV(t + 3, t + 2); FA_MLOAD(mwA0, mwA1, t + 2);
        FA_STEP_C(sA0, sA1, sB0, sB1, t, FA_VS(t), FA_KS(t + 1), mwB0, mwB1);
        FA_COMMIT(t + 3, FA_KS(t + 3), t + 2, FA_VS(t + 2));
        FA_LOADKV(t + 4, t + 3); FA_MLOAD(mwB0, mwB1, t + 3);
        FA_STEP_C(sB0, sB1, sA0, sA1, t + 1, FA_VS(t + 1), FA_KS(t + 2), mwA0, mwA1);
        FA_COMMIT(t + 4, FA_KS(t + 4), t + 3, FA_VS(t + 3));
        __syncthreads();
    }
#undef FA_KS
#undef FA_UNC
#undef FA_MLOAD
#undef FA_VS
#undef FA_BIAS
#undef FA_RESCALE
#undef FA_EXP
#undef FA_PV
#undef FA_KLOAD
#undef FA_QKMFMA
#undef FA_VLOAD
#undef FA_MASKW
#undef FA_STEP_U
#undef FA_STEP_C
#undef FA_LOADKV
#undef FA_COMMIT
    if (LMF) {
        if (fast) { bool okr = true;
#pragma unroll
            for (int r = 0; r < 16; ++r) okr = okr && (lac[r] >= 0x1p-90f) && (lac[r] <= 0x1p90f);
            if (!okr) *(volatile LAS unsigned*)(lds + L_FLAG) = 1u; }
#pragma unroll
        for (int r = 0; r < 16; ++r) { const float iv = __builtin_amdgcn_rcpf(lac[r]); o0[r] *= iv; o1[r] *= iv; }
    } else {
        const float lt = xhalf_sum(lsum);
        if (fast) { if (!(lt >= 0x1p-90f && lt <= 0x1p90f)) *(volatile LAS unsigned*)(lds + L_FLAG) = 1u; }
        if (hi == 0) wsf[32 + r32] = __builtin_amdgcn_rcpf(lt);
#pragma unroll
        for (int r = 0; r < 16; ++r) { const float iv = wsf[32 + crow(r, hi)]; o0[r] *= iv; o1[r] *= iv; }
        asm volatile("" ::: "memory");
    }
    if (TYPE == 1 && mp == 0) {
#pragma unroll
        for (int r = 0; r < 16; ++r) { okl[r * 64] = o0[r]; okl[(16 + r) * 64] = o1[r]; }
    }
    }
    if (!fast) break;
    __syncthreads();
    if (__builtin_amdgcn_readfirstlane(*(volatile LAS unsigned*)(lds + L_FLAG)) == 0u) break;
    fast = 0;
    }
    const int gcol = (TYPE == 0) ? CA_G : (TYPE == 1) ? CB_G : CC_G;
    bf16_t* Y = (bf16_t*)(ws + WS_Y);
    float gs0[16], gs1[16];
    {
        bf16_t gr0[16], gr1[16];
#pragma unroll
        for (int r = 0; r < 16; ++r) { const bf16_t* gp = P + (row0 + qw + crow(r, hi)) * PC + gcol + h * 64; gr0[r] = gp[r32]; gr1[r] = gp[32 + r32]; }
#pragma unroll
        for (int r = 0; r < 16; ++r) { const float a0 = bf2f(gr0[r]), a1 = bf2f(gr1[r]);
            gs0[r] = a0 * __builtin_amdgcn_rcpf(1.f + __expf(-a0)); gs1[r] = a1 * __builtin_amdgcn_rcpf(1.f + __expf(-a1)); }
    }
    if (TYPE == 1) {
        const float* lamp = A->dlam + layer * 128;
        float s1 = 0.f, s2 = 0.f;
        for (int i = 0; i < 32; ++i) { s1 += lamp[i] * lamp[32 + i]; s2 += lamp[64 + i] * lamp[96 + i]; }
        const float lambda_init = A->lambda_init[layer];
        const float lam = __expf(s1) - __expf(s2) + lambda_init;
        const float g0 = A->subg[layer * 64 + r32], g1 = A->subg[layer * 64 + 32 + r32];
#pragma unroll
        for (int r = 0; r < 16; ++r) {
            const float v0 = okl[r * 64] - lam * o0[r];
            const float v1 = okl[(16 + r) * 64] - lam * o1[r];
            float ss = v0 * v0 + v1 * v1;
#pragma unroll
            for (int off = 1; off < 32; off <<= 1) ss += __shfl_xor(ss, off);
            const float rr = rsqrtf(ss * (1.f / 64.f) + EPS) * (1.f - lambda_init);
            bf16_t* yp = Y + (row0 + qw + crow(r, hi)) * D + 256 + h * 64;
            yp[r32] = f2bf(v0 * rr * g0 * gs0[r]);
            yp[32 + r32] = f2bf(v1 * rr * g1 * gs1[r]);
        }
    } else {
#pragma unroll
        for (int r = 0; r < 16; ++r) {
            bf16_t* yp = Y + (row0 + qw + crow(r, hi)) * D + TYPE * 256 + h * 64;
            yp[r32] = f2bf(o0[r] * gs0[r]);
            yp[32 + r32] = f2bf(o1[r] * gs1[r]);
        }
    }
}
__device__ __forceinline__ void attn_unit_diff(LAS unsigned char* lds, int b, int h, int qb, int layer) {
    ArgsP A = get_args();
    unsigned char* ws = A->ws;
    const bf16_t* P = (const bf16_t*)(ws + WS_P);
    const int tid = opaque_tid(), lane = tid & 63, r32 = lane & 31, hi = lane >> 5, wid = __builtin_amdgcn_readfirstlane(tid >> 6);
    const size_t row0 = (size_t)b * S;
    const int skey = tid >> 3, sch = tid & 7;
    const bf16_t* kg0 = P + (row0 + skey) * PC + CB_K + h * 64 + sch * 8;
    const bf16_t* vg0 = P + (row0 + skey) * PC + CB_V + h * 64 + sch * 8;
    const int kl0 = sch * KCS + skey * 16;
    const int vl0 = ((sch >> 2) * 4 + (skey >> 4)) * 1024 + (skey & 15) * 64 + (sch & 3) * 16;
    const int qw = qb * 256 + wid * 32;
    const size_t tq = row0 + qw + r32;
    const int NT = 4 * qb + 4, NTw = 4 * qb + (wid >> 1) + 1, TM = 4 * qb;
    LAS float* wsf = (LAS float*)(lds + L_WSF) + wid * 64;
    const LAS unsigned char* vfb = lds + L_V0 + ((lane >> 4) & 1) * 32 + (lane & 3) * 8 + (4 * hi + ((lane & 15) >> 2)) * 64;
    const LAS unsigned char* kfA = lds + L_K0 + hi * KCS + r32 * 16;
    const LAS unsigned char* kfB = kfA + 4 * KCS;
    const LAS unsigned char* btA = lds + L_BIAS + (256 + 4 * hi - r32 - qw) * 4 + (2 * h) * 1280;
    const LAS unsigned char* btB = btA + 1280;
    bf16x8 qA[2], qB[2];
#pragma unroll
    for (int d0 = 0; d0 < 2; ++d0) { qA[d0] = *(const bf16x8*)(P + tq * PC + CB_Q + h * 64 + 16 * d0 + 8 * hi); qB[d0] = *(const bf16x8*)(P + tq * PC + CB_Q + 32 + h * 64 + 16 * d0 + 8 * hi); }
    f32x16 oA0, oA1, oB0, oB1;
    float mA, mB, lA, lB;
    const size_t tstep = (size_t)64 * PC;
    int fast = 1; asm volatile("" : "+s"(fast));
#define DF_KS(tt) ((((tt)) & 3) * KBUF)
#define DF_VS(tt) ((((tt)) & 3) * 8192)
#define DF_QK(N0, N1, KF, ks_off, QF, MH) do { const LAS unsigned char* kb_ = (KF) + (ks_off); \
        const bf16x8 k00 = *(const LAS bf16x8*)kb_, k01 = *(const LAS bf16x8*)(kb_ + 512), k10 = *(const LAS bf16x8*)(kb_ + 2 * KCS), k11 = *(const LAS bf16x8*)(kb_ + 2 * KCS + 512); \
        if (fast) { N0 = __builtin_amdgcn_mfma_f32_32x32x16_bf16(k00, QF[0], f32x16{}, 0, 0, 0); N1 = __builtin_amdgcn_mfma_f32_32x32x16_bf16(k01, QF[0], f32x16{}, 0, 0, 0); } \
        else { const float nm_ = -(MH); N0 = (f32x16){nm_, nm_, nm_, nm_, nm_, nm_, nm_, nm_, nm_, nm_, nm_, nm_, nm_, nm_, nm_, nm_}; N1 = N0; \
            N0 = __builtin_amdgcn_mfma_f32_32x32x16_bf16(k00, QF[0], N0, 0, 0, 0); N1 = __builtin_amdgcn_mfma_f32_32x32x16_bf16(k01, QF[0], N1, 0, 0, 0); } \
        N0 = __builtin_amdgcn_mfma_f32_32x32x16_bf16(k10, QF[1], N0, 0, 0, 0); N1 = __builtin_amdgcn_mfma_f32_32x32x16_bf16(k11, QF[1], N1, 0, 0, 0); } while (0)
#define DF_SOFTMAX(S0, S1, O0, O1, MH, LS, BT, WOFF, t, PW) do { \
        if (64 * (t) > qw - 154) { const LAS float* bt = (const LAS float*)((BT) + (t) * 256); \
            _Pragma("unroll") for (int r = 0; r < 16; ++r) { S0[r] += bt[(r & 3) + 8 * (r >> 2)]; S1[r] += bt[32 + (r & 3) + 8 * (r >> 2)]; } } \
        if (!fast) { float rm; FA_ROWMAX(rm, S0, S1); rm = xhalf_max(rm); const bool first = ((t) == 0); \
            if (__any(first || rm > THR)) { const float dl = first ? fmaxf(rm, -64.f) : fmaxf(rm, 0.f); MH += dl; \
                _Pragma("unroll") for (int r = 0; r < 16; ++r) { S0[r] -= dl; S1[r] -= dl; } \
                if (!first) { const float f = __builtin_amdgcn_exp2f(-dl); LS *= f; if (hi == 0) wsf[(WOFF) + r32] = f; \
                    _Pragma("unroll") for (int r = 0; r < 16; ++r) { const float fr_ = wsf[(WOFF) + crow(r, hi)]; O0[r] *= fr_; O1[r] *= fr_; } \
                    asm volatile("" ::: "memory"); } } } \
        { float sacc = 0.f; \
          _Pragma("unroll") for (int r = 0; r < 16; ++r) { S0[r] = __builtin_amdgcn_exp2f(S0[r]); S1[r] = __builtin_amdgcn_exp2f(S1[r]); sacc += S0[r] + S1[r]; } \
          LS += sacc; } \
        _Pragma("unroll") for (int i = 0; i < 4; ++i) { PW[0][i] = cvtpk(S0[2 * i], S0[2 * i + 1]); PW[1][i] = cvtpk(S0[8 + 2 * i], S0[8 + 2 * i + 1]); \
                                                       PW[2][i] = cvtpk(S1[2 * i], S1[2 * i + 1]); PW[3][i] = cvtpk(S1[8 + 2 * i], S1[8 + 2 * i + 1]); } } while (0)
#define DF_VLOAD(vs_off, G0) do { const LAS unsigned char* vb_ = vfb + (vs_off); \
        _Pragma("unroll") for (int i = 0; i < 4; ++i) { vlo_[i] = vtr(vb_ + ((G0) + i) * 1024); vhi_[i] = vtr(vb_ + ((G0) + i) * 1024 + 512); } } while (0)
#define DF_PV(O0, O1, PW, vs_off) do { \
        DF_VLOAD(vs_off, 0); \
        _Pragma("unroll") for (int ks = 0; ks < 4; ++ks) { const bf16x8 vf = (bf16x8){vlo_[ks][0], vlo_[ks][1], vlo_[ks][2], vlo_[ks][3], vhi_[ks][0], vhi_[ks][1], vhi_[ks][2], vhi_[ks][3]}; \
            O0 = __builtin_amdgcn_mfma_f32_32x32x16_bf16(__builtin_bit_cast(bf16x8, PW[ks]), vf, O0, 0, 0, 0); } \
        DF_VLOAD(vs_off, 4); \
        _Pragma("unroll") for (int ks = 0; ks < 4; ++ks) { const bf16x8 vf = (bf16x8){vlo_[ks][0], vlo_[ks][1], vlo_[ks][2], vlo_[ks][3], vhi_[ks][0], vhi_[ks][1], vhi_[ks][2], vhi_[ks][3]}; \
            O1 = __builtin_amdgcn_mfma_f32_32x32x16_bf16(__builtin_bit_cast(bf16x8, PW[ks]), vf, O1, 0, 0, 0); } } while (0)
#define DF_STEP(COND, t) do { \
        if (!(COND) || (t) + 2 < NT) { kr = *(const u32x4*)kp; kp += tstep; } \
        if (!(COND) || (t) + 1 < NT) { vr = *(const u32x4*)vp; vp += tstep; } \
        if (!(COND) || (t) < NTw) { s16x4 vlo_[4], vhi_[4]; u32x4 pw[4]; \
            DF_QK(sB0, sB1, kfB, DF_KS(t), qB, mB); \
            DF_SOFTMAX(sA0, sA1, oA0, oA1, mA, lA, btA, 0, t, pw); \
            DF_PV(oA0, oA1, pw, DF_VS(t)); \
            DF_SOFTMAX(sB0, sB1, oB0, oB1, mB, lB, btB, 32, t, pw); \
            if (!(COND) || (t) + 1 < NTw) DF_QK(sA0, sA1, kfA, DF_KS((t) + 1), qA, mA); \
            DF_PV(oB0, oB1, pw, DF_VS(t)); } \
        if (!(COND) || (t) + 2 < NT) *(LAS u32x4*)(lds + L_K0 + DF_KS((t) + 2) + kl0) = kr; \
        if (!(COND) || (t) + 1 < NT) *(LAS u32x4*)(lds + L_V0 + DF_VS((t) + 1) + vl0) = vr; \
        __syncthreads(); } while (0)
#pragma unroll 1
    for (;;) {
        mA = 0.f; mB = 0.f; lA = 0.f; lB = 0.f; oA0 = f32x16{}; oA1 = f32x16{}; oB0 = f32x16{}; oB1 = f32x16{};
        const bf16_t* kp = kg0; const bf16_t* vp = vg0;
        u32x4 kr, vr;
        {
            const u32x4 ka = *(const u32x4*)kp; kp += tstep; const u32x4 va = *(const u32x4*)vp; vp += tstep; const u32x4 kb = *(const u32x4*)kp; kp += tstep;
            __syncthreads();
            *(LAS u32x4*)(lds + L_K0 + kl0) = ka; *(LAS u32x4*)(lds + L_V0 + vl0) = va; *(LAS u32x4*)(lds + L_K0 + KBUF + kl0) = kb;
            if (fast && tid == 0) *(volatile LAS unsigned*)(lds + L_FLAG) = 0u;
        }
        __syncthreads();
        f32x16 sA0, sA1, sB0, sB1;
        DF_QK(sA0, sA1, kfA, 0, qA, mA);
#pragma unroll
        for (int r = 0; r < 16; ++r) { sB0[r] = 0.f; sB1[r] = 0.f; }
        int t = 0;
        _Pragma("unroll 1") for (; t < TM; ++t) { DF_STEP(false, t); }
        _Pragma("unroll 1") for (; t < NT; ++t) { DF_STEP(true, t); }
        {
            const float ltA = xhalf_sum(lA), ltB = xhalf_sum(lB);
            if (fast) { if (!(ltA >= 0x1p-90f && ltA <= 0x1p90f && ltB >= 0x1p-90f && ltB <= 0x1p90f)) *(volatile LAS unsigned*)(lds + L_FLAG) = 1u; }
            if (hi == 0) { wsf[r32] = __builtin_amdgcn_rcpf(ltA); wsf[32 + r32] = __builtin_amdgcn_rcpf(ltB); }
#pragma unroll
            for (int r = 0; r < 16; ++r) { const float ia = wsf[crow(r, hi)], ib = wsf[32 + crow(r, hi)]; oA0[r] *= ia; oA1[r] *= ia; oB0[r] *= ib; oB1[r] *= ib; }
            asm volatile("" ::: "memory");
        }
        if (!fast) break;
        __syncthreads();
        if (__builtin_amdgcn_readfirstlane(*(volatile LAS unsigned*)(lds + L_FLAG)) == 0u) break;
        fast = 0;
    }
#undef DF_STEP
#undef DF_PV
#undef DF_VLOAD
#undef DF_SOFTMAX
#undef DF_QK
#undef DF_KS
#undef DF_VS
    bf16_t* Y = (bf16_t*)(ws + WS_Y);
    float gs0[16], gs1[16];
    {
        bf16_t gr0[16], gr1[16];
#pragma unroll
        for (int r = 0; r < 16; ++r) { const bf16_t* gp = P + (row0 + qw + crow(r, hi)) * PC + CB_G + h * 64; gr0[r] = gp[r32]; gr1[r] = gp[32 + r32]; }
#pragma unroll
        for (int r = 0; r < 16; ++r) { const float a0 = bf2f(gr0[r]), a1 = bf2f(gr1[r]);
            gs0[r] = a0 * __builtin_amdgcn_rcpf(1.f + __expf(-a0)); gs1[r] = a1 * __builtin_amdgcn_rcpf(1.f + __expf(-a1)); }
    }
    {
        const float* lamp = A->dlam + layer * 128;
        float s1 = 0.f, s2 = 0.f;
        for (int i = 0; i < 32; ++i) { s1 += lamp[i] * lamp[32 + i]; s2 += lamp[64 + i] * lamp[96 + i]; }
        const float lambda_init = A->lambda_init[layer];
        const float lam = __expf(s1) - __expf(s2) + lambda_init;
        const float g0 = A->subg[layer * 64 + r32], g1 = A->subg[layer * 64 + 32 + r32];
#pragma unroll
        for (int r = 0; r < 16; ++r) {
            const float v0 = oA0[r] - lam * oB0[r];
            const float v1 = oA1[r] - lam * oB1[r];
            float ss = v0 * v0 + v1 * v1;
#pragma unroll
            for (int off = 1; off < 32; off <<= 1) ss += __shfl_xor(ss, off);
            const float rr = rsqrtf(ss * (1.f / 64.f) + EPS) * (1.f - lambda_init);
            bf16_t* yp = Y + (row0 + qw + crow(r, hi)) * D + 256 + h * 64;
            yp[r32] = f2bf(v0 * rr * g0 * gs0[r]);
            yp[32 + r32] = f2bf(v1 * rr * g1 * gs1[r]);
        }
    }
}
}

namespace sel {
__device__ __forceinline__ float relu_s(float x) { const int i = __builtin_bit_cast(int, x); return __builtin_bit_cast(float, i > 0 ? i : 0); }
}

extern "C" __device__ int lane_write(int src, int lane, int old) __asm("llvm.amdgcn.writelane");
namespace sel2 {
typedef float f32x16 __attribute__((ext_vector_type(16)));
typedef short s16x2 __attribute__((ext_vector_type(2)));
typedef unsigned short u16x2 __attribute__((ext_vector_type(2)));
__device__ __forceinline__ unsigned pk_lt(unsigned v, unsigned c) {
    const s16x2 d = __builtin_elementwise_sub_sat(__builtin_bit_cast(s16x2, v), __builtin_bit_cast(s16x2, c));
    return __builtin_bit_cast(unsigned, __builtin_bit_cast(u16x2, d) >> 15);
}
__device__ __forceinline__ unsigned pk_add(unsigned a, unsigned b) { return __builtin_bit_cast(unsigned, __builtin_bit_cast(u16x2, a) + __builtin_bit_cast(u16x2, b)); }
__device__ __forceinline__ unsigned half_sum(unsigned x) {
    x = pk_add(x, (unsigned)__builtin_amdgcn_update_dpp(0, (int)x, 0xB1, 0xf, 0xf, false));
    x = pk_add(x, (unsigned)__builtin_amdgcn_update_dpp(0, (int)x, 0x4E, 0xf, 0xf, false));
    x = pk_add(x, (unsigned)__builtin_amdgcn_update_dpp(0, (int)x, 0x141, 0xf, 0xf, false));
    x = pk_add(x, (unsigned)__builtin_amdgcn_update_dpp(0, (int)x, 0x140, 0xf, 0xf, false));
    x = pk_add(x, (unsigned)__builtin_amdgcn_ds_swizzle((int)x, 0x401F));
    return x;
}
__device__ __forceinline__ float mul_s(float a, float b) { float d; asm("v_mul_f32_e32 %0, %1, %2" : "=v"(d) : "v"(a), "v"(b)); return d; }
__device__ __forceinline__ float fma_s(float a, float b, float c) { float d; asm("v_fma_f32 %0, %1, %2, %3" : "=v"(d) : "v"(a), "v"(b), "v"(c)); return d; }
__device__ __forceinline__ void select_unit(LAS unsigned char* lds, int b, int c, int half) {
    ArgsP A = get_args();
    unsigned char* ws = A->ws;
    const bf16_t* P = (const bf16_t*)(ws + WS_P);
    unsigned* MASK = (unsigned*)(ws + WS_MASK);
    const int tid = opaque_tid(), lane = tid & 63, r32 = lane & 31, hi = lane >> 5; const int wid = __builtin_amdgcn_readfirstlane(tid >> 6);
    const int ni = c + 1, nb = 2 * ni;
    const size_t tq0 = (size_t)b * S + 64 * c + 32 * half + 4 * wid;
    if (c <= 3) {
        for (int e = lane; e < 4 * nb; e += 64) MASK[(tq0 + e / nb) * 128 + e % nb] = 0xffffffffu;
        return;
    }
    int nkeys_v = 64 * ni; asm volatile("" : "+v"(nkeys_v));
    unsigned vals[64];
    LAS unsigned* ldsv = (LAS unsigned*)lds + wid * 4096 + lane;
#define SVAL(blk) (((blk) < 64) ? vals[(blk) & 63] : ldsv[(((blk) - 64) & 63) * 64])
    {
        const int ql = 2 * ((r32 >> 2) & 1) + (r32 >> 4), hh = ((r32 >> 3) & 1) * 4 + (r32 & 3);
        const bf16x8 af0 = *(const bf16x8*)(P + (tq0 + ql) * PC + CC_QI + hh * 32 + 8 * hi), af1 = *(const bf16x8*)(P + (tq0 + ql) * PC + CC_QI + hh * 32 + 16 + 8 * hi);
        const float idx_scale = 0.35355339059327373f * 0.17677669529663687f * 0.125f;
        float wv[16];
#pragma unroll
        for (int qh = 0; qh < 2; ++qh) { const u16x8 w8 = *(const u16x8*)(P + (tq0 + 2 * hi + qh) * PC + CC_WI);
#pragma unroll
            for (int e = 0; e < 8; ++e) wv[8 * qh + e] = bf2f(w8[e]) * idx_scale; }
        const bf16_t* kgl = P + ((size_t)b * S) * PC + CC_KI;
        LAS unsigned char* kch = lds + 131072;
        const int sk0 = tid >> 2, sq = tid & 3;
        const bf16_t* sg = kgl + (size_t)sk0 * PC + sq * 8;
        const int sl0 = sk0 * 64 + ((sq ^ ((sk0 >> 2) & 3)) * 16), sl1 = sl0 + 128 * 64;
        const int sw = (r32 >> 2) & 3;
        const LAS unsigned char* rd0 = kch + r32 * 64 + ((hi ^ sw) * 16);
        const LAS unsigned char* rd1 = kch + r32 * 64 + (((2 + hi) ^ sw) * 16);
        bf16x8 afc[2][2] = {{af0, af1}, {af0, af1}};
        u32x4 st0 = *(const u32x4*)sg, st1 = *(const u32x4*)(sg + (size_t)128 * PC);
        const int ngc = 2 * ((nb + 15) >> 4);
#define SEL_BAR() do { asm volatile("s_waitcnt lgkmcnt(0)" ::: "memory"); __builtin_amdgcn_s_barrier(); asm volatile("" ::: "memory"); } while (0)
#pragma unroll
        for (int g = 0; g < 16; ++g) if (g < ngc) {
            SEL_BAR();
            *(LAS u32x4*)(kch + sl0) = st0; *(LAS u32x4*)(kch + sl1) = st1;
            SEL_BAR();
            if (g + 1 < ngc) { st0 = *(const u32x4*)(sg + (size_t)(256 * (g + 1)) * PC); st1 = *(const u32x4*)(sg + (size_t)(256 * (g + 1) + 128) * PC); }
            bf16x8 pb[2][2];
            pb[0][0] = *(const LAS bf16x8*)rd0; pb[0][1] = *(const LAS bf16x8*)rd1;
#pragma unroll
            for (int jb = 0; jb < 8; ++jb) { const int blk = 8 * g + jb;
                if (jb + 1 < 8) { pb[(jb + 1) & 1][0] = *(const LAS bf16x8*)(rd0 + (jb + 1) * 2048); pb[(jb + 1) & 1][1] = *(const LAS bf16x8*)(rd1 + (jb + 1) * 2048); }
                f32x16 acc = f32x16{};
                acc = __builtin_amdgcn_mfma_f32_32x32x16_bf16(afc[blk & 1][0], pb[jb & 1][0], acc, 0, 0, 0);
                acc = __builtin_amdgcn_mfma_f32_32x32x16_bf16(afc[blk & 1][1], pb[jb & 1][1], acc, 0, 0, 0);
                float pr_[16];
#pragma unroll
                for (int r = 0; r < 16; ++r) pr_[r] = sel::relu_s(acc[r]);
                float v0 = mul_s(wv[0], pr_[0]), v1 = mul_s(wv[8], pr_[8]);
#pragma unroll
                for (int e = 1; e < 8; ++e) { v0 = fma_s(wv[e], pr_[e], v0); v1 = fma_s(wv[8 + e], pr_[8 + e], v1); }
                unsigned sv_ = __builtin_bit_cast(unsigned, __builtin_amdgcn_cvt_pknorm_i16(v0, v1));
                { int nb_ = nb; asm volatile("" : "+s"(nb_)); sv_ = (blk < nb_) ? sv_ : 0x80008000u; }
                asm volatile("" : "+v"(afc[blk & 1][0]) : "v"(sv_));
                if (blk < 64) vals[blk & 63] = sv_; else ldsv[((blk - 64) & 63) * 64] = sv_;
            }
        }
        SEL_BAR();
#undef SEL_BAR
    }
    const int ng16 = (nb + 15) >> 4;
    const unsigned total = (unsigned)ng16 * 512u;
#define SEL2_COUNT_LT(res, c2) do { unsigned a0_ = 0u, a1_ = 0u, a2_ = 0u, a3_ = 0u; \
        _Pragma("unroll") for (int g = 0; g < 8; ++g) if (g < ng16) { \
            unsigned sv_[16]; _Pragma("unroll") for (int j = 0; j < 16; ++j) sv_[j] = SVAL(16 * g + j); \
            __builtin_amdgcn_sched_barrier(0); \
            s16x2 dd_[16]; _Pragma("unroll") for (int j = 0; j < 16; ++j) dd_[j] = __builtin_elementwise_sub_sat(__builtin_bit_cast(s16x2, sv_[j]), __builtin_bit_cast(s16x2, (unsigned)(c2))); \
            __builtin_amdgcn_sched_barrier(0); \
            u16x2 ss_[16]; _Pragma("unroll") for (int j = 0; j < 16; ++j) ss_[j] = __builtin_bit_cast(u16x2, dd_[j]) >> 15; \
            __builtin_amdgcn_sched_barrier(0); \
            _Pragma("unroll") for (int j = 0; j < 8; ++j) ss_[j] += ss_[j + 8]; \
            __builtin_amdgcn_sched_barrier(0); \
            _Pragma("unroll") for (int j = 0; j < 4; ++j) ss_[j] += ss_[j + 4]; \
            __builtin_amdgcn_sched_barrier(0); \
            a0_ = pk_add(a0_, __builtin_bit_cast(unsigned, ss_[0])); a1_ = pk_add(a1_, __builtin_bit_cast(unsigned, ss_[1])); a2_ = pk_add(a2_, __builtin_bit_cast(unsigned, ss_[2])); a3_ = pk_add(a3_, __builtin_bit_cast(unsigned, ss_[3])); \
            __builtin_amdgcn_sched_barrier(0); } \
        res = half_sum(pk_add(pk_add(a0_, a1_), pk_add(a2_, a3_))); } while (0)
    unsigned Tu2 = 0u;
    unsigned cge_lo = total, cge_hi = total;
#pragma unroll 1
    for (int bit = 15; bit >= 0; --bit) {
        const unsigned cand2 = Tu2 | ((1u << bit) * 0x10001u);
        unsigned clt; SEL2_COUNT_LT(clt, cand2 ^ 0x80008000u);
        const unsigned g_lo = total - (clt & 0xffffu), g_hi = total - (clt >> 16);
        if (g_lo >= 256u) { Tu2 = (Tu2 & 0xffff0000u) | (cand2 & 0x0000ffffu); cge_lo = g_lo; }
        if (g_hi >= 256u) { Tu2 = (Tu2 & 0x0000ffffu) | (cand2 & 0xffff0000u); cge_hi = g_hi; }
        if (__all((cge_lo == 256u) && (cge_hi == 256u))) break;
    }
    const unsigned Ts2 = Tu2 ^ 0x80008000u;
    const bool anytie = __any((cge_lo != 256u) || (cge_hi != 256u));
    unsigned mw[4][2] = {{0u, 0u}, {0u, 0u}, {0u, 0u}, {0u, 0u}};
#define SEL_PUT(blk, bl, bh) do { \
        mw[0][(blk) >> 6] = (unsigned)lane_write((int)(unsigned)(bl), (blk) & 63, (int)mw[0][(blk) >> 6]); mw[2][(blk) >> 6] = (unsigned)lane_write((int)(unsigned)((bl) >> 32), (blk) & 63, (int)mw[2][(blk) >> 6]); \
        mw[1][(blk) >> 6] = (unsigned)lane_write((int)(unsigned)(bh), (blk) & 63, (int)mw[1][(blk) >> 6]); mw[3][(blk) >> 6] = (unsigned)lane_write((int)(unsigned)((bh) >> 32), (blk) & 63, (int)mw[3][(blk) >> 6]); } while (0)
    if (!anytie) {
#pragma unroll
        for (int g = 0; g < 8; ++g) if (g < ng16)
#pragma unroll
        for (int jb = 0; jb < 16; ++jb) { const int blk = 16 * g + jb;
            const unsigned d = __builtin_bit_cast(unsigned, __builtin_elementwise_sub_sat(__builtin_bit_cast(s16x2, SVAL(blk)), __builtin_bit_cast(s16x2, Ts2)));
            const unsigned long long bl = __ballot((d & 0x8000u) == 0u), bh = __ballot((int)d >= 0);
            SEL_PUT(blk, bl, bh);
        }
    } else {
        const int excess_lo = (int)cge_lo - 256, excess_hi = (int)cge_hi - 256;
        int seen_lo = 0, seen_hi = 0;
#pragma unroll
        for (int g = 7; g >= 0; --g) if (g < ng16)
#pragma unroll
        for (int jb = 15; jb >= 0; --jb) { const int blk = 16 * g + jb;
            const unsigned d = __builtin_bit_cast(unsigned, __builtin_elementwise_sub_sat(__builtin_bit_cast(s16x2, SVAL(blk)), __builtin_bit_cast(s16x2, Ts2)));
            const bool eq_lo = ((d & 0xffffu) == 0u), eq_hi = ((d >> 16) == 0u);
            const unsigned long long el = __ballot(eq_lo), eh = __ballot(eq_hi);
            unsigned long long bl = __ballot((int)(d << 16) >= 0), bh = __ballot((int)d >= 0);
            if (__builtin_expect((el | eh) != 0ull, 0)) {
                const int cl0 = __popc((unsigned)el), cl1 = __popc((unsigned)(el >> 32)), ch0 = __popc((unsigned)eh), ch1 = __popc((unsigned)(eh >> 32));
                const int clh = hi ? cl1 : cl0, chh = hi ? ch1 : ch0;
                const int pre_lo = (int)__builtin_amdgcn_mbcnt_hi((unsigned)(el >> 32), __builtin_amdgcn_mbcnt_lo((unsigned)el, 0u)) - (hi ? cl0 : 0);
                const int pre_hi = (int)__builtin_amdgcn_mbcnt_hi((unsigned)(eh >> 32), __builtin_amdgcn_mbcnt_lo((unsigned)eh, 0u)) - (hi ? ch0 : 0);
                bl &= ~__ballot(eq_lo && (seen_lo + clh - pre_lo - 1) < excess_lo); bh &= ~__ballot(eq_hi && (seen_hi + chh - pre_hi - 1) < excess_hi);
                seen_lo += clh; seen_hi += chh;
            }
            SEL_PUT(blk, bl, bh);
        }
    }
    asm volatile("s_waitcnt lgkmcnt(0)" ::: "memory");
#pragma unroll
    for (int q = 0; q < 4; ++q)
#pragma unroll
        for (int hf = 0; hf < 2; ++hf) { const int bw = lane + 64 * hf; if (bw < nb) MASK[(tq0 + q) * 128 + bw] = mw[q][hf]; }
#undef SEL_PUT
#undef SEL2_COUNT_LT
#undef SVAL
}
}

namespace mp {
constexpr int AQ_STRIDE = 528, AKV_STRIDE = 272, L_AQ = 0, L_AKV = 128 * AQ_STRIDE;
constexpr int L_RK = L_AKV + 128 * AKV_STRIDE;
constexpr int ST_STRIDE = 208, L_ST = L_RK + 128 * 64;
__device__ __forceinline__ void stage4(LAS unsigned char* p, const f32x4 v) { u32x2 w; w.x = pg8::cvt_pk_bf16(v[0], v[1]); w.y = pg8::cvt_pk_bf16(v[2], v[3]); *(LAS u32x2*)p = w; }
__device__ __forceinline__ void store4(bf16_t* p, const f32x4 v) { uint2 w; w.x = pg8::cvt_pk_bf16(v[0], v[1]); w.y = pg8::cvt_pk_bf16(v[2], v[3]); *(uint2*)p = w; }
template <int CTRL> __device__ __forceinline__ float dppf(float v) { return __builtin_bit_cast(float, __builtin_amdgcn_update_dpp(0, __builtin_bit_cast(int, v), CTRL, 0xf, 0xf, false)); }
__device__ __forceinline__ float wave_sum64(float v) {
    v += dppf<0xB1>(v); v += dppf<0x4E>(v); v += dppf<0x141>(v); v += dppf<0x140>(v);
    v += __builtin_bit_cast(float, __builtin_amdgcn_ds_swizzle(__builtin_bit_cast(int, v), 0x401F));
    return fa::xhalf_sum(v);
}
__device__ __forceinline__ void mla_prep_unit(LAS unsigned char* lds, int tile, int l) {
    ArgsP A = get_args();
    unsigned char* ws = A->ws;
    const bf16_t* P = (const bf16_t*)(ws + WS_P);
    const float* ROPE = (const float*)(ws + WS_ROPE);
    bf16_t* QA = (bf16_t*)(ws + WS_QA); bf16_t* KA = (bf16_t*)(ws + WS_KA); bf16_t* VA = (bf16_t*)(ws + WS_VA);
    const int tid = opaque_tid(), lane = tid & 63, wid = __builtin_amdgcn_readfirstlane(tid >> 6);
    int fr = lane & 15, fq = lane >> 4;
    const size_t t0 = (size_t)tile * 128;
    const int h = wid >> 1, half = wid & 1;
    bf16x8 wq[8][3];
    {
        const bf16_t* W = (const bf16_t*)(ws + WS_WTUQ) + (size_t)l * 384 * 256 + (size_t)(48 * wid + fr) * 256 + 8 * fq;
#pragma unroll
        for (int ks = 0; ks < 8; ++ks)
#pragma unroll
            for (int nf = 0; nf < 3; ++nf) wq[ks][nf] = *(const bf16x8*)(W + (size_t)(16 * nf) * 256 + 32 * ks);
    }
    __syncthreads();
    {
        const float* qg = A->qa_g + l * 256; const float* kg = A->kva_g + l * 128;
        float gq[4], gk[4];
#pragma unroll
        for (int j = 0; j < 4; ++j) { gq[j] = qg[4 * lane + j]; gk[j] = kg[(4 * lane + j) & 127]; }
#pragma unroll 1
        for (int bt = 0; bt < 4; ++bt) {
            uint2 cq[4], ck[4]; bf16_t kr1[4], kr2[4]; float rcs[4], rsn[4];
#pragma unroll
            for (int i = 0; i < 4; ++i) {
                const int row = 16 * wid + 4 * bt + i; const size_t t = t0 + row;
                const bf16_t* p = P + t * PC;
                cq[i] = *(const uint2*)(p + CA_CQ + 4 * lane);
                ck[i] = *(const uint2*)(p + CA_CKV + 4 * (lane & 31));
                if (lane < 16) { const int pos = (int)(t % S); kr1[i] = p[CA_KR + lane]; kr2[i] = p[CA_KR + 16 + lane]; rcs[i] = ROPE[pos * 16 + lane]; rsn[i] = ROPE[S * 16 + pos * 16 + lane]; }
            }
#pragma unroll
            for (int i = 0; i < 4; ++i) {
                const int row = 16 * wid + 4 * bt + i; const size_t t = t0 + row;
                float a[4] = {bf2f((bf16_t)(cq[i].x & 0xffff)), bf2f((bf16_t)(cq[i].x >> 16)), bf2f((bf16_t)(cq[i].y & 0xffff)), bf2f((bf16_t)(cq[i].y >> 16))};
                float c[4] = {bf2f((bf16_t)(ck[i].x & 0xffff)), bf2f((bf16_t)(ck[i].x >> 16)), bf2f((bf16_t)(ck[i].y & 0xffff)), bf2f((bf16_t)(ck[i].y >> 16))};
                float sa = a[0] * a[0] + a[1] * a[1] + a[2] * a[2] + a[3] * a[3];
                float sb = (lane < 32) ? (c[0] * c[0] + c[1] * c[1] + c[2] * c[2] + c[3] * c[3]) : 0.f;
                sa = wave_sum64(sa); sb = wave_sum64(sb);
                const float ra = rsqrtf(sa * (1.f / 256.f) + EPS), rb = rsqrtf(sb * (1.f / 128.f) + EPS);
                u32x2 w; w.x = pg8::cvt_pk_bf16(a[0] * ra * gq[0], a[1] * ra * gq[1]); w.y = pg8::cvt_pk_bf16(a[2] * ra * gq[2], a[3] * ra * gq[3]);
                *(LAS u32x2*)(lds + L_AQ + row * AQ_STRIDE + 8 * lane) = w;
                if (lane < 32) { u32x2 v; v.x = pg8::cvt_pk_bf16(c[0] * rb * gk[0], c[1] * rb * gk[1]); v.y = pg8::cvt_pk_bf16(c[2] * rb * gk[2], c[3] * rb * gk[3]);
                    *(LAS u32x2*)(lds + L_AKV + row * AKV_STRIDE + 8 * lane) = v; }
                if (lane < 16) {
                    const float k1 = bf2f(kr1[i]), k2 = bf2f(kr2[i]);
                    const bf16_t o1 = f2bf(k1 * rcs[i] - k2 * rsn[i]), o2 = f2bf(k2 * rcs[i] + k1 * rsn[i]);
                    LAS bf16_t* rk = (LAS bf16_t*)(lds + L_RK + row * 64); rk[lane] = o1; rk[16 + lane] = o2;
                }
            }
        }
    }
    __syncthreads();
    const int lane2 = opaque_tid() & 63; fr = lane2 & 15; fq = lane2 >> 4;
    f32x4 acc[8][3];
#pragma unroll
    for (int mi = 0; mi < 8; ++mi)
#pragma unroll
        for (int nf = 0; nf < 3; ++nf) acc[mi][nf] = (f32x4){0.f, 0.f, 0.f, 0.f};
#pragma unroll
    for (int ks = 0; ks < 8; ++ks) {
#pragma unroll
        for (int mi = 0; mi < 8; ++mi) {
            const bf16x8 xf = *(const LAS bf16x8*)(lds + L_AQ + (16 * mi + fr) * AQ_STRIDE + 64 * ks + 16 * fq);
#pragma unroll
            for (int nf = 0; nf < 3; ++nf) acc[mi][nf] = __builtin_amdgcn_mfma_f32_16x16x32_bf16(wq[ks][nf], xf, acc[mi][nf], 0, 0, 0);
        }
    }
    __builtin_amdgcn_sched_barrier(0);
    bf16x8 wkv[4][4];
    {
        const bf16_t* W = (const bf16_t*)(ws + WS_WTUKV) + (size_t)l * 512 * 128 + (size_t)(64 * wid + fr) * 128 + 8 * fq;
#pragma unroll
        for (int ks = 0; ks < 4; ++ks)
#pragma unroll
            for (int nf = 0; nf < 4; ++nf) wkv[ks][nf] = *(const bf16x8*)(W + (size_t)(16 * nf) * 128 + 32 * ks);
    }
    LAS unsigned char* stg = lds + L_ST + wid * (16 * ST_STRIDE);
#pragma unroll
    for (int mb = 0; mb < 2; ++mb) {
        f32x4 cs[4], sn[4];
        if (half == 1) {
#pragma unroll
            for (int i = 0; i < 4; ++i) { const int pos = (int)((t0 + 16 * (4 * mb + i) + fr) % S);
                cs[i] = *(const f32x4*)(ROPE + pos * 16 + 4 * fq); sn[i] = *(const f32x4*)(ROPE + S * 16 + pos * 16 + 4 * fq); }
        }
#pragma unroll
        for (int i = 0; i < 4; ++i) { const int mi = 4 * mb + i;
            LAS unsigned char* sp = stg + fr * ST_STRIDE + 8 * fq;
            if (half == 0) { stage4(sp, acc[mi][0]); stage4(sp + 32, acc[mi][1]); stage4(sp + 64, acc[mi][2]); }
            else { const f32x4 x1 = acc[mi][1], x2 = acc[mi][2];
                stage4(sp, acc[mi][0]); stage4(sp + 32, x1 * cs[i] - x2 * sn[i]); stage4(sp + 64, x2 * cs[i] + x1 * sn[i]); }
            asm volatile("" ::: "memory");
#pragma unroll
            for (int j = 0; j < 2; ++j) { const int pc = lane2 + 64 * j; const int row = pc / 6, c = pc % 6;
                if (pc < 96) { const u32x4 v = *(const LAS u32x4*)(stg + row * ST_STRIDE + c * 16);
                    *(u32x4*)(QA + (t0 + 16 * mi + row) * 384 + h * 96 + 48 * half + c * 8) = v; } }
            asm volatile("" ::: "memory");
        }
    }
    {
        f32x4 ac2[8][4];
#pragma unroll
        for (int mi = 0; mi < 8; ++mi)
#pragma unroll
            for (int nf = 0; nf < 4; ++nf) ac2[mi][nf] = (f32x4){0.f, 0.f, 0.f, 0.f};
#pragma unroll
        for (int ks = 0; ks < 4; ++ks) {
#pragma unroll
            for (int mi = 0; mi < 8; ++mi) {
                const bf16x8 xf = *(const LAS bf16x8*)(lds + L_AKV + (16 * mi + fr) * AKV_STRIDE + 64 * ks + 16 * fq);
#pragma unroll
                for (int nf = 0; nf < 4; ++nf) ac2[mi][nf] = __builtin_amdgcn_mfma_f32_16x16x32_bf16(wkv[ks][nf], xf, ac2[mi][nf], 0, 0, 0);
            }
        }
#pragma unroll
        for (int mi = 0; mi < 8; ++mi) {
            LAS unsigned char* sp = stg + fr * ST_STRIDE + 8 * fq;
#pragma unroll
            for (int nf = 0; nf < 4; ++nf) stage4(sp + 32 * nf, ac2[mi][nf]);
            asm volatile("" ::: "memory");
            if (half == 0) {
#pragma unroll
                for (int j = 0; j < 3; ++j) { const int pc = lane2 + 64 * j; const int row = pc / 12, c = pc % 12;
                    const u32x4 v = (c < 8) ? *(const LAS u32x4*)(stg + row * ST_STRIDE + c * 16) : *(const LAS u32x4*)(lds + L_RK + (16 * mi + row) * 64 + (c - 8) * 16);
                    *(u32x4*)(KA + (t0 + 16 * mi + row) * 384 + h * 96 + c * 8) = v; }
            } else {
#pragma unroll
                for (int j = 0; j < 2; ++j) { const int pc = lane2 + 64 * j; const int row = pc >> 3, c = pc & 7;
                    const u32x4 v = *(const LAS u32x4*)(stg + row * ST_STRIDE + c * 16);
                    *(u32x4*)(VA + (t0 + 16 * mi + row) * 256 + h * 64 + c * 8) = v; }
            }
            asm volatile("" ::: "memory");
        }
    }
}
}

__device__ __forceinline__ void conv_tokens(int t, int cg, const bf16_t* P, const float* cw, bf16_t* Y) {
    const int pos = t % S, ch = cg * 8;
    const bf16_t* p = P + (size_t)t * PC;
    const u16x8 zero = (u16x8){0, 0, 0, 0, 0, 0, 0, 0};
    const u16x8 c2 = *(const u16x8*)(p + CD_C + ch), h2 = *(const u16x8*)(p + CD_H + ch);
    const u16x8 c1 = (pos >= 1) ? *(const u16x8*)(p - PC + CD_C + ch) : zero, h1 = (pos >= 1) ? *(const u16x8*)(p - PC + CD_H + ch) : zero;
    const u16x8 c0 = (pos >= 2) ? *(const u16x8*)(p - 2 * PC + CD_C + ch) : zero, h0 = (pos >= 2) ? *(const u16x8*)(p - 2 * PC + CD_H + ch) : zero;
    const u16x8 bb = *(const u16x8*)(p + CD_B + ch), gg = *(const u16x8*)(p + CD_G + ch);
    u16x8 out;
#pragma unroll
    for (int e = 0; e < 8; ++e) {
        const float y = cw[ch + e] * (bf2f(c0[e]) * bf2f(h0[e])) + cw[256 + ch + e] * (bf2f(c1[e]) * bf2f(h1[e])) + cw[512 + ch + e] * (bf2f(c2[e]) * bf2f(h2[e]));
        const float g = bf2f(gg[e]);
        out[e] = f2bf(bf2f(bb[e]) * y * (g * __builtin_amdgcn_rcpf(1.f + __expf(-g))));
    }
    *(u16x8*)(Y + (size_t)t * D + 768 + ch) = out;
}

struct ConvIn { u16x8 c2, h2, c1, h1, c0, h0, bb, gg; };
__device__ __forceinline__ ConvIn conv_load(int t, int ch, const bf16_t* P) {
    const int pos = t % S; const bf16_t* p = P + (size_t)t * PC;
    const u16x8 zero = (u16x8){0, 0, 0, 0, 0, 0, 0, 0};
    ConvIn r;
    r.c2 = *(const u16x8*)(p + CD_C + ch); r.h2 = *(const u16x8*)(p + CD_H + ch);
    r.c1 = (pos >= 1) ? *(const u16x8*)(p - PC + CD_C + ch) : zero; r.h1 = (pos >= 1) ? *(const u16x8*)(p - PC + CD_H + ch) : zero;
    r.c0 = (pos >= 2) ? *(const u16x8*)(p - 2 * PC + CD_C + ch) : zero; r.h0 = (pos >= 2) ? *(const u16x8*)(p - 2 * PC + CD_H + ch) : zero;
    r.bb = *(const u16x8*)(p + CD_B + ch); r.gg = *(const u16x8*)(p + CD_G + ch);
    return r;
}
__device__ __forceinline__ u16x8 conv_eval(const ConvIn& r, const float (&w0)[8], const float (&w1)[8], const float (&w2)[8]) {
    u16x8 out;
#pragma unroll
    for (int e = 0; e < 8; ++e) {
        const float y = w0[e] * (bf2f(r.c0[e]) * bf2f(r.h0[e])) + w1[e] * (bf2f(r.c1[e]) * bf2f(r.h1[e])) + w2[e] * (bf2f(r.c2[e]) * bf2f(r.h2[e]));
        const float g = bf2f(r.gg[e]);
        out[e] = f2bf(bf2f(r.bb[e]) * y * (g * __builtin_amdgcn_rcpf(1.f + __expf(-g))));
    }
    return out;
}
#define PH_PRE const int tid = opaque_tid(), lane = tid & 63, wave = __builtin_amdgcn_readfirstlane(tid >> 6); const int G = opaque_grid(), bid = opaque_bid(); \
    ArgsP A = get_args(); unsigned char* ws = A->ws; (void)lane; (void)wave; (void)G; (void)bid; (void)ws;
__device__ __forceinline__ void ph_prologue(LAS unsigned char* lds) {
    PH_PRE
    const long gtid = (long)bid * NTHR + tid, gthreads = (long)G * NTHR;
    {
        LAS float* scr = (LAS float*)lds;
        constexpr int T_IN = 16 * 64, T_OUT = 16 * 16, T_UQ = 4 * 6, T_UKV = 2 * 8, T_L = T_IN + T_OUT + T_UQ + T_UKV;
        for (int it = bid; it < NL * T_L; it += G) {
            const int l = it / T_L; int r = it % T_L;
            if (r < T_IN) { convert_tile(scr, A->w_in + (size_t)l * 1024 * INC, (bf16_t*)(ws + WS_WTIN) + (size_t)l * PC * 1024, 1024, INC, 1, 1.f, (r >> 6) * 64, (r & 63) * 64, tid); continue; } r -= T_IN;
            if (r < T_OUT) { convert_tile(scr, A->w_out + (size_t)l * 1024 * 1024, (bf16_t*)(ws + WS_WTOUT) + (size_t)l * 1024 * 1024, 1024, 1024, 0, 1.f, (r >> 4) * 64, (r & 15) * 64, tid); continue; } r -= T_OUT;
            if (r < T_UQ) { convert_tile(scr, A->w_uq + (size_t)l * 256 * 384, (bf16_t*)(ws + WS_WTUQ) + (size_t)l * 384 * 256, 256, 384, 0, QS_MLA, (r / 6) * 64, (r % 6) * 64, tid); continue; } r -= T_UQ;
            convert_tile(scr, A->w_ukv + (size_t)l * 128 * 512, (bf16_t*)(ws + WS_WTUKV) + (size_t)l * 512 * 128, 128, 512, 0, 1.f, (r >> 3) * 64, (r & 7) * 64, tid);
        }
        __syncthreads();
    }
    float* ROPE = (float*)(ws + WS_ROPE);
    for (long i = gtid; i < S * 16; i += gthreads) {
        const int s = (int)(i >> 4), f = (int)(i & 15);
        const float inv = powf(10000.0f, -(float)f / 16.0f);
        const float ang = (float)s * inv;
        float sn, c; sincosf(ang, &sn, &c);
        ROPE[i] = c; ROPE[S * 16 + i] = sn;
    }
}
__device__ __forceinline__ void ph_rms(int l) {
    PH_PRE
    bf16_t* HN = (bf16_t*)(ws + WS_HN);
    const int cu = bid >> 3; const size_t rb = (size_t)(bid & 7) * S;
    for (int it = 0; it < 4; ++it) { const size_t r = rb + ((it < 2) ? 2048 : 0) + cu * 64 + wave * 8 + (it & 1) * 4;
        if (l == 0) rms_rows4<true>(A->x + r * D, (size_t)D, A->norm_g + l * D, HN + r * D, nullptr, lane);
        else rms_rows4b<true>((const bf16_t*)(ws + WS_XR) + r * D, (size_t)D, A->norm_g + l * D, HN + r * D, nullptr, lane); }
}
__device__ __forceinline__ void ph_gemm_in(LAS unsigned char* lds, int l) {
    PH_PRE
    pg8::Gemm g{(const bf16_t*)(ws + WS_HN), (const bf16_t*)(ws + WS_WTIN) + (size_t)l * PC * 1024, T, PC, 1024}; pg8::StaticOrder So; So.init(T, PC, G, bid);
    pg8::EpiBf16 E{(bf16_t*)(ws + WS_P), PC, lds + 131072, (unsigned)((size_t)T * PC * 2), 0};
    pg8::gemm_phase<pg8::EpiBf16, pg8::StaticOrder, true, true>(lds, g, So, E);
}
__device__ __forceinline__ void ph_mid(LAS unsigned char* lds, int l) {
    const int G = opaque_grid(), bid = opaque_bid();
    mp::mla_prep_unit(lds, (bid & 7) * (G >> 3) + (bid >> 3), l);
    __syncthreads();
    {
        const int vcu = (bid & 7) * (G >> 3) + (bid >> 3);
        const int b = vcu >> 5, j = vcu & 31;
        for (int m = 0; m < 4; ++m) { const int c = ((m & 1) ? (15 - (j >> 1)) : (j >> 1)) + 16 * m; sel2::select_unit(lds, b, c, j & 1); }
    }
}
__device__ __forceinline__ void ph_attn(LAS unsigned char* lds, int l) {
    const int G = opaque_grid(), bid = opaque_bid();
    {
        const int vcu = (bid & 7) * (G >> 3) + (bid >> 3);
        const int b = vcu >> 5, h = (vcu >> 3) & 3, s = vcu & 7;
        { ArgsP A = get_args(); fa::build_bias(lds, A->rel_bias); }
#define ATTN_UNIT(TY) do { _Pragma("unroll 1") for (int u_ = 0; u_ < 2; ++u_) { int b_ = b, h_ = h, q_ = u_ ? s : 15 - s, l_ = l; asm volatile("" : "+s"(b_), "+s"(h_), "+s"(q_), "+s"(l_)); \
            fa::attn_unit<TY>(lds, b_, h_, q_, l_); } } while (0)
        ATTN_UNIT(0);
        { _Pragma("unroll 1") for (int u_ = 0; u_ < 2; ++u_) { int b_ = b, h_ = h, q_ = u_ ? s : 15 - s, l_ = l; asm volatile("" : "+s"(b_), "+s"(h_), "+s"(q_), "+s"(l_)); fa::attn_unit_diff(lds, b_, h_, q_, l_); } }
        ATTN_UNIT(2);
#undef ATTN_UNIT
        __syncthreads();
    }
    {
        PH_PRE
        const int vcu = (bid & 7) * (G >> 3) + (bid >> 3);
        const int ch = (tid & 31) * 8; const float* cw = A->conv_w + l * 768;
        float w0[8], w1[8], w2[8];
#pragma unroll
        for (int e = 0; e < 8; ++e) { w0[e] = cw[ch + e]; w1[e] = cw[256 + ch + e]; w2[e] = cw[512 + ch + e]; }
        const bf16_t* Pp = (const bf16_t*)(ws + WS_P); bf16_t* Y = (bf16_t*)(ws + WS_Y);
        for (int t = vcu * 128 + (tid >> 5); t < vcu * 128 + 128; t += 32) {
            const ConvIn ra = conv_load(t, ch, Pp), rb = conv_load(t + 16, ch, Pp);
            const u16x8 oa = conv_eval(ra, w0, w1, w2), ob = conv_eval(rb, w0, w1, w2);
            *(u16x8*)(Y + (size_t)t * D + 768 + ch) = oa; *(u16x8*)(Y + (size_t)(t + 16) * D + 768 + ch) = ob;
        }
    }
}
__device__ __forceinline__ void ph_gemm_out(LAS unsigned char* lds, int l) {
    PH_PRE
    pg8::Gemm g{(const bf16_t*)(ws + WS_Y), (const bf16_t*)(ws + WS_WTOUT) + (size_t)l * 1024 * 1024, T, 1024, 1024}; pg8::StaticOrder So; So.init(T, 1024, G, bid);
    bf16_t* XR = (bf16_t*)(ws + WS_XR);
    if (l == 0) { pg8::EpiResBf16<false> E{A->x, XR, 1024}; pg8::gemm_phase<pg8::EpiResBf16<false>, pg8::StaticOrder, true, true>(lds, g, So, E); }
    else { pg8::EpiResBf16<true> E{XR, XR, 1024}; pg8::gemm_phase<pg8::EpiResBf16<true>, pg8::StaticOrder, true, true>(lds, g, So, E); }
}
__device__ __forceinline__ void ph_final() {
    PH_PRE
    const bf16_t* XR = (const bf16_t*)(ws + WS_XR);
    const int cu = bid >> 3; const size_t rb = (size_t)(bid & 7) * S;
    for (int it = 0; it < 4; ++it) { const size_t r = rb + ((it < 2) ? 2048 : 0) + cu * 64 + wave * 8 + (it & 1) * 4;
        rms_rows4b<false>(XR + r * D, (size_t)D, A->final_g, nullptr, A->out + r * D, lane); }
}

#define GRID_SYNC() xcd_barrier(lds, true)
__global__ void __launch_bounds__(NTHR, 2) mk_fwd(Args Akernarg) {
    extern __shared__ __attribute__((aligned(16))) unsigned char lds_raw[];
    LAS unsigned char* lds = (LAS unsigned char*)lds_raw;
    xcd_barrier_post(lds);
    ph_prologue(lds);
    for (int l = 0; l < NL; ++l) {
        ph_rms(l);
        if (l == 0) { xcd_barrier(lds, false); xcd_decide_scope(lds); }
        else GRID_SYNC();
        ph_gemm_in(lds, l);
        GRID_SYNC();
        ph_mid(lds, l);
        GRID_SYNC();
        ph_attn(lds, l);
        GRID_SYNC();
        ph_gemm_out(lds, l);
        GRID_SYNC();
    }
    ph_final();
}

extern "C" void kernel_launch(void* const* d_in, const int* in_sizes, int n_in, void* d_out, int out_size, void* d_ws, size_t ws_size, hipStream_t stream) {
    static int grid = 0;
    if (grid == 0) {
        if (ws_size < WS_END) { fprintf(stderr, "kernel_launch: workspace too small (%zu < %zu)\n", ws_size, (size_t)WS_END); grid = -1; return; }
        int dev = 0, cus = 0, per_cu = 0;
        hipGetDevice(&dev);
        hipDeviceGetAttribute(&cus, hipDeviceAttributeMultiprocessorCount, dev);
        hipFuncSetAttribute((const void*)mk_fwd, hipFuncAttributeMaxDynamicSharedMemorySize, LDS_BYTES);
        hipOccupancyMaxActiveBlocksPerMultiprocessor(&per_cu, (const void*)mk_fwd, NTHR, LDS_BYTES);
        if (per_cu < 1) fprintf(stderr, "kernel_launch: note: the occupancy query reports %d workgroups per CU; 145 KiB of LDS per workgroup admits exactly one\n", per_cu);
        (void)hipGetLastError();
        if (cus != 256) { fprintf(stderr, "kernel_launch: built for a 256-CU device (one workgroup per CU, 32 per batch); found %d CUs; nothing launched\n", cus); grid = -1; return; }
        grid = cus;
    }
    if (grid < 0) return;
    Args a{};
    a.x = (const float*)d_in[0]; a.norm_g = (const float*)d_in[1]; a.w_in = (const float*)d_in[2]; a.qa_g = (const float*)d_in[3];
    a.w_uq = (const float*)d_in[4]; a.kva_g = (const float*)d_in[5]; a.w_ukv = (const float*)d_in[6]; a.dlam = (const float*)d_in[7];
    a.subg = (const float*)d_in[8]; a.conv_w = (const float*)d_in[9]; a.w_out = (const float*)d_in[10]; a.rel_bias = (const float*)d_in[11];
    a.final_g = (const float*)d_in[12];
    a.out = (float*)d_out; a.ws = (unsigned char*)d_ws;
    a.lambda_init[0] = 0.8f - 0.6f * expf(-0.3f * 0.f); a.lambda_init[1] = 0.8f - 0.6f * expf(-0.3f * 1.f);
    if (hipMemsetAsync(d_ws, 0, 65536, stream) != hipSuccess) { fprintf(stderr, "kernel_launch: memset of the barrier words failed\n"); return; }
    hipLaunchKernelGGL(mk_fwd, dim3(grid), dim3(NTHR), LDS_BYTES, stream, a);
    const hipError_t e = hipPeekAtLastError();
    if (e != hipSuccess) fprintf(stderr, "launch failed: %s (grid %d)\n", hipGetErrorString(e), grid);
}
```
